# Optimizing an MI355X kernel written in HIP

```python
import jax, jax.numpy as jnp
from jax import lax

D_MODEL = 1024
BATCH = 4
SEQ = 4096
DEPTH = 2

GRID_W = 64
CTX_LEN = 256
NORM_EPS = 1e-6
ROPE_THETA = 10000.0
RET_HEADS = 4
RET_DK = 128
RET_DV = 256
RET_CHUNK = 128
SWA_HEADS = 16
SWA_KV_HEADS = 2
SWA_HD = 64
WINDOW = 128
GA_HEADS = 8
GA_KV_HEADS = 2
GA_HD = 128
Q_BLOCK = 128
N_EXPERTS = 16
N_GROUPS = 4
EXPERTS_PER_GROUP = N_EXPERTS // N_GROUPS
TOP_K = 2
D_EXPERT = 512
MOE_BLOCK = 128

RET_QK = RET_HEADS * RET_DK
RET_V = RET_HEADS * RET_DV
SWA_Q = SWA_HEADS * SWA_HD
SWA_KV = SWA_KV_HEADS * SWA_HD
GA_Q = GA_HEADS * GA_HD
GA_KV = GA_KV_HEADS * GA_HD
SPLITS = (RET_QK, RET_QK, RET_V, RET_V, SWA_Q, SWA_KV, SWA_KV, GA_Q, GA_KV, GA_KV, D_MODEL, D_MODEL, D_MODEL)
D_IN = 2 * RET_QK + 2 * RET_V + SWA_Q + 2 * SWA_KV + GA_Q + 2 * GA_KV + 3 * D_MODEL

kernel_name = 'hybrid_retention_swa_gqa_moe_dit'


def rms_normalize(x):
    x32 = x.astype(jnp.float32)
    return (x32 * lax.rsqrt(jnp.mean(x32 * x32, axis=-1, keepdims=True) + NORM_EPS)).astype(x.dtype)


def rms_norm(x, g):
    return rms_normalize(x) * g.astype(x.dtype)


def split_columns(p):
    parts = []
    start = 0
    for width in SPLITS:
        parts.append(p[..., start:start + width])
        start += width
    return parts


def heads(t, n_heads):
    return t.reshape(t.shape[0], t.shape[1], n_heads, -1)


def grid_positions(n_tokens):
    rows = n_tokens // GRID_W
    row = jnp.repeat(jnp.arange(rows, dtype=jnp.int32), GRID_W)
    col = jnp.tile(jnp.arange(GRID_W, dtype=jnp.int32), rows)
    return row, col


def rope_2d(x, row, col):
    hd = x.shape[-1]
    half = hd // 2
    quarter = hd // 4
    freqs = ROPE_THETA ** (-jnp.arange(quarter, dtype=jnp.float32) / quarter)
    parts = []
    for a, pos in enumerate((row, col)):
        ang = pos.astype(jnp.float32)[:, None] * freqs[None, :]
        cos = jnp.cos(ang)[None, :, None, :]
        sin = jnp.sin(ang)[None, :, None, :]
        xa = x[..., a * half:(a + 1) * half].astype(jnp.float32)
        x1, x2 = xa[..., :quarter], xa[..., quarter:]
        parts.append(x1 * cos - x2 * sin)
        parts.append(x1 * sin + x2 * cos)
    return jnp.concatenate(parts, axis=-1).astype(x.dtype)


def retention_chunkwise(q, k, v, log_gamma, state0, strict):
    b, length, h, _ = q.shape
    dv = v.shape[-1]
    n_chunks = length // RET_CHUNK
    idx = jnp.arange(RET_CHUNK, dtype=jnp.float32)
    diff = idx[:, None] - idx[None, :]
    keep = (diff > 0) if strict else (diff >= 0)
    decay_in = jnp.where(keep[None], jnp.exp(jnp.maximum(diff, 0.0)[None] * log_gamma[:, None, None]), 0.0)
    q_decay = jnp.exp((idx[:, None] + 1.0) * log_gamma[None, :])[None, :, :, None]
    k_decay = jnp.exp((RET_CHUNK - 1.0 - idx)[:, None] * log_gamma[None, :])[None, :, :, None]
    chunk_decay = jnp.exp(RET_CHUNK * log_gamma)[None, :, None, None]

    def chunks(t):
        return t.reshape(b, n_chunks, RET_CHUNK, h, t.shape[-1]).swapaxes(0, 1)

    def step(state, qkv):
        qc, kc, vc = qkv
        s = jnp.einsum('bihd,bjhd->bhij', qc, kc) * decay_in
        o = jnp.einsum('bhij,bjhe->bihe', s, vc) + jnp.einsum('bihd,bhde->bihe', qc * q_decay, state)
        state = chunk_decay * state + jnp.einsum('bjhd,bjhe->bhde', kc * k_decay, vc)
        return state, o

    _, o = lax.scan(step, state0, (chunks(q), chunks(k), chunks(v)))
    return o.swapaxes(0, 1).reshape(b, length, h, dv)


def retention_context(q, k, v, lg_f, lg_b):
    n = k.shape[1]
    pos = jnp.arange(n, dtype=jnp.float32)
    diff = pos[:, None] - pos[None, :]
    decay = jnp.where(diff[None] >= 0,
                      jnp.exp(jnp.maximum(diff, 0.0)[None] * lg_f[:, None, None]),
                      jnp.exp(jnp.maximum(-diff, 0.0)[None] * lg_b[:, None, None]))
    s = jnp.einsum('bihd,bjhd->bhij', q, k) * decay
    return jnp.einsum('bhij,bjhe->bihe', s, v)


def retention_context_states(k, v, lg_f, lg_b):
    n = k.shape[1]
    pos = jnp.arange(n, dtype=jnp.float32)
    w_f = jnp.exp((n - 1.0 - pos)[:, None] * lg_f[None, :])
    w_b = jnp.exp(pos[:, None] * lg_b[None, :])
    s_f = jnp.einsum('lh,blhd,blhe->bhde', w_f, k, v).astype(jnp.float32)
    s_b = jnp.einsum('lh,blhd,blhe->bhde', w_b, k, v).astype(jnp.float32)
    return s_f, s_b


def retention_output(o, u):
    b, length, h, dv = o.shape
    y = rms_normalize(o.astype(jnp.float32)) * jax.nn.silu(u.astype(jnp.float32)).reshape(b, length, h, dv)
    return y.reshape(b, length, h * dv).astype(u.dtype)


def window_attention(q, k, v, k_ctx, v_ctx, sink):
    b, length, n_heads, hd = q.shape
    kvh = k.shape[2]
    g = n_heads // kvh
    n_ctx = k_ctx.shape[1]
    nb = length // Q_BLOCK
    band = Q_BLOCK + 2 * WINDOW
    qg = (q * hd ** -0.5).reshape(b, nb, Q_BLOCK, kvh, g, hd).swapaxes(0, 1)
    kp = jnp.pad(k, ((0, 0), (WINDOW, WINDOW), (0, 0), (0, 0)))
    vp = jnp.pad(v, ((0, 0), (WINDOW, WINDOW), (0, 0), (0, 0)))
    sink_g = sink.reshape(kvh, g).astype(jnp.float32)[None, :, :, None, None]
    q_off = jnp.arange(Q_BLOCK, dtype=jnp.int32)
    k_off = jnp.arange(band, dtype=jnp.int32)

    def block(args):
        qb, j = args
        start = j * Q_BLOCK
        kb = lax.dynamic_slice_in_dim(kp, start, band, axis=1)
        vb = lax.dynamic_slice_in_dim(vp, start, band, axis=1)
        qpos = start + q_off
        kpos = start - WINDOW + k_off
        valid = (jnp.abs(qpos[:, None] - kpos[None, :]) <= WINDOW) & (kpos[None, :] >= 0) & (kpos[None, :] < length)
        s_loc = jnp.where(valid, jnp.einsum('bqkgd,bckd->bkgqc', qb, kb).astype(jnp.float32), -jnp.inf)
        s_ctx = jnp.einsum('bqkgd,bckd->bkgqc', qb, k_ctx).astype(jnp.float32)
        s_sink = jnp.broadcast_to(sink_g, s_ctx.shape[:-1] + (1,))
        p = jax.nn.softmax(jnp.concatenate([s_loc, s_ctx, s_sink], axis=-1), axis=-1).astype(v.dtype)
        o = (jnp.einsum('bkgqc,bckd->bqkgd', p[..., :band], vb)
             + jnp.einsum('bkgqc,bckd->bqkgd', p[..., band:band + n_ctx], v_ctx))
        return o.reshape(b, Q_BLOCK, n_heads * hd)

    out = lax.map(block, (qg, jnp.arange(nb, dtype=jnp.int32)))
    return out.swapaxes(0, 1).reshape(b, length, n_heads * hd)


def global_attention(q, k_all, v_all):
    b, length, n_heads, hd = q.shape
    kvh = k_all.shape[2]
    g = n_heads // kvh
    nb = length // Q_BLOCK
    qg = (q * hd ** -0.5).reshape(b, nb, Q_BLOCK, kvh, g, hd).swapaxes(0, 1)

    def block(qb):
        s = jnp.einsum('bqkgd,bckd->bkgqc', qb, k_all).astype(jnp.float32)
        p = jax.nn.softmax(s, axis=-1).astype(v_all.dtype)
        return jnp.einsum('bkgqc,bckd->bqkgd', p, v_all).reshape(b, Q_BLOCK, n_heads * hd)

    out = lax.map(block, qg)
    return out.swapaxes(0, 1).reshape(b, length, n_heads * hd)


def context_attention(q, k, v, sink):
    b, n, n_heads, hd = q.shape
    kvh = k.shape[2]
    g = n_heads // kvh
    qg = (q * hd ** -0.5).reshape(b, n, kvh, g, hd)
    s = jnp.einsum('bqkgd,bckd->bkgqc', qg, k).astype(jnp.float32)
    if sink is not None:
        s_sink = jnp.broadcast_to(sink.reshape(kvh, g).astype(jnp.float32)[None, :, :, None, None], s.shape[:-1] + (1,))
        p = jax.nn.softmax(jnp.concatenate([s, s_sink], axis=-1), axis=-1)[..., :n]
    else:
        p = jax.nn.softmax(s, axis=-1)
    o = jnp.einsum('bkgqc,bckd->bqkgd', p.astype(v.dtype), v)
    return o.reshape(b, n, n_heads * hd)


def merge_branches(o_ret, o_swa, o_ga, a_ret, a_swa, a_ga, w_br_ret, w_br_swa, w_br_ga, w_out):
    y = (jax.nn.sigmoid(a_ret) * (o_ret @ w_br_ret)
         + jax.nn.sigmoid(a_swa) * (o_swa @ w_br_swa)
         + jax.nn.sigmoid(a_ga) * (o_ga @ w_br_ga))
    return y @ w_out


def mixer_sublayer(h, hc, row, col, w_in, ret_logit, sink, g_q, g_k,
                   w_br_ret, w_br_swa, w_br_ga, w_out, need_ctx):
    (q_r, k_r, v_r, u_r, q_s, k_s, v_s, q_a, k_a, v_a, a_r, a_s, a_a) = split_columns(h @ w_in)
    (cq_r, ck_r, cv_r, cu_r, cq_s, ck_s, cv_s, cq_a, ck_a, cv_a, ca_r, ca_s, ca_a) = split_columns(hc @ w_in)
    log_gamma = jax.nn.log_sigmoid(ret_logit.astype(jnp.float32))
    lg_f, lg_b = log_gamma[0], log_gamma[1]
    k_scale = RET_DK ** -0.5

    ckr = heads(ck_r, RET_HEADS) * k_scale
    cvr = heads(cv_r, RET_HEADS)
    s_f, s_b = retention_context_states(ckr, cvr, lg_f, lg_b)
    cks = heads(ck_s, SWA_KV_HEADS)
    cvs = heads(cv_s, SWA_KV_HEADS)
    cka = rms_norm(heads(ck_a, GA_KV_HEADS), g_k)
    cva = heads(cv_a, GA_KV_HEADS)

    qr = rope_2d(heads(q_r, RET_HEADS), row, col)
    kr = rope_2d(heads(k_r, RET_HEADS), row, col) * k_scale
    vr = heads(v_r, RET_HEADS)
    o_f = retention_chunkwise(qr, kr, vr, lg_f, s_f, False)
    o_b = retention_chunkwise(qr[:, ::-1], kr[:, ::-1], vr[:, ::-1], lg_b, s_b, True)[:, ::-1]
    o_ret = retention_output(o_f + o_b, u_r)

    o_swa = window_attention(rope_2d(heads(q_s, SWA_HEADS), row, col),
                             rope_2d(heads(k_s, SWA_KV_HEADS), row, col),
                             heads(v_s, SWA_KV_HEADS), cks, cvs, sink)

    qa = rope_2d(rms_norm(heads(q_a, GA_HEADS), g_q), row, col)
    ka = rope_2d(rms_norm(heads(k_a, GA_KV_HEADS), g_k), row, col)
    k_all = jnp.concatenate([ka, cka], axis=1)
    v_all = jnp.concatenate([heads(v_a, GA_KV_HEADS), cva], axis=1)
    o_ga = global_attention(qa, k_all, v_all)

    y = merge_branches(o_ret, o_swa, o_ga, a_r, a_s, a_a, w_br_ret, w_br_swa, w_br_ga, w_out)
    yc = None
    if need_ctx:
        co_ret = retention_output(retention_context(heads(cq_r, RET_HEADS), ckr, cvr, lg_f, lg_b), cu_r)
        co_swa = context_attention(heads(cq_s, SWA_HEADS), cks, cvs, sink)
        co_ga = context_attention(rms_norm(heads(cq_a, GA_HEADS), g_q), cka, cva, None)
        yc = merge_branches(co_ret, co_swa, co_ga, ca_r, ca_s, ca_a, w_br_ret, w_br_swa, w_br_ga, w_out)
    return y, yc


def moe_ffn(tokens, w_router, b_router, w_gate, w_up, w_down):
    n_tok, d = tokens.shape
    scores = jax.nn.sigmoid(tokens.astype(jnp.float32) @ w_router.astype(jnp.float32))
    biased = (scores + b_router.astype(jnp.float32)).reshape(n_tok, N_GROUPS, EXPERTS_PER_GROUP)
    group_score = lax.top_k(biased, TOP_K)[0].sum(-1)
    group = jnp.argmax(group_score, axis=-1).astype(jnp.int32)
    in_group = jnp.take_along_axis(biased, group[:, None, None], axis=1)[:, 0]
    local = lax.top_k(in_group, TOP_K)[1]
    expert = group[:, None] * EXPERTS_PER_GROUP + local
    weight = jnp.take_along_axis(scores, expert, axis=1)
    weight = weight / jnp.sum(weight, axis=-1, keepdims=True)

    n_assign = n_tok * TOP_K
    flat_e = expert.reshape(-1)
    flat_t = jnp.repeat(jnp.arange(n_tok, dtype=jnp.int32), TOP_K)
    flat_w = weight.reshape(-1)
    order = jnp.argsort(flat_e)
    se, st, sw = flat_e[order], flat_t[order], flat_w[order]
    counts = jax.ops.segment_sum(jnp.ones_like(flat_e), flat_e, num_segments=N_EXPERTS)
    padded = (counts + MOE_BLOCK - 1) // MOE_BLOCK * MOE_BLOCK
    starts = jnp.cumsum(counts) - counts
    pad_ends = jnp.cumsum(padded)
    pad_starts = pad_ends - padded
    dest = pad_starts[se] + jnp.arange(n_assign, dtype=jnp.int32) - starts[se]
    n_blocks = (n_assign + N_EXPERTS * (MOE_BLOCK - 1) + MOE_BLOCK - 1) // MOE_BLOCK
    buf = jnp.zeros((n_blocks * MOE_BLOCK, d), tokens.dtype).at[dest].set(tokens[st])
    block_e = jnp.minimum(jnp.searchsorted(pad_ends, jnp.arange(n_blocks, dtype=jnp.int32) * MOE_BLOCK, side='right'),
                          N_EXPERTS - 1)

    def expert_block(args):
        xb, e = args
        hid = jax.nn.silu(xb @ w_gate[e]) * (xb @ w_up[e])
        return hid @ w_down[e]

    y = lax.map(expert_block, (buf.reshape(n_blocks, MOE_BLOCK, d), block_e)).reshape(-1, d)
    contrib = y[dest] * sw[:, None].astype(y.dtype)
    return jnp.zeros_like(tokens).at[st].add(contrib)


def setup_inputs(seed: int = 0) -> dict:
    key = jax.random.key(seed)
    ks = jax.random.split(key, 24)
    f32 = jnp.float32
    nrm = jax.random.normal

    def w(k, shape, fan_in, scale=1.0):
        return nrm(k, shape, f32) * (scale * fan_in ** -0.5)

    def gain(k, shape):
        return 1.0 + 0.02 * nrm(k, shape, f32)

    decay0 = jnp.log(2.0 ** (5.0 + jnp.arange(RET_HEADS, dtype=f32)) - 1.0)
    return {
        'x': nrm(ks[0], (BATCH, SEQ, D_MODEL), f32),
        'c': nrm(ks[1], (BATCH, D_MODEL), f32),
        'ctx': nrm(ks[2], (BATCH, CTX_LEN, D_MODEL), f32),
        'c_ctx': nrm(ks[3], (D_MODEL,), f32),
        'w_mod': w(ks[4], (DEPTH, D_MODEL, 6 * D_MODEL), D_MODEL, 0.5),
        'b_mod': 0.01 * nrm(ks[5], (DEPTH, 6 * D_MODEL), f32),
        'g_norm1': gain(ks[6], (DEPTH, D_MODEL)),
        'g_norm2': gain(ks[7], (DEPTH, D_MODEL)),
        'w_in': w(ks[8], (DEPTH, D_MODEL, D_IN), D_MODEL),
        'ret_decay_logit': decay0 + 0.1 * nrm(ks[9], (DEPTH, 2, RET_HEADS), f32),
        'swa_sink': 0.5 * nrm(ks[10], (DEPTH, SWA_HEADS), f32),
        'g_qnorm': gain(ks[11], (DEPTH, GA_HD)),
        'g_knorm': gain(ks[12], (DEPTH, GA_HD)),
        'w_br_ret': w(ks[13], (DEPTH, RET_V, D_MODEL), RET_V),
        'w_br_swa': w(ks[14], (DEPTH, SWA_Q, D_MODEL), SWA_Q),
        'w_br_ga': w(ks[15], (DEPTH, GA_Q, D_MODEL), GA_Q),
        'w_out': w(ks[16], (DEPTH, D_MODEL, D_MODEL), D_MODEL),
        'w_router': w(ks[17], (D_MODEL, N_EXPERTS), D_MODEL),
        'b_router': 0.01 * nrm(ks[18], (N_EXPERTS,), f32),
        'w_gate': w(ks[19], (DEPTH, N_EXPERTS, D_MODEL, D_EXPERT), D_MODEL),
        'w_up': w(ks[20], (DEPTH, N_EXPERTS, D_MODEL, D_EXPERT), D_MODEL),
        'w_down': w(ks[21], (DEPTH, N_EXPERTS, D_EXPERT, D_MODEL), D_EXPERT),
        'g_final': gain(ks[22], (D_MODEL,)),
    }


def reference(x, c, ctx, c_ctx, w_mod, b_mod, g_norm1, g_norm2, w_in, ret_decay_logit, swa_sink,
              g_qnorm, g_knorm, w_br_ret, w_br_swa, w_br_ga, w_out, w_router, b_router,
              w_gate, w_up, w_down, g_final):
    b, length, d = x.shape
    row, col = grid_positions(length)
    for l in range(DEPTH):
        need_ctx = l < DEPTH - 1
        mod = (jax.nn.silu(c) @ w_mod[l] + b_mod[l])[:, None, :]
        mod_c = (jax.nn.silu(c_ctx) @ w_mod[l] + b_mod[l])[None, None, :]
        sh1, sc1, gt1, sh2, sc2, gt2 = jnp.split(mod, 6, axis=-1)
        csh1, csc1, cgt1, csh2, csc2, cgt2 = jnp.split(mod_c, 6, axis=-1)

        h = rms_norm(x, g_norm1[l]) * (1.0 + sc1) + sh1
        hc = rms_norm(ctx, g_norm1[l]) * (1.0 + csc1) + csh1
        y, yc = mixer_sublayer(h, hc, row, col, w_in[l], ret_decay_logit[l], swa_sink[l], g_qnorm[l], g_knorm[l],
                               w_br_ret[l], w_br_swa[l], w_br_ga[l], w_out[l], need_ctx)
        x = x + gt1 * y

        h = rms_norm(x, g_norm2[l]) * (1.0 + sc2) + sh2
        if need_ctx:
            ctx = ctx + cgt1 * yc
            hc = rms_norm(ctx, g_norm2[l]) * (1.0 + csc2) + csh2
            tokens = jnp.concatenate([h.reshape(-1, d), hc.reshape(-1, d)], axis=0)
            out = moe_ffn(tokens, w_router, b_router, w_gate[l], w_up[l], w_down[l])
            x = x + gt2 * out[:b * length].reshape(x.shape)
            ctx = ctx + cgt2 * out[b * length:].reshape(ctx.shape)
        else:
            x = x + gt2 * moe_ffn(h.reshape(-1, d), w_router, b_router, w_gate[l], w_up[l], w_down[l]).reshape(x.shape)
    return rms_norm(x, g_final)
```

```cpp
#include <hip/hip_runtime.h>
#include <hip/hip_cooperative_groups.h>
#include <cstdio>
#include <cstdint>
namespace cg = cooperative_groups;

#ifndef MULTI_LAUNCH
#define MULTI_LAUNCH 0
#endif

typedef unsigned short bf16;
typedef __attribute__((ext_vector_type(8))) short bf16x8;
typedef __attribute__((ext_vector_type(16))) float f32x16;

constexpr int NT = 512;
constexpr int D = 1024, NB = 4, SEQ = 4096, CTXL = 256;
constexpr int TLAT = NB * SEQ, TCTX = NB * CTXL, TALL = TLAT + TCTX;
constexpr int DIN = 8960, DQKV = 5888;
constexpr int NEXP = 16, DEXP = 512;
constexpr float EPS = 1e-6f;

constexpr size_t OFF_CTL  = 0;
constexpr size_t OFF_LTS  = 4096;
constexpr size_t OFF_LW   = OFF_LTS + (size_t)16 * TALL * 4;
constexpr size_t OFF_MOD  = OFF_LW + (size_t)16 * TALL * 4;
constexpr size_t OFF_ROPE = OFF_MOD + (size_t)2 * 5 * 6144 * 4;
constexpr size_t OFF_CX   = OFF_ROPE + 32768;
constexpr size_t OFF_H    = OFF_CX + (size_t)TCTX * D * 4;
constexpr size_t OFF_QR   = OFF_H + (size_t)TALL * 1024 * 2;
constexpr size_t OFF_KR   = OFF_QR + (size_t)TALL * 512 * 2;
constexpr size_t OFF_VR   = OFF_KR + (size_t)TALL * 512 * 2;
constexpr size_t OFF_UR   = OFF_VR + (size_t)TALL * 1024 * 2;
constexpr size_t OFF_QS   = OFF_UR + (size_t)TALL * 1024 * 2;
constexpr size_t OFF_KS   = OFF_QS + (size_t)TALL * 1024 * 2;
constexpr size_t OFF_VS   = OFF_KS + (size_t)TALL * 128 * 2;
constexpr size_t OFF_QA   = OFF_VS + (size_t)TALL * 128 * 2;
constexpr size_t OFF_KA   = OFF_QA + (size_t)TALL * 1024 * 2;
constexpr size_t OFF_VA   = OFF_KA + (size_t)TALL * 256 * 2;
constexpr size_t OFF_F    = OFF_VA + (size_t)TALL * 256 * 2;
constexpr size_t F_BYTES  = (size_t)71303168;
constexpr size_t OFF_WT   = OFF_F + F_BYTES;
constexpr size_t WT_LAYER = ((size_t)DIN * 1024 + 4 * 1024 * 1024) * 2;
constexpr size_t WS_END   = OFF_WT + 2 * WT_LAYER;
constexpr size_t OFF_Y    = OFF_QR;
constexpr size_t OFF_HB   = OFF_VR;
constexpr size_t OFF_YB   = OFF_QS;
constexpr size_t OFF_WGU  = OFF_F;
constexpr size_t OFF_WD   = OFF_F + (size_t)16 * 1024 * 1024 * 2;

struct Params {
    const float *x, *c, *ctx, *c_ctx, *w_mod, *b_mod, *g1, *g2, *w_in, *ret_logit, *sink, *gq, *gk,
                *w_br_ret, *w_br_swa, *w_br_ga, *w_out, *w_router, *b_router, *w_gate, *w_up, *w_down, *g_final;
    float* out;
    unsigned char* ws;
    int ph_lo, ph_hi;
};

__device__ __forceinline__ int otid() { int t = threadIdx.x; asm volatile("" : "+v"(t)); return t; }
__device__ __forceinline__ bf16 f2bf(float f) { unsigned u = __float_as_uint(f); u += 0x7fffu + ((u >> 16) & 1u); return (bf16)(u >> 16); }
__device__ __forceinline__ float bf2f(bf16 h) { return __uint_as_float(((unsigned)h) << 16); }
__device__ __forceinline__ unsigned pack2(float a, float b) { return (unsigned)f2bf(a) | ((unsigned)f2bf(b) << 16); }
__device__ __forceinline__ float lo2f(unsigned u) { return __uint_as_float(u << 16); }
__device__ __forceinline__ float hi2f(unsigned u) { return __uint_as_float(u & 0xffff0000u); }
__device__ __forceinline__ float wsum(float v) {
#pragma unroll
    for (int o = 32; o > 0; o >>= 1) v += __shfl_xor(v, o, 64);
    return v;
}
__device__ __forceinline__ float wmax(float v) {
#pragma unroll
    for (int o = 32; o > 0; o >>= 1) v = fmaxf(v, __shfl_xor(v, o, 64));
    return v;
}
__device__ __forceinline__ float sigmoidf_(float x) { return 1.f / (1.f + expf(-x)); }
__device__ __forceinline__ float siluf_(float x) { return x / (1.f + expf(-x)); }

__device__ void mod_item(const Params& p, int item, char* smem) {
    float* sc = (float*)smem;
    float* red = sc + 5 * 1024;
    const int tid = otid();
    for (int i = tid; i < 5 * 1024; i += NT) {
        int v = i >> 10, k = i & 1023;
        float xv = v < 4 ? p.c[v * 1024 + k] : p.c_ctx[k];
        sc[i] = siluf_(xv);
    }
    __syncthreads();
    const int l = item / 96, cgp = item % 96, cc = tid & 63, ks = tid >> 6;
    const float* w = p.w_mod + (size_t)l * 1024 * 6144 + cgp * 64 + cc;
    float a0 = 0, a1 = 0, a2 = 0, a3 = 0, a4 = 0;
    for (int k = ks * 128; k < ks * 128 + 128; ++k) {
        float wv = w[(size_t)k * 6144];
        a0 += sc[k] * wv; a1 += sc[1024 + k] * wv; a2 += sc[2048 + k] * wv; a3 += sc[3072 + k] * wv; a4 += sc[4096 + k] * wv;
    }
    red[(ks * 5 + 0) * 64 + cc] = a0; red[(ks * 5 + 1) * 64 + cc] = a1; red[(ks * 5 + 2) * 64 + cc] = a2;
    red[(ks * 5 + 3) * 64 + cc] = a3; red[(ks * 5 + 4) * 64 + cc] = a4;
    __syncthreads();
    if (tid < 320) {
        int v = tid >> 6, c2 = tid & 63; float s = 0;
        for (int k2 = 0; k2 < 8; ++k2) s += red[(k2 * 5 + v) * 64 + c2];
        float* mod = (float*)(p.ws + OFF_MOD);
        mod[(size_t)(l * 5 + v) * 6144 + cgp * 64 + c2] = s + p.b_mod[l * 6144 + cgp * 64 + c2];
    }
    __syncthreads();
}

__device__ void transpose_tile(const float* src, int ld_src, bf16* dst, int ld_dst, char* smem) {
    float* t = (float*)smem;
    const int tid = otid();
#pragma unroll
    for (int i = 0; i < 8; ++i) { int kk = (tid >> 6) + 8 * i, nn = tid & 63; t[kk * 65 + nn] = src[(size_t)kk * ld_src + nn]; }
    __syncthreads();
    const int nn = tid >> 3, kc = tid & 7;
    uint4 o;
    o.x = pack2(t[(kc * 8 + 0) * 65 + nn], t[(kc * 8 + 1) * 65 + nn]);
    o.y = pack2(t[(kc * 8 + 2) * 65 + nn], t[(kc * 8 + 3) * 65 + nn]);
    o.z = pack2(t[(kc * 8 + 4) * 65 + nn], t[(kc * 8 + 5) * 65 + nn]);
    o.w = pack2(t[(kc * 8 + 6) * 65 + nn], t[(kc * 8 + 7) * 65 + nn]);
    *(uint4*)(dst + (size_t)nn * ld_dst + kc * 8) = o;
    __syncthreads();
}

constexpr int CONV_TILES_LAYER = 2240 + 1024;
__device__ void conv_item(const Params& p, int l, int it, char* smem) {
    bf16* wt = (bf16*)(p.ws + OFF_WT + (size_t)l * WT_LAYER);
    if (it < 2240) {
        int kt = it / 140, nt = it % 140;
        transpose_tile(p.w_in + (size_t)l * 1024 * DIN + (size_t)kt * 64 * DIN + nt * 64, DIN, wt + (size_t)nt * 64 * 1024 + kt * 64, 1024, smem);
    } else {
        int j = it - 2240; int mtx = j >> 8; int r = j & 255; int kt = r >> 4, nt = r & 15;
        const float* src = (mtx == 0 ? p.w_br_ret : mtx == 1 ? p.w_br_swa : mtx == 2 ? p.w_br_ga : p.w_out) + (size_t)l * 1024 * 1024;
        bf16* dst = wt + (size_t)DIN * 1024 + (size_t)mtx * 1024 * 1024;
        transpose_tile(src + (size_t)kt * 64 * 1024 + nt * 64, 1024, dst + (size_t)nt * 64 * 1024 + kt * 64, 1024, smem);
    }
}
constexpr int MOE_CONV_TILES = 16 * 384;
__device__ void moe_conv_item(const Params& p, int l, int it, char* smem) {
    int e = it / 384, r = it % 384;
    bf16* wgu = (bf16*)(p.ws + OFF_WGU) + (size_t)e * 1024 * 1024;
    bf16* wd = (bf16*)(p.ws + OFF_WD) + (size_t)e * 1024 * 512;
    if (r < 256) {
        int up = r >> 7; int q = r & 127; int kt = q >> 3, nt = q & 7;
        const float* src = (up ? p.w_up : p.w_gate) + ((size_t)(l * 16 + e) * 1024 + (size_t)kt * 64) * 512 + nt * 64;
        transpose_tile(src, 512, wgu + (size_t)(nt * 128 + up * 64) * 1024 + kt * 64, 1024, smem);
    } else {
        int q = r - 256; int kt = q >> 4, nt = q & 15;
        const float* src = p.w_down + ((size_t)(l * 16 + e) * 512 + (size_t)kt * 64) * 1024 + nt * 64;
        transpose_tile(src, 1024, wd + (size_t)nt * 64 * 512 + kt * 64, 512, smem);
    }
}

__device__ void phase0(const Params& p, char* smem) {
    const int tid = otid();
    if (blockIdx.x == 0) {
        int* ctl = (int*)(p.ws + OFF_CTL);
        if (tid < 64) ctl[tid] = 0;
        float* rp = (float*)(p.ws + OFF_ROPE);
        for (int i = tid; i < 64 * 32; i += NT) {
            int pos = i >> 5, j = i & 31;
            float fr = powf(10000.f, -(float)j / 32.f); float a = (float)pos * fr;
            rp[i] = cosf(a); rp[2048 + i] = sinf(a);
        }
        for (int i = tid; i < 64 * 16; i += NT) {
            int pos = i >> 4, j = i & 15;
            float fr = powf(10000.f, -(float)j / 16.f); float a = (float)pos * fr;
            rp[4096 + i] = cosf(a); rp[4096 + 1024 + i] = sinf(a);
        }
    }
    const int nitems = 192 + 2 * CONV_TILES_LAYER;
    for (int it = blockIdx.x; it < nitems; it += gridDim.x) {
        if (it < 192) mod_item(p, it, smem);
        else { int j = it - 192; conv_item(p, j / CONV_TILES_LAYER, j % CONV_TILES_LAYER, smem); }
    }
}

__device__ void phase_norm1(const Params& p, int l) {
    const int tid = otid(), wave = tid >> 6, lane = tid & 63;
    const float* mod = (const float*)(p.ws + OFF_MOD);
    float* CX = (float*)(p.ws + OFF_CX);
    const bf16* YB = (const bf16*)(p.ws + OFF_YB);
    bf16* H = (bf16*)(p.ws + OFF_H);
    for (int r = blockIdx.x * 8 + wave; r < TALL; r += gridDim.x * 8) {
        const bool isctx = r >= TLAT; const int v = isctx ? 4 : r / SEQ;
        float4 xv[4];
        if (l == 0) {
            const float* xin = isctx ? p.ctx + (size_t)(r - TLAT) * D : p.x + (size_t)r * D;
#pragma unroll
            for (int j = 0; j < 4; ++j) xv[j] = *(const float4*)(xin + j * 256 + lane * 4);
        } else {
            float* xr = isctx ? CX + (size_t)(r - TLAT) * D : p.out + (size_t)r * D;
            const float* gt2 = mod + (size_t)((l - 1) * 5 + v) * 6144 + 5 * 1024;
#pragma unroll
            for (int j = 0; j < 4; ++j) {
                int col = j * 256 + lane * 4;
                float4 a = *(const float4*)(xr + col); float4 g = *(const float4*)(gt2 + col);
                uint2 y0 = *(const uint2*)(YB + (size_t)(r * 2) * D + col), y1 = *(const uint2*)(YB + (size_t)(r * 2 + 1) * D + col);
                a.x += g.x * (lo2f(y0.x) + lo2f(y1.x)); a.y += g.y * (hi2f(y0.x) + hi2f(y1.x));
                a.z += g.z * (lo2f(y0.y) + lo2f(y1.y)); a.w += g.w * (hi2f(y0.y) + hi2f(y1.y));
                *(float4*)(xr + col) = a; xv[j] = a;
            }
        }
        float ss = 0;
#pragma unroll
        for (int j = 0; j < 4; ++j) ss += xv[j].x * xv[j].x + xv[j].y * xv[j].y + xv[j].z * xv[j].z + xv[j].w * xv[j].w;
        ss = wsum(ss);
        const float rstd = rsqrtf(ss * (1.f / 1024.f) + EPS);
        const float* md = mod + (size_t)(l * 5 + v) * 6144;
#pragma unroll
        for (int j = 0; j < 4; ++j) {
            int col = j * 256 + lane * 4;
            float4 g = *(const float4*)(p.g1 + l * 1024 + col), sh = *(const float4*)(md + col), sc = *(const float4*)(md + 1024 + col);
            float h0 = xv[j].x * rstd * g.x * (1.f + sc.x) + sh.x, h1 = xv[j].y * rstd * g.y * (1.f + sc.y) + sh.y;
            float h2 = xv[j].z * rstd * g.z * (1.f + sc.z) + sh.z, h3 = xv[j].w * rstd * g.w * (1.f + sc.w) + sh.w;
            uint2 o; o.x = pack2(h0, h1); o.y = pack2(h2, h3);
            *(uint2*)(H + (size_t)r * D + col) = o;
        }
    }
}

__device__ void phase_norm2(const Params& p, int l) {
    const int tid = otid(), wave = tid >> 6, lane = tid & 63;
    const float* mod = (const float*)(p.ws + OFF_MOD);
    const float* CX = (const float*)(p.ws + OFF_CX);
    bf16* H = (bf16*)(p.ws + OFF_H);
    int* cnt = (int*)(p.ws + OFF_CTL) + l * 16;
    int* lts = (int*)(p.ws + OFF_LTS);
    float* lw = (float*)(p.ws + OFF_LW);
    const int nrows = (l == 0) ? TALL : TLAT;
    for (int r = blockIdx.x * 8 + wave; r < nrows; r += gridDim.x * 8) {
        const bool isctx = r >= TLAT; const int v = isctx ? 4 : r / SEQ;
        const float* xr = isctx ? CX + (size_t)(r - TLAT) * D : p.out + (size_t)r * D;
        float4 xv[4];
#pragma unroll
        for (int j = 0; j < 4; ++j) xv[j] = *(const float4*)(xr + j * 256 + lane * 4);
        float ss = 0;
#pragma unroll
        for (int j = 0; j < 4; ++j) ss += xv[j].x * xv[j].x + xv[j].y * xv[j].y + xv[j].z * xv[j].z + xv[j].w * xv[j].w;
        ss = wsum(ss);
        const float rstd = rsqrtf(ss * (1.f / 1024.f) + EPS);
        const float* md = mod + (size_t)(l * 5 + v) * 6144;
        float part[16];
#pragma unroll
        for (int e = 0; e < 16; ++e) part[e] = 0.f;
#pragma unroll
        for (int j = 0; j < 4; ++j) {
            int col = j * 256 + lane * 4;
            float4 g = *(const float4*)(p.g2 + l * 1024 + col), sh = *(const float4*)(md + 3072 + col), sc = *(const float4*)(md + 4096 + col);
            float hv[4];
            hv[0] = xv[j].x * rstd * g.x * (1.f + sc.x) + sh.x; hv[1] = xv[j].y * rstd * g.y * (1.f + sc.y) + sh.y;
            hv[2] = xv[j].z * rstd * g.z * (1.f + sc.z) + sh.z; hv[3] = xv[j].w * rstd * g.w * (1.f + sc.w) + sh.w;
            uint2 o; o.x = pack2(hv[0], hv[1]); o.y = pack2(hv[2], hv[3]);
            *(uint2*)(H + (size_t)r * D + col) = o;
#pragma unroll
            for (int i = 0; i < 4; ++i) {
                const float4* wr = (const float4*)(p.w_router + (size_t)(col + i) * 16);
                float4 w0 = wr[0], w1 = wr[1], w2 = wr[2], w3 = wr[3];
                part[0] += hv[i] * w0.x; part[1] += hv[i] * w0.y; part[2] += hv[i] * w0.z; part[3] += hv[i] * w0.w;
                part[4] += hv[i] * w1.x; part[5] += hv[i] * w1.y; part[6] += hv[i] * w1.z; part[7] += hv[i] * w1.w;
                part[8] += hv[i] * w2.x; part[9] += hv[i] * w2.y; part[10] += hv[i] * w2.z; part[11] += hv[i] * w2.w;
                part[12] += hv[i] * w3.x; part[13] += hv[i] * w3.y; part[14] += hv[i] * w3.z; part[15] += hv[i] * w3.w;
            }
        }
#pragma unroll
        for (int e = 0; e < 16; ++e) part[e] = wsum(part[e]);
        if (lane == 0) {
            float s[16], bb[16];
#pragma unroll
            for (int e = 0; e < 16; ++e) { s[e] = sigmoidf_(part[e]); bb[e] = s[e] + p.b_router[e]; }
            float bestscore = -1e30f; int be0 = 0, be1 = 1; float bs0 = 0.f, bs1 = 0.f;
#pragma unroll
            for (int g = 0; g < 4; ++g) {
                int i1 = 0; float m1 = bb[g * 4]; float s1 = s[g * 4];
#pragma unroll
                for (int i = 1; i < 4; ++i) if (bb[g * 4 + i] > m1) { m1 = bb[g * 4 + i]; i1 = i; s1 = s[g * 4 + i]; }
                int i2 = -1; float m2 = -1e30f; float s2 = 0.f;
#pragma unroll
                for (int i = 0; i < 4; ++i) if (i != i1 && bb[g * 4 + i] > m2) { m2 = bb[g * 4 + i]; i2 = i; s2 = s[g * 4 + i]; }
                float gs = m1 + m2;
                if (gs > bestscore) { bestscore = gs; be0 = g * 4 + i1; be1 = g * 4 + i2; bs0 = s1; bs1 = s2; }
            }
            float inv = 1.f / (bs0 + bs1);
            int p0 = atomicAdd(&cnt[be0], 1);
            lts[(size_t)be0 * TALL + p0] = r * 2; lw[(size_t)be0 * TALL + p0] = bs0 * inv;
            int p1 = atomicAdd(&cnt[be1], 1);
            lts[(size_t)be1 * TALL + p1] = r * 2 + 1; lw[(size_t)be1 * TALL + p1] = bs1 * inv;
        }
    }
}

__device__ void phase_final(const Params& p) {
    const int tid = otid(), wave = tid >> 6, lane = tid & 63;
    const float* mod = (const float*)(p.ws + OFF_MOD);
    const bf16* YB = (const bf16*)(p.ws + OFF_YB);
    for (int r = blockIdx.x * 8 + wave; r < TLAT; r += gridDim.x * 8) {
        const int v = r / SEQ;
        float* xr = p.out + (size_t)r * D;
        const float* gt2 = mod + (size_t)(1 * 5 + v) * 6144 + 5 * 1024;
        float4 xv[4];
#pragma unroll
        for (int j = 0; j < 4; ++j) {
            int col = j * 256 + lane * 4;
            float4 a = *(const float4*)(xr + col); float4 g = *(const float4*)(gt2 + col);
            uint2 y0 = *(const uint2*)(YB + (size_t)(r * 2) * D + col), y1 = *(const uint2*)(YB + (size_t)(r * 2 + 1) * D + col);
            a.x += g.x * (lo2f(y0.x) + lo2f(y1.x)); a.y += g.y * (hi2f(y0.x) + hi2f(y1.x));
            a.z += g.z * (lo2f(y0.y) + lo2f(y1.y)); a.w += g.w * (hi2f(y0.y) + hi2f(y1.y));
            xv[j] = a;
        }
        float ss = 0;
#pragma unroll
        for (int j = 0; j < 4; ++j) ss += xv[j].x * xv[j].x + xv[j].y * xv[j].y + xv[j].z * xv[j].z + xv[j].w * xv[j].w;
        ss = wsum(ss);
        const float rstd = rsqrtf(ss * (1.f / 1024.f) + EPS);
#pragma unroll
        for (int j = 0; j < 4; ++j) {
            int col = j * 256 + lane * 4;
            float4 g = *(const float4*)(p.g_final + col);
            float4 o; o.x = xv[j].x * rstd * g.x; o.y = xv[j].y * rstd * g.y; o.z = xv[j].z * rstd * g.z; o.w = xv[j].w * rstd * g.w;
            *(float4*)(xr + col) = o;
        }
    }
}

constexpr int LDS_ROW = 144;
constexpr int A_STAGE = 256 * LDS_ROW;
constexpr int B_STAGE = 128 * LDS_ROW;
constexpr int STAGE = A_STAGE + B_STAGE;
constexpr int GEMM_LDS = 2 * STAGE;
constexpr int CT_LD = 132;

template <int MI>
__device__ __forceinline__ void zero_acc(f32x16 (&acc)[MI][2]) {
#pragma unroll
    for (int a = 0; a < MI; ++a)
#pragma unroll
        for (int b = 0; b < 2; ++b)
#pragma unroll
            for (int r = 0; r < 16; ++r) acc[a][b][r] = 0.f;
}

template <int MI>
__device__ __forceinline__ void gemm_mainloop(f32x16 (&acc)[MI][2], const bf16* ap0, const bf16* ap1, const bf16* ap2, const bf16* ap3,
                                              const bf16* bp0, const bf16* bp1, int K, char* smem) {
    const int tid = otid(), lane = tid & 63, wave = tid >> 6, wm = wave >> 1, wn = wave & 1;
    const int kc = tid & 7, lr = tid >> 3;
    uint4 ra0, ra1, ra2, ra3, rb0, rb1;
    ra0 = *(const uint4*)(ap0 + kc * 8); ra1 = *(const uint4*)(ap1 + kc * 8);
    if (MI == 2) { ra2 = *(const uint4*)(ap2 + kc * 8); ra3 = *(const uint4*)(ap3 + kc * 8); }
    rb0 = *(const uint4*)(bp0 + kc * 8); rb1 = *(const uint4*)(bp1 + kc * 8);
    {
        char* st = smem;
        *(uint4*)(st + (lr) * LDS_ROW + kc * 16) = ra0; *(uint4*)(st + (lr + 64) * LDS_ROW + kc * 16) = ra1;
        if (MI == 2) { *(uint4*)(st + (lr + 128) * LDS_ROW + kc * 16) = ra2; *(uint4*)(st + (lr + 192) * LDS_ROW + kc * 16) = ra3; }
        *(uint4*)(st + A_STAGE + (lr) * LDS_ROW + kc * 16) = rb0; *(uint4*)(st + A_STAGE + (lr + 64) * LDS_ROW + kc * 16) = rb1;
    }
    __syncthreads();
    const int nk = K >> 6;
    const int aoff = (wm * (32 * MI) + (lane & 31)) * LDS_ROW + (lane >> 5) * 16;
    const int boff = A_STAGE + (wn * 64 + (lane & 31)) * LDS_ROW + (lane >> 5) * 16;
    for (int kt = 0; kt < nk; ++kt) {
        char* cur = smem + (kt & 1) * STAGE;
        const bool more = (kt + 1 < nk);
        if (more) {
            const int ko = (kt + 1) * 64 + kc * 8;
            ra0 = *(const uint4*)(ap0 + ko); ra1 = *(const uint4*)(ap1 + ko);
            if (MI == 2) { ra2 = *(const uint4*)(ap2 + ko); ra3 = *(const uint4*)(ap3 + ko); }
            rb0 = *(const uint4*)(bp0 + ko); rb1 = *(const uint4*)(bp1 + ko);
        }
#pragma unroll
        for (int ks = 0; ks < 4; ++ks) {
            bf16x8 b0 = *(const bf16x8*)(cur + boff + ks * 32);
            bf16x8 b1 = *(const bf16x8*)(cur + boff + 32 * LDS_ROW + ks * 32);
#pragma unroll
            for (int mi = 0; mi < MI; ++mi) {
                bf16x8 a0 = *(const bf16x8*)(cur + aoff + mi * 32 * LDS_ROW + ks * 32);
                acc[mi][0] = __builtin_amdgcn_mfma_f32_32x32x16_bf16(a0, b0, acc[mi][0], 0, 0, 0);
                acc[mi][1] = __builtin_amdgcn_mfma_f32_32x32x16_bf16(a0, b1, acc[mi][1], 0, 0, 0);
            }
        }
        if (more) {
            char* st = smem + ((kt + 1) & 1) * STAGE;
            *(uint4*)(st + (lr) * LDS_ROW + kc * 16) = ra0; *(uint4*)(st + (lr + 64) * LDS_ROW + kc * 16) = ra1;
            if (MI == 2) { *(uint4*)(st + (lr + 128) * LDS_ROW + kc * 16) = ra2; *(uint4*)(st + (lr + 192) * LDS_ROW + kc * 16) = ra3; }
            *(uint4*)(st + A_STAGE + (lr) * LDS_ROW + kc * 16) = rb0; *(uint4*)(st + A_STAGE + (lr + 64) * LDS_ROW + kc * 16) = rb1;
        }
        __syncthreads();
    }
}

__device__ __forceinline__ void stage_full(const f32x16 (&acc)[1][2], char* smem) {
    const int tid = otid(), lane = tid & 63, wave = tid >> 6, wm = wave >> 1, wn = wave & 1;
    float* Ct = (float*)smem;
#pragma unroll
    for (int ni = 0; ni < 2; ++ni)
#pragma unroll
        for (int r = 0; r < 16; ++r) {
            int row = wm * 32 + (r & 3) + 8 * (r >> 2) + 4 * (lane >> 5);
            int col = wn * 64 + ni * 32 + (lane & 31);
            Ct[row * CT_LD + col] = acc[0][ni][r];
        }
}

__device__ __forceinline__ void stage_half(const f32x16 (&acc)[2][2], int h, char* smem) {
    const int tid = otid(), lane = tid & 63, wave = tid >> 6, wm = wave >> 1, wn = wave & 1;
    float* Ct = (float*)smem;
    if ((wm >> 1) == h) {
#pragma unroll
        for (int mi = 0; mi < 2; ++mi)
#pragma unroll
            for (int ni = 0; ni < 2; ++ni)
#pragma unroll
                for (int r = 0; r < 16; ++r) {
                    int row = (wm & 1) * 64 + mi * 32 + (r & 3) + 8 * (r >> 2) + 4 * (lane >> 5);
                    int col = wn * 64 + ni * 32 + (lane & 31);
                    Ct[row * CT_LD + col] = acc[mi][ni][r];
                }
    }
}

__device__ __forceinline__ void store32_bf16(bf16* dst, const float (&v)[32]) {
#pragma unroll
    for (int i = 0; i < 4; ++i) {
        uint4 o; o.x = pack2(v[i * 8 + 0], v[i * 8 + 1]); o.y = pack2(v[i * 8 + 2], v[i * 8 + 3]);
        o.z = pack2(v[i * 8 + 4], v[i * 8 + 5]); o.w = pack2(v[i * 8 + 6], v[i * 8 + 7]);
        *(uint4*)(dst + i * 8) = o;
    }
}

__device__ void epi_inproj(const Params& p, int l, const float* Ct, int mrow0, int n0) {
    const int tid = otid(), r = tid >> 2, q = tid & 3;
    const int row = mrow0 + r;
    const bool isctx = row >= TLAT;
    const int t = row & (SEQ - 1);
    const int prow = t >> 6, pcol = t & 63;
    unsigned char* ws = p.ws;
    bf16* dst; int ld, coff, rope = 0; const float* gain = nullptr; float scale = 1.f;
    if (n0 < 512)       { dst = (bf16*)(ws + OFF_QR); ld = 512;  coff = n0;        rope = 128; }
    else if (n0 < 1024) { dst = (bf16*)(ws + OFF_KR); ld = 512;  coff = n0 - 512;  rope = 128; scale = 0.08838834764831845f; }
    else if (n0 < 2048) { dst = (bf16*)(ws + OFF_VR); ld = 1024; coff = n0 - 1024; }
    else if (n0 < 3072) { dst = (bf16*)(ws + OFF_UR); ld = 1024; coff = n0 - 2048; }
    else if (n0 < 4096) { dst = (bf16*)(ws + OFF_QS); ld = 1024; coff = n0 - 3072; rope = 64; scale = 0.125f; }
    else if (n0 < 4224) { dst = (bf16*)(ws + OFF_KS); ld = 128;  coff = 0;         rope = 64; }
    else if (n0 < 4352) { dst = (bf16*)(ws + OFF_VS); ld = 128;  coff = 0; }
    else if (n0 < 5376) { dst = (bf16*)(ws + OFF_QA); ld = 1024; coff = n0 - 4352; rope = 128; gain = p.gq + l * 128; scale = 0.08838834764831845f; }
    else if (n0 < 5632) { dst = (bf16*)(ws + OFF_KA); ld = 256;  coff = n0 - 5376; rope = 128; gain = p.gk + l * 128; }
    else                { dst = (bf16*)(ws + OFF_VA); ld = 256;  coff = n0 - 5632; }
    if (isctx) rope = 0;
    const float* rp = (const float*)(ws + OFF_ROPE);
    const float* src = Ct + r * CT_LD + 32 * q;
    float rstd = 1.f;
    if (gain) {
        float ss = 0;
#pragma unroll 8
        for (int j = 0; j < 32; ++j) ss += src[j] * src[j];
        ss += __shfl_xor(ss, 1, 64); ss += __shfl_xor(ss, 2, 64);
        rstd = rsqrtf(ss * (1.f / 128.f) + EPS);
    }
    bf16* drow = dst + (size_t)row * ld + coff + 32 * q;
#pragma unroll 1
    for (int c = 0; c < 4; ++c) {
        float v[8], o[8];
#pragma unroll
        for (int j = 0; j < 8; ++j) v[j] = src[c * 8 + j];
        if (gain) {
#pragma unroll
            for (int j = 0; j < 8; ++j) v[j] = v[j] * rstd * gain[32 * q + c * 8 + j];
        }
        if (rope == 128) {
            const float* psrc = Ct + r * CT_LD + 32 * (q ^ 1) + c * 8;
            const int pos = (q >> 1) ? pcol : prow;
            const float* cs = rp + pos * 32 + c * 8; const float* sn = rp + 2048 + pos * 32 + c * 8;
#pragma unroll
            for (int j = 0; j < 8; ++j) {
                float pv = psrc[j];
                if (gain) pv = pv * rstd * gain[32 * (q ^ 1) + c * 8 + j];
                float cc = cs[j], sv = sn[j];
                o[j] = (q & 1) ? (pv * sv + v[j] * cc) : (v[j] * cc - pv * sv);
            }
        } else if (rope == 64) {
            const float* psrc = src + ((c ^ 2) * 8);
            const int pos = (q & 1) ? pcol : prow;
            const float* cs = rp + 4096 + pos * 16 + (c & 1) * 8; const float* sn = rp + 4096 + 1024 + pos * 16 + (c & 1) * 8;
#pragma unroll
            for (int j = 0; j < 8; ++j) {
                float pv = psrc[j];
                float cc = cs[j], sv = sn[j];
                o[j] = (c < 2) ? (v[j] * cc - pv * sv) : (pv * sv + v[j] * cc);
            }
        } else {
#pragma unroll
            for (int j = 0; j < 8; ++j) o[j] = v[j];
        }
        uint4 ov;
        ov.x = pack2(o[0] * scale, o[1] * scale); ov.y = pack2(o[2] * scale, o[3] * scale);
        ov.z = pack2(o[4] * scale, o[5] * scale); ov.w = pack2(o[6] * scale, o[7] * scale);
        *(uint4*)(drow + c * 8) = ov;
    }
}

__device__ void epi_plain_bf16(const float* Ct, bf16* dst, int ld, int mrow0, int n0) {
    const int tid = otid(), r = tid >> 2, q = tid & 3;
    float v[32];
    const float* src = Ct + r * CT_LD + 32 * q;
#pragma unroll
    for (int j = 0; j < 32; ++j) v[j] = src[j];
    store32_bf16(dst + (size_t)(mrow0 + r) * ld + n0 + 32 * q, v);
}

__device__ void epi_outproj(const Params& p, int l, const float* Ct, int mrow0, int n0) {
    const int tid = otid(), r = tid >> 2, q = tid & 3;
    const int row = mrow0 + r;
    const bool isctx = row >= TLAT; const int v = isctx ? 4 : row / SEQ;
    const float* gt = (const float*)(p.ws + OFF_MOD) + (size_t)(l * 5 + v) * 6144 + 2048 + n0 + 32 * q;
    float* CX = (float*)(p.ws + OFF_CX);
    const float* xin; float* xo;
    if (isctx) { xo = CX + (size_t)(row - TLAT) * D + n0 + 32 * q; xin = (l == 0) ? p.ctx + (size_t)(row - TLAT) * D + n0 + 32 * q : xo; }
    else { xo = p.out + (size_t)row * D + n0 + 32 * q; xin = (l == 0) ? p.x + (size_t)row * D + n0 + 32 * q : xo; }
    const float* src = Ct + r * CT_LD + 32 * q;
#pragma unroll
    for (int i = 0; i < 8; ++i) {
        float4 a = *(const float4*)(xin + i * 4); float4 g = *(const float4*)(gt + i * 4);
        a.x += g.x * src[i * 4 + 0]; a.y += g.y * src[i * 4 + 1]; a.z += g.z * src[i * 4 + 2]; a.w += g.w * src[i * 4 + 3];
        *(float4*)(xo + i * 4) = a;
    }
}

__device__ void phase_inproj(const Params& p, int l, char* smem) {
    const int tid = otid(), lr = tid >> 3;
    const bf16* H = (const bf16*)(p.ws + OFF_H);
    const bf16* Wt = (const bf16*)(p.ws + OFF_WT + (size_t)l * WT_LAYER);
    constexpr int NTN = DQKV / 128;
    constexpr int NTM = TALL / 256;
    for (int t = blockIdx.x; t < NTM * NTN; t += gridDim.x) {
        const int mt = t / NTN, nt = t % NTN;
        const int m0 = mt * 256, n0 = nt * 128;
        f32x16 acc[2][2]; zero_acc<2>(acc);
        const bf16* a = H + (size_t)(m0 + lr) * 1024;
        const bf16* b = Wt + (size_t)(n0 + lr) * 1024;
        gemm_mainloop<2>(acc, a, a + 64 * 1024, a + 128 * 1024, a + 192 * 1024, b, b + 64 * 1024, 1024, smem);
        for (int h = 0; h < 2; ++h) {
            stage_half(acc, h, smem);
            __syncthreads();
            epi_inproj(p, l, (const float*)smem, m0 + h * 128, n0);
            __syncthreads();
        }
    }
}

__device__ void phase_merge(const Params& p, int l, char* smem) {
    const int tid = otid(), lr = tid >> 3;
    const bf16* H = (const bf16*)(p.ws + OFF_H);
    const bf16* Wt = (const bf16*)(p.ws + OFF_WT + (size_t)l * WT_LAYER);
    bf16* Y = (bf16*)(p.ws + OFF_Y);
    const int M = (l == 0) ? TALL : TLAT;
    const int ntm = M / 128;
    for (int t = blockIdx.x; t < ntm * 8; t += gridDim.x) {
        const int mt = t >> 3, nt = t & 7;
        const int m0 = mt * 128, n0 = nt * 128;
        f32x16 yacc[1][2]; zero_acc<1>(yacc);
#pragma unroll 1
        for (int br = 0; br < 3; ++br) {
            unsigned gp[2][8];
            {
                f32x16 acc[1][2]; zero_acc<1>(acc);
                const bf16* a = H + (size_t)(m0 + lr) * 1024;
                const bf16* b = Wt + (size_t)(DQKV + br * 1024 + n0 + lr) * 1024;
                gemm_mainloop<1>(acc, a, a + 64 * 1024, a, a, b, b + 64 * 1024, 1024, smem);
#pragma unroll
                for (int ni = 0; ni < 2; ++ni)
#pragma unroll
                    for (int r = 0; r < 8; ++r) gp[ni][r] = pack2(sigmoidf_(acc[0][ni][2 * r]), sigmoidf_(acc[0][ni][2 * r + 1]));
            }
            {
                f32x16 acc[1][2]; zero_acc<1>(acc);
                const bf16* O = (const bf16*)(p.ws + (br == 0 ? OFF_UR : br == 1 ? OFF_QS : OFF_QA));
                const bf16* a = O + (size_t)(m0 + lr) * 1024;
                const bf16* b = Wt + (size_t)DIN * 1024 + (size_t)br * 1024 * 1024 + (size_t)(n0 + lr) * 1024;
                gemm_mainloop<1>(acc, a, a + 64 * 1024, a, a, b, b + 64 * 1024, 1024, smem);
#pragma unroll
                for (int ni = 0; ni < 2; ++ni)
#pragma unroll
                    for (int r = 0; r < 8; ++r) {
                        yacc[0][ni][2 * r] += lo2f(gp[ni][r]) * acc[0][ni][2 * r];
                        yacc[0][ni][2 * r + 1] += hi2f(gp[ni][r]) * acc[0][ni][2 * r + 1];
                    }
            }
        }
        stage_full(yacc, smem);
        __syncthreads();
        epi_plain_bf16((const float*)smem, Y, 1024, m0, n0);
        __syncthreads();
    }
}

__device__ void phase_outproj(const Params& p, int l, char* smem) {
    const int tid = otid(), lr = tid >> 3;
    const bf16* Y = (const bf16*)(p.ws + OFF_Y);
    const bf16* Wt = (const bf16*)(p.ws + OFF_WT + (size_t)l * WT_LAYER) + (size_t)DIN * 1024 + (size_t)3 * 1024 * 1024;
    const int M = (l == 0) ? TALL : TLAT;
    const int ntm = M / 256;
    for (int t = blockIdx.x; t < ntm * 8; t += gridDim.x) {
        const int mt = t >> 3, nt = t & 7;
        const int m0 = mt * 256, n0 = nt * 128;
        f32x16 acc[2][2]; zero_acc<2>(acc);
        const bf16* a = Y + (size_t)(m0 + lr) * 1024;
        const bf16* b = Wt + (size_t)(n0 + lr) * 1024;
        gemm_mainloop<2>(acc, a, a + 64 * 1024, a + 128 * 1024, a + 192 * 1024, b, b + 64 * 1024, 1024, smem);
        for (int h = 0; h < 2; ++h) {
            stage_half(acc, h, smem);
            __syncthreads();
            epi_outproj(p, l, (const float*)smem, m0 + h * 128, n0);
            __syncthreads();
        }
    }
}

__device__ __forceinline__ bool moe_find(const int* cnt, int tile, int& e, int& mt, int& rowbase, int& ce) {
    int acc_t = 0, acc_r = 0;
    for (int i = 0; i < 16; ++i) {
        int c = cnt[i]; int nt = (c + 255) >> 8;
        if (tile < acc_t + nt) { e = i; mt = tile - acc_t; rowbase = acc_r; ce = c; return true; }
        acc_t += nt; acc_r += c;
    }
    return false;
}

__device__ void phase_moe1(const Params& p, int l, char* smem) {
    const int tid = otid(), lr = tid >> 3;
    const int* cnt = (const int*)(p.ws + OFF_CTL) + l * 16;
    const int* lts = (const int*)(p.ws + OFF_LTS);
    const bf16* H = (const bf16*)(p.ws + OFF_H);
    bf16* HB = (bf16*)(p.ws + OFF_HB);
    int total = 0;
    for (int i = 0; i < 16; ++i) total += (cnt[i] + 255) >> 8;
    for (int t = blockIdx.x; t < total * 8; t += gridDim.x) {
        const int tile = t >> 3, nt = t & 7;
        int e, mt, rowbase, ce;
        moe_find(cnt, tile, e, mt, rowbase, ce);
        const int* le = lts + (size_t)e * TALL;
        const bf16* ap[4];
#pragma unroll
        for (int i = 0; i < 4; ++i) {
            int idx = mt * 256 + lr + 64 * i; if (idx >= ce) idx = ce - 1;
            ap[i] = H + (size_t)(le[idx] >> 1) * 1024;
        }
        const bf16* b = (const bf16*)(p.ws + OFF_WGU) + (size_t)e * 1024 * 1024 + (size_t)(nt * 128 + lr) * 1024;
        f32x16 acc[2][2]; zero_acc<2>(acc);
        gemm_mainloop<2>(acc, ap[0], ap[1], ap[2], ap[3], b, b + 64 * 1024, 1024, smem);
        for (int h = 0; h < 2; ++h) {
            stage_half(acc, h, smem);
            __syncthreads();
            {
                const float* Ct = (const float*)smem;
                const int r = tid >> 2, q = tid & 3;
                const int idx = mt * 256 + h * 128 + r;
                if (idx < ce) {
                    const float* src = Ct + r * CT_LD;
                    uint4 o0, o1; float hv[16];
#pragma unroll
                    for (int j = 0; j < 16; ++j) { float g = src[16 * q + j], u = src[64 + 16 * q + j]; hv[j] = siluf_(g) * u; }
                    o0.x = pack2(hv[0], hv[1]); o0.y = pack2(hv[2], hv[3]); o0.z = pack2(hv[4], hv[5]); o0.w = pack2(hv[6], hv[7]);
                    o1.x = pack2(hv[8], hv[9]); o1.y = pack2(hv[10], hv[11]); o1.z = pack2(hv[12], hv[13]); o1.w = pack2(hv[14], hv[15]);
                    bf16* d = HB + (size_t)(rowbase + idx) * 512 + nt * 64 + 16 * q;
                    *(uint4*)d = o0; *(uint4*)(d + 8) = o1;
                }
            }
            __syncthreads();
        }
    }
}

__device__ void phase_moe2(const Params& p, int l, char* smem) {
    const int tid = otid(), lr = tid >> 3;
    const int* cnt = (const int*)(p.ws + OFF_CTL) + l * 16;
    const int* lts = (const int*)(p.ws + OFF_LTS);
    const float* lw = (const float*)(p.ws + OFF_LW);
    const bf16* HB = (const bf16*)(p.ws + OFF_HB);
    bf16* YB = (bf16*)(p.ws + OFF_YB);
    int total = 0;
    for (int i = 0; i < 16; ++i) total += (cnt[i] + 255) >> 8;
    for (int t = blockIdx.x; t < total * 8; t += gridDim.x) {
        const int tile = t >> 3, nt = t & 7;
        int e, mt, rowbase, ce;
        moe_find(cnt, tile, e, mt, rowbase, ce);
        const bf16* ap[4];
#pragma unroll
        for (int i = 0; i < 4; ++i) {
            int idx = mt * 256 + lr + 64 * i; if (idx >= ce) idx = ce - 1;
            ap[i] = HB + (size_t)(rowbase + idx) * 512;
        }
        const bf16* b = (const bf16*)(p.ws + OFF_WD) + (size_t)e * 1024 * 512 + (size_t)(nt * 128 + lr) * 512;
        f32x16 acc[2][2]; zero_acc<2>(acc);
        gemm_mainloop<2>(acc, ap[0], ap[1], ap[2], ap[3], b, b + 64 * 512, 512, smem);
        for (int h = 0; h < 2; ++h) {
            stage_half(acc, h, smem);
            __syncthreads();
            {
                const float* Ct = (const float*)smem;
                const int r = tid >> 2, q = tid & 3;
                const int idx = mt * 256 + h * 128 + r;
                if (idx < ce) {
                    const int ts = lts[(size_t)e * TALL + idx]; const float w = lw[(size_t)e * TALL + idx];
                    const float* src = Ct + r * CT_LD + 32 * q;
                    float v[32];
#pragma unroll
                    for (int j = 0; j < 32; ++j) v[j] = src[j] * w;
                    store32_bf16(YB + (size_t)ts * 1024 + nt * 128 + 32 * q, v);
                }
            }
            __syncthreads();
        }
    }
}

__device__ __forceinline__ void unpack8(uint4 u, float (&f)[8]) {
    f[0] = lo2f(u.x); f[1] = hi2f(u.x); f[2] = lo2f(u.y); f[3] = hi2f(u.y); f[4] = lo2f(u.z); f[5] = hi2f(u.z); f[6] = lo2f(u.w); f[7] = hi2f(u.w);
}

__device__ void ga_naive_item(const Params& p, int item, char* smem) {
    const int tid = otid(), wave = tid >> 6, lane = tid & 63;
    float* qs = (float*)smem;
    float* inv = qs + 512;
    float* sc = qs + 528;
    bf16* QA = (bf16*)(p.ws + OFF_QA); const bf16* KA = (const bf16*)(p.ws + OFF_KA); const bf16* VA = (const bf16*)(p.ws + OFF_VA);
    int b, kvh, qrow, nkeys, keybase_lat, keybase_ctx, nlat;
    if (item < 32768) { b = item >> 13; kvh = (item >> 12) & 1; int n = item & 4095; qrow = b * SEQ + n; nkeys = 4352; nlat = 4096; }
    else { int j = item - 32768; b = j >> 9; kvh = (j >> 8) & 1; int n = j & 255; qrow = TLAT + b * CTXL + n; nkeys = 256; nlat = 0; }
    keybase_lat = b * SEQ; keybase_ctx = TLAT + b * CTXL;
    qs[tid] = bf2f(QA[(size_t)qrow * 1024 + kvh * 512 + tid]);
    __syncthreads();
    for (int m = tid; m < nkeys; m += NT) {
        const int krow = m < nlat ? keybase_lat + m : keybase_ctx + (m - nlat);
        const uint4* kp = (const uint4*)(KA + (size_t)krow * 256 + kvh * 128);
        float d0 = 0, d1 = 0, d2 = 0, d3 = 0;
#pragma unroll 4
        for (int c = 0; c < 16; ++c) {
            float kf[8]; unpack8(kp[c], kf);
#pragma unroll
            for (int j = 0; j < 8; ++j) { d0 += qs[c * 8 + j] * kf[j]; d1 += qs[128 + c * 8 + j] * kf[j]; d2 += qs[256 + c * 8 + j] * kf[j]; d3 += qs[384 + c * 8 + j] * kf[j]; }
        }
        sc[m] = d0; sc[4352 + m] = d1; sc[2 * 4352 + m] = d2; sc[3 * 4352 + m] = d3;
    }
    __syncthreads();
    if (wave < 4) {
        float* s = sc + wave * 4352;
        float mx = -1e30f;
        for (int m = lane; m < nkeys; m += 64) mx = fmaxf(mx, s[m]);
        mx = wmax(mx);
        float sum = 0;
        for (int m = lane; m < nkeys; m += 64) { float e = expf(s[m] - mx); s[m] = e; sum += e; }
        sum = wsum(sum);
        if (lane == 0) inv[wave] = 1.f / sum;
    }
    __syncthreads();
    {
        const int head = tid >> 7, d = tid & 127;
        const float* s = sc + head * 4352;
        float acc = 0;
        for (int m = 0; m < nkeys; ++m) {
            const int krow = m < nlat ? keybase_lat + m : keybase_ctx + (m - nlat);
            acc += s[m] * bf2f(VA[(size_t)krow * 256 + kvh * 128 + d]);
        }
        QA[(size_t)qrow * 1024 + kvh * 512 + tid] = f2bf(acc * inv[head]);
    }
    __syncthreads();
}

__device__ void swa_naive_item(const Params& p, int l, int item, char* smem) {
    const int tid = otid(), wave = tid >> 6, lane = tid & 63;
    float* qs = (float*)smem;
    float* inv = qs + 512;
    float* sc = qs + 528;
    bf16* QS = (bf16*)(p.ws + OFF_QS); const bf16* KS = (const bf16*)(p.ws + OFF_KS); const bf16* VS = (const bf16*)(p.ws + OFF_VS);
    int b, kvh, qrow, nl, lo;
    if (item < 32768) { b = item >> 13; kvh = (item >> 12) & 1; int n = item & 4095; qrow = b * SEQ + n; lo = n - 128 < 0 ? 0 : n - 128; int hi = n + 128 > SEQ - 1 ? SEQ - 1 : n + 128; nl = hi - lo + 1; }
    else { int j = item - 32768; b = j >> 9; kvh = (j >> 8) & 1; int n = j & 255; qrow = TLAT + b * CTXL + n; nl = 0; lo = 0; }
    const int ntot = nl + 256;
    const int kb_lat = b * SEQ + lo, kb_ctx = TLAT + b * CTXL;
    qs[tid] = bf2f(QS[(size_t)qrow * 1024 + kvh * 512 + tid]);
    __syncthreads();
    for (int kk = tid; kk < ntot; kk += NT) {
        const int krow = kk < nl ? kb_lat + kk : kb_ctx + (kk - nl);
        const uint4* kp = (const uint4*)(KS + (size_t)krow * 128 + kvh * 64);
        uint4 kr[8];
#pragma unroll
        for (int c = 0; c < 8; ++c) kr[c] = kp[c];
#pragma unroll 1
        for (int h = 0; h < 8; ++h) {
            float dd = 0.f;
            const float* qh = qs + h * 64;
#pragma unroll
            for (int c = 0; c < 8; ++c) {
                float kf[8]; unpack8(kr[c], kf);
#pragma unroll
                for (int j = 0; j < 8; ++j) dd += qh[c * 8 + j] * kf[j];
            }
            sc[h * 520 + kk] = dd;
        }
    }
    __syncthreads();
    {
        float* s = sc + wave * 520;
        const float sk = p.sink[l * 16 + kvh * 8 + wave];
        float mx = sk;
        for (int m = lane; m < ntot; m += 64) mx = fmaxf(mx, s[m]);
        mx = wmax(mx);
        float sum = 0;
        for (int m = lane; m < ntot; m += 64) { float e = expf(s[m] - mx); s[m] = e; sum += e; }
        sum = wsum(sum) + expf(sk - mx);
        if (lane == 0) inv[wave] = 1.f / sum;
    }
    __syncthreads();
    {
        const int head = tid >> 6, d = tid & 63;
        const float* s = sc + head * 520;
        float acc = 0;
        for (int kk = 0; kk < ntot; ++kk) {
            const int krow = kk < nl ? kb_lat + kk : kb_ctx + (kk - nl);
            acc += s[kk] * bf2f(VS[(size_t)krow * 128 + kvh * 64 + d]);
        }
        QS[(size_t)qrow * 1024 + kvh * 512 + tid] = f2bf(acc * inv[head]);
    }
    __syncthreads();
}

__device__ void ret_naive_item(const Params& p, int l, int item, char* smem) {
    const int tid = otid(), wave = tid >> 6, lane = tid & 63;
    float* qs = (float*)smem;
    float* red = qs + 128;
    float* sc = qs + 528;
    const bf16* QR = (const bf16*)(p.ws + OFF_QR); const bf16* KR = (const bf16*)(p.ws + OFF_KR); const bf16* VR = (const bf16*)(p.ws + OFF_VR);
    bf16* UR = (bf16*)(p.ws + OFF_UR);
    int b, h, n, qrow, nkeys, nlat; bool isctx;
    if (item < 65536) { b = item >> 14; h = (item >> 12) & 3; n = item & 4095; qrow = b * SEQ + n; nkeys = 4352; nlat = 4096; isctx = false; }
    else { int j = item - 65536; b = j >> 10; h = (j >> 8) & 3; n = j & 255; qrow = TLAT + b * CTXL + n; nkeys = 256; nlat = 0; isctx = true; }
    const float xf = p.ret_logit[l * 8 + h], xb = p.ret_logit[l * 8 + 4 + h];
    const float lgf = -log1pf(expf(-xf)), lgb = -log1pf(expf(-xb));
    const int kb_lat = b * SEQ, kb_ctx = TLAT + b * CTXL;
    if (tid < 128) qs[tid] = bf2f(QR[(size_t)qrow * 512 + h * 128 + tid]);
    __syncthreads();
    for (int m = tid; m < nkeys; m += NT) {
        const int krow = m < nlat ? kb_lat + m : kb_ctx + (m - nlat);
        const uint4* kp = (const uint4*)(KR + (size_t)krow * 512 + h * 128);
        float d0 = 0;
#pragma unroll 4
        for (int c = 0; c < 16; ++c) {
            float kf[8]; unpack8(kp[c], kf);
#pragma unroll
            for (int j = 0; j < 8; ++j) d0 += qs[c * 8 + j] * kf[j];
        }
        float dec;
        if (isctx) { int dd = n - m; dec = dd >= 0 ? expf((float)dd * lgf) : expf((float)(-dd) * lgb); }
        else if (m < nlat) { int dd = n - m; dec = dd >= 0 ? expf((float)dd * lgf) : expf((float)(-dd) * lgb); }
        else { int j = m - nlat; dec = expf((float)(n + 256 - j) * lgf) + expf((float)(SEQ - n + j) * lgb); }
        sc[m] = d0 * dec;
    }
    __syncthreads();
    const int e = tid & 255, half = tid >> 8;
    float acc = 0;
    {
        const int mh = nkeys >> 1;
        for (int m = half * mh; m < half * mh + mh; ++m) {
            const int krow = m < nlat ? kb_lat + m : kb_ctx + (m - nlat);
            acc += sc[m] * bf2f(VR[(size_t)krow * 1024 + h * 256 + e]);
        }
    }
    if (half == 1) red[e] = acc;
    __syncthreads();
    float ss = 0;
    if (half == 0) { acc += red[e]; ss = acc * acc; }
    ss = wsum(ss);
    if (lane == 0) red[256 + wave] = ss;
    __syncthreads();
    if (half == 0) {
        float tot = red[256] + red[257] + red[258] + red[259];
        float rstd = rsqrtf(tot * (1.f / 256.f) + EPS);
        size_t idx = (size_t)qrow * 1024 + h * 256 + e;
        float u = bf2f(UR[idx]);
        UR[idx] = f2bf(acc * rstd * siluf_(u));
    }
    __syncthreads();
}

__device__ void phase_mixers_naive(const Params& p, int l, char* smem) {
    const int n_ga = 32768 + (l == 0 ? 2048 : 0);
    const int n_sw = n_ga;
    const int n_rt = 65536 + (l == 0 ? 4096 : 0);
    const int total = n_ga + n_sw + n_rt;
    for (int it = blockIdx.x; it < total; it += gridDim.x) {
        if (it < n_ga) ga_naive_item(p, it, smem);
        else if (it < n_ga + n_sw) swa_naive_item(p, l, it - n_ga, smem);
        else ret_naive_item(p, l, it - n_ga - n_sw, smem);
    }
}

constexpr int NPHASE = 18;
constexpr int LDS_BYTES = GEMM_LDS;

__device__ void run_phase(const Params& p, int ph, char* smem) {
#ifndef PHASE_MASK
    if (ph == 0) { phase0(p, smem); return; }
    if (ph == 17) { phase_final(p); return; }
#else
    if (ph == 0 || ph == 17) return;
#endif
    const int l = (ph - 1) >> 3, s = (ph - 1) & 7;
#ifdef PHASE_MASK
    if (!((PHASE_MASK >> s) & 1)) return;
#endif
    switch (s) {
        case 0: phase_norm1(p, l); break;
        case 1: phase_inproj(p, l, smem); break;
        case 2: phase_mixers_naive(p, l, smem); break;
        case 3: phase_merge(p, l, smem); break;
        case 4: phase_outproj(p, l, smem); break;
        case 5: {
            phase_norm2(p, l);
            for (int it = blockIdx.x; it < MOE_CONV_TILES; it += gridDim.x) moe_conv_item(p, l, it, smem);
        } break;
        case 6: phase_moe1(p, l, smem); break;
        case 7: phase_moe2(p, l, smem); break;
    }
}

__global__ void __launch_bounds__(NT, 2) mega(Params p) {
    extern __shared__ __attribute__((aligned(16))) char smem[];
    cg::grid_group grid = cg::this_grid();
    for (int ph = p.ph_lo; ph < p.ph_hi; ++ph) {
        run_phase(p, ph, smem);
        if (ph + 1 < p.ph_hi) grid.sync();
    }
}

extern "C" void kernel_launch(void* const* d_in, const int* in_sizes, int n_in, void* d_out, int out_size, void* d_ws, size_t ws_size,
                              hipStream_t stream) {
    static int grid_blocks = 0;
    if (!grid_blocks) {
        int dev = 0, cus = 0, per_cu = 0;
        hipGetDevice(&dev);
        hipDeviceGetAttribute(&cus, hipDeviceAttributeMultiprocessorCount, dev);
        hipFuncSetAttribute((const void*)mega, hipFuncAttributeMaxDynamicSharedMemorySize, LDS_BYTES);
        hipOccupancyMaxActiveBlocksPerMultiprocessor(&per_cu, (const void*)mega, NT, LDS_BYTES);
        if (per_cu < 1) { fprintf(stderr, "occupancy query returned %d\n", per_cu); per_cu = 1; }
        if (per_cu > 1) per_cu = 1;
        grid_blocks = cus * per_cu;
        if (ws_size < WS_END) fprintf(stderr, "workspace too small: %zu < %zu\n", ws_size, (size_t)WS_END);
    }
    Params p{};
    const float** f = (const float**)&p;
    for (int i = 0; i < 23; ++i) f[i] = (const float*)d_in[i];
    p.out = (float*)d_out; p.ws = (unsigned char*)d_ws;
#if MULTI_LAUNCH
    for (int ph = 0; ph < NPHASE; ++ph) {
        p.ph_lo = ph; p.ph_hi = ph + 1;
        hipLaunchKernelGGL(mega, dim3(grid_blocks), dim3(NT), LDS_BYTES, stream, p);
    }
#else
    p.ph_lo = 0; p.ph_hi = NPHASE;
    void* args[] = {&p};
    hipError_t e = hipLaunchCooperativeKernel((const void*)mega, dim3(grid_blocks), dim3(NT), args, LDS_BYTES, stream);
    if (e != hipSuccess) fprintf(stderr, "cooperative launch failed: %s (grid %d)\n", hipGetErrorString(e), grid_blocks);
#endif
}
```

```cpp
#include <hip/hip_runtime.h>
#include <hip/hip_cooperative_groups.h>
#include <cstdio>
#include <cstdint>
namespace cg = cooperative_groups;

#ifndef MULTI_LAUNCH
#define MULTI_LAUNCH 0
#endif

typedef unsigned short bf16;
typedef __attribute__((ext_vector_type(8))) short bf16x8;
typedef __attribute__((ext_vector_type(16))) float f32x16;

constexpr int NT = 512;
constexpr int D = 1024, NB = 4, SEQ = 4096, CTXL = 256;
constexpr int TLAT = NB * SEQ, TCTX = NB * CTXL, TALL = TLAT + TCTX;
constexpr int DIN = 8960, DQKV = 5888;
constexpr int NEXP = 16, DEXP = 512;
constexpr float EPS = 1e-6f;

constexpr size_t OFF_CTL  = 0;
constexpr size_t OFF_LTS  = 4096;
constexpr size_t OFF_LW   = OFF_LTS + (size_t)16 * TALL * 4;
constexpr size_t OFF_MOD  = OFF_LW + (size_t)16 * TALL * 4;
constexpr size_t OFF_ROPE = OFF_MOD + (size_t)2 * 5 * 6144 * 4;
constexpr size_t OFF_CX   = OFF_ROPE + 32768;
constexpr size_t OFF_H    = OFF_CX + (size_t)TCTX * D * 4;
constexpr size_t OFF_QR   = OFF_H + (size_t)TALL * 1024 * 2;
constexpr size_t OFF_KR   = OFF_QR + (size_t)TALL * 512 * 2;
constexpr size_t OFF_VR   = OFF_KR + (size_t)TALL * 512 * 2;
constexpr size_t OFF_UR   = OFF_VR + (size_t)TALL * 1024 * 2;
constexpr size_t OFF_QS   = OFF_UR + (size_t)TALL * 1024 * 2;
constexpr size_t OFF_KS   = OFF_QS + (size_t)TALL * 1024 * 2;
constexpr size_t OFF_VS   = OFF_KS + (size_t)TALL * 128 * 2;
constexpr size_t OFF_QA   = OFF_VS + (size_t)TALL * 128 * 2;
constexpr size_t OFF_KA   = OFF_QA + (size_t)TALL * 1024 * 2;
constexpr size_t OFF_VA   = OFF_KA + (size_t)TALL * 256 * 2;
constexpr size_t OFF_F    = OFF_VA + (size_t)TALL * 256 * 2;
constexpr size_t F_BYTES  = (size_t)71303168;
constexpr size_t OFF_WT   = OFF_F + F_BYTES;
constexpr size_t WT_LAYER = ((size_t)DIN * 1024 + 4 * 1024 * 1024) * 2;
constexpr size_t OFF_KFT  = OFF_WT + WT_LAYER;
constexpr size_t OFF_KBT  = OFF_KFT + (size_t)16 * 128 * 4352 * 2;
constexpr size_t OFF_SM   = OFF_KBT + (size_t)16 * 128 * 4352 * 2;
constexpr int MAXBLK = 320;
constexpr size_t WS_END   = OFF_SM + (size_t)MAXBLK * 128 * 128 * 2;
constexpr int KEYS = 4352;
constexpr size_t OFF_Y    = OFF_QR;
constexpr size_t OFF_HB   = OFF_VR;
constexpr size_t OFF_YB   = OFF_QS;
constexpr size_t OFF_WGU  = OFF_F;
constexpr size_t OFF_WD   = OFF_F + (size_t)16 * 1024 * 1024 * 2;

struct Params {
    const float *x, *c, *ctx, *c_ctx, *w_mod, *b_mod, *g1, *g2, *w_in, *ret_logit, *sink, *gq, *gk,
                *w_br_ret, *w_br_swa, *w_br_ga, *w_out, *w_router, *b_router, *w_gate, *w_up, *w_down, *g_final;
    float* out;
    unsigned char* ws;
    int ph_lo, ph_hi;
};

__device__ __forceinline__ int otid() { int t = threadIdx.x; asm volatile("" : "+v"(t)); return t; }
__device__ __forceinline__ bf16 f2bf(float f) { unsigned u = __float_as_uint(f); u += 0x7fffu + ((u >> 16) & 1u); return (bf16)(u >> 16); }
__device__ __forceinline__ float bf2f(bf16 h) { return __uint_as_float(((unsigned)h) << 16); }
__device__ __forceinline__ unsigned pack2(float a, float b) { return (unsigned)f2bf(a) | ((unsigned)f2bf(b) << 16); }
__device__ __forceinline__ float lo2f(unsigned u) { return __uint_as_float(u << 16); }
__device__ __forceinline__ float hi2f(unsigned u) { return __uint_as_float(u & 0xffff0000u); }
__device__ __forceinline__ float wsum(float v) {
#pragma unroll
    for (int o = 32; o > 0; o >>= 1) v += __shfl_xor(v, o, 64);
    return v;
}
__device__ __forceinline__ float wmax(float v) {
#pragma unroll
    for (int o = 32; o > 0; o >>= 1) v = fmaxf(v, __shfl_xor(v, o, 64));
    return v;
}
__device__ __forceinline__ float sigmoidf_(float x) { return 1.f / (1.f + expf(-x)); }
__device__ __forceinline__ float siluf_(float x) { return x / (1.f + expf(-x)); }

__device__ void mod_item(const Params& p, int item, char* smem) {
    float* sc = (float*)smem;
    float* red = sc + 5 * 1024;
    const int tid = otid();
    for (int i = tid; i < 5 * 1024; i += NT) {
        int v = i >> 10, k = i & 1023;
        float xv = v < 4 ? p.c[v * 1024 + k] : p.c_ctx[k];
        sc[i] = siluf_(xv);
    }
    __syncthreads();
    const int l = item / 96, cgp = item % 96, cc = tid & 63, ks = tid >> 6;
    const float* w = p.w_mod + (size_t)l * 1024 * 6144 + cgp * 64 + cc;
    float a0 = 0, a1 = 0, a2 = 0, a3 = 0, a4 = 0;
    for (int k = ks * 128; k < ks * 128 + 128; ++k) {
        float wv = w[(size_t)k * 6144];
        a0 += sc[k] * wv; a1 += sc[1024 + k] * wv; a2 += sc[2048 + k] * wv; a3 += sc[3072 + k] * wv; a4 += sc[4096 + k] * wv;
    }
    red[(ks * 5 + 0) * 64 + cc] = a0; red[(ks * 5 + 1) * 64 + cc] = a1; red[(ks * 5 + 2) * 64 + cc] = a2;
    red[(ks * 5 + 3) * 64 + cc] = a3; red[(ks * 5 + 4) * 64 + cc] = a4;
    __syncthreads();
    if (tid < 320) {
        int v = tid >> 6, c2 = tid & 63; float s = 0;
        for (int k2 = 0; k2 < 8; ++k2) s += red[(k2 * 5 + v) * 64 + c2];
        float* mod = (float*)(p.ws + OFF_MOD);
        mod[(size_t)(l * 5 + v) * 6144 + cgp * 64 + c2] = s + p.b_mod[l * 6144 + cgp * 64 + c2];
    }
    __syncthreads();
}

__device__ void transpose_tile(const float* src, int ld_src, bf16* dst, int ld_dst, char* smem) {
    float* t = (float*)smem;
    const int tid = otid();
#pragma unroll
    for (int i = 0; i < 8; ++i) { int kk = (tid >> 6) + 8 * i, nn = tid & 63; t[kk * 65 + nn] = src[(size_t)kk * ld_src + nn]; }
    __syncthreads();
    const int nn = tid >> 3, kc = tid & 7;
    uint4 o;
    o.x = pack2(t[(kc * 8 + 0) * 65 + nn], t[(kc * 8 + 1) * 65 + nn]);
    o.y = pack2(t[(kc * 8 + 2) * 65 + nn], t[(kc * 8 + 3) * 65 + nn]);
    o.z = pack2(t[(kc * 8 + 4) * 65 + nn], t[(kc * 8 + 5) * 65 + nn]);
    o.w = pack2(t[(kc * 8 + 6) * 65 + nn], t[(kc * 8 + 7) * 65 + nn]);
    *(uint4*)(dst + (size_t)nn * ld_dst + kc * 8) = o;
    __syncthreads();
}

constexpr int CONV_TILES_LAYER = 2240 + 1024;
__device__ void conv_item(const Params& p, int l, int it, char* smem) {
    bf16* wt = (bf16*)(p.ws + OFF_WT);
    if (it < 2240) {
        int kt = it / 140, nt = it % 140;
        transpose_tile(p.w_in + (size_t)l * 1024 * DIN + (size_t)kt * 64 * DIN + nt * 64, DIN, wt + (size_t)nt * 64 * 1024 + kt * 64, 1024, smem);
    } else {
        int j = it - 2240; int mtx = j >> 8; int r = j & 255; int kt = r >> 4, nt = r & 15;
        const float* src = (mtx == 0 ? p.w_br_ret : mtx == 1 ? p.w_br_swa : mtx == 2 ? p.w_br_ga : p.w_out) + (size_t)l * 1024 * 1024;
        bf16* dst = wt + (size_t)DIN * 1024 + (size_t)mtx * 1024 * 1024;
        transpose_tile(src + (size_t)kt * 64 * 1024 + nt * 64, 1024, dst + (size_t)nt * 64 * 1024 + kt * 64, 1024, smem);
    }
}
constexpr int MOE_CONV_TILES = 16 * 384;
__device__ void moe_conv_item(const Params& p, int l, int it, char* smem) {
    int e = it / 384, r = it % 384;
    bf16* wgu = (bf16*)(p.ws + OFF_WGU) + (size_t)e * 1024 * 1024;
    bf16* wd = (bf16*)(p.ws + OFF_WD) + (size_t)e * 1024 * 512;
    if (r < 256) {
        int up = r >> 7; int q = r & 127; int kt = q >> 3, nt = q & 7;
        const float* src = (up ? p.w_up : p.w_gate) + ((size_t)(l * 16 + e) * 1024 + (size_t)kt * 64) * 512 + nt * 64;
        transpose_tile(src, 512, wgu + (size_t)(nt * 128 + up * 64) * 1024 + kt * 64, 1024, smem);
    } else {
        int q = r - 256; int kt = q >> 4, nt = q & 15;
        const float* src = p.w_down + ((size_t)(l * 16 + e) * 512 + (size_t)kt * 64) * 1024 + nt * 64;
        transpose_tile(src, 1024, wd + (size_t)nt * 64 * 512 + kt * 64, 512, smem);
    }
}

__device__ void phase0(const Params& p, char* smem) {
    const int tid = otid();
    if (blockIdx.x == 0) {
        int* ctl = (int*)(p.ws + OFF_CTL);
        if (tid < 64) ctl[tid] = 0;
        float* rp = (float*)(p.ws + OFF_ROPE);
        for (int i = tid; i < 64 * 32; i += NT) {
            int pos = i >> 5, j = i & 31;
            float fr = powf(10000.f, -(float)j / 32.f); float a = (float)pos * fr;
            rp[i] = cosf(a); rp[2048 + i] = sinf(a);
        }
        for (int i = tid; i < 64 * 16; i += NT) {
            int pos = i >> 4, j = i & 15;
            float fr = powf(10000.f, -(float)j / 16.f); float a = (float)pos * fr;
            rp[4096 + i] = cosf(a); rp[4096 + 1024 + i] = sinf(a);
        }
    }
    const int nitems = 192 + CONV_TILES_LAYER;
    for (int it = blockIdx.x; it < nitems; it += gridDim.x) {
        if (it < 192) mod_item(p, it, smem);
        else conv_item(p, 0, it - 192, smem);
    }
}

__device__ void phase_norm1(const Params& p, int l) {
    const int tid = otid(), wave = tid >> 6, lane = tid & 63;
    const float* mod = (const float*)(p.ws + OFF_MOD);
    float* CX = (float*)(p.ws + OFF_CX);
    const bf16* YB = (const bf16*)(p.ws + OFF_YB);
    bf16* H = (bf16*)(p.ws + OFF_H);
    for (int r = blockIdx.x * 8 + wave; r < TALL; r += gridDim.x * 8) {
        const bool isctx = r >= TLAT; const int v = isctx ? 4 : r / SEQ;
        float4 xv[4];
        if (l == 0) {
            const float* xin = isctx ? p.ctx + (size_t)(r - TLAT) * D : p.x + (size_t)r * D;
#pragma unroll
            for (int j = 0; j < 4; ++j) xv[j] = *(const float4*)(xin + j * 256 + lane * 4);
        } else {
            float* xr = isctx ? CX + (size_t)(r - TLAT) * D : p.out + (size_t)r * D;
            const float* gt2 = mod + (size_t)((l - 1) * 5 + v) * 6144 + 5 * 1024;
#pragma unroll
            for (int j = 0; j < 4; ++j) {
                int col = j * 256 + lane * 4;
                float4 a = *(const float4*)(xr + col); float4 g = *(const float4*)(gt2 + col);
                uint2 y0 = *(const uint2*)(YB + (size_t)(r * 2) * D + col), y1 = *(const uint2*)(YB + (size_t)(r * 2 + 1) * D + col);
                a.x += g.x * (lo2f(y0.x) + lo2f(y1.x)); a.y += g.y * (hi2f(y0.x) + hi2f(y1.x));
                a.z += g.z * (lo2f(y0.y) + lo2f(y1.y)); a.w += g.w * (hi2f(y0.y) + hi2f(y1.y));
                *(float4*)(xr + col) = a; xv[j] = a;
            }
        }
        float ss = 0;
#pragma unroll
        for (int j = 0; j < 4; ++j) ss += xv[j].x * xv[j].x + xv[j].y * xv[j].y + xv[j].z * xv[j].z + xv[j].w * xv[j].w;
        ss = wsum(ss);
        const float rstd = rsqrtf(ss * (1.f / 1024.f) + EPS);
        const float* md = mod + (size_t)(l * 5 + v) * 6144;
#pragma unroll
        for (int j = 0; j < 4; ++j) {
            int col = j * 256 + lane * 4;
            float4 g = *(const float4*)(p.g1 + l * 1024 + col), sh = *(const float4*)(md + col), sc = *(const float4*)(md + 1024 + col);
            float h0 = xv[j].x * rstd * g.x * (1.f + sc.x) + sh.x, h1 = xv[j].y * rstd * g.y * (1.f + sc.y) + sh.y;
            float h2 = xv[j].z * rstd * g.z * (1.f + sc.z) + sh.z, h3 = xv[j].w * rstd * g.w * (1.f + sc.w) + sh.w;
            uint2 o; o.x = pack2(h0, h1); o.y = pack2(h2, h3);
            *(uint2*)(H + (size_t)r * D + col) = o;
        }
    }
}

__device__ void phase_norm2(const Params& p, int l) {
    const int tid = otid(), wave = tid >> 6, lane = tid & 63;
    const float* mod = (const float*)(p.ws + OFF_MOD);
    const float* CX = (const float*)(p.ws + OFF_CX);
    bf16* H = (bf16*)(p.ws + OFF_H);
    int* cnt = (int*)(p.ws + OFF_CTL) + l * 16;
    int* lts = (int*)(p.ws + OFF_LTS);
    float* lw = (float*)(p.ws + OFF_LW);
    const int nrows = (l == 0) ? TALL : TLAT;
    for (int r = blockIdx.x * 8 + wave; r < nrows; r += gridDim.x * 8) {
        const bool isctx = r >= TLAT; const int v = isctx ? 4 : r / SEQ;
        const float* xr = isctx ? CX + (size_t)(r - TLAT) * D : p.out + (size_t)r * D;
        float4 xv[4];
#pragma unroll
        for (int j = 0; j < 4; ++j) xv[j] = *(const float4*)(xr + j * 256 + lane * 4);
        float ss = 0;
#pragma unroll
        for (int j = 0; j < 4; ++j) ss += xv[j].x * xv[j].x + xv[j].y * xv[j].y + xv[j].z * xv[j].z + xv[j].w * xv[j].w;
        ss = wsum(ss);
        const float rstd = rsqrtf(ss * (1.f / 1024.f) + EPS);
        const float* md = mod + (size_t)(l * 5 + v) * 6144;
        float part[16];
#pragma unroll
        for (int e = 0; e < 16; ++e) part[e] = 0.f;
#pragma unroll
        for (int j = 0; j < 4; ++j) {
            int col = j * 256 + lane * 4;
            float4 g = *(const float4*)(p.g2 + l * 1024 + col), sh = *(const float4*)(md + 3072 + col), sc = *(const float4*)(md + 4096 + col);
            float hv[4];
            hv[0] = xv[j].x * rstd * g.x * (1.f + sc.x) + sh.x; hv[1] = xv[j].y * rstd * g.y * (1.f + sc.y) + sh.y;
            hv[2] = xv[j].z * rstd * g.z * (1.f + sc.z) + sh.z; hv[3] = xv[j].w * rstd * g.w * (1.f + sc.w) + sh.w;
            uint2 o; o.x = pack2(hv[0], hv[1]); o.y = pack2(hv[2], hv[3]);
            *(uint2*)(H + (size_t)r * D + col) = o;
#pragma unroll
            for (int i = 0; i < 4; ++i) {
                const float4* wr = (const float4*)(p.w_router + (size_t)(col + i) * 16);
                float4 w0 = wr[0], w1 = wr[1], w2 = wr[2], w3 = wr[3];
                part[0] += hv[i] * w0.x; part[1] += hv[i] * w0.y; part[2] += hv[i] * w0.z; part[3] += hv[i] * w0.w;
                part[4] += hv[i] * w1.x; part[5] += hv[i] * w1.y; part[6] += hv[i] * w1.z; part[7] += hv[i] * w1.w;
                part[8] += hv[i] * w2.x; part[9] += hv[i] * w2.y; part[10] += hv[i] * w2.z; part[11] += hv[i] * w2.w;
                part[12] += hv[i] * w3.x; part[13] += hv[i] * w3.y; part[14] += hv[i] * w3.z; part[15] += hv[i] * w3.w;
            }
        }
#pragma unroll
        for (int e = 0; e < 16; ++e) part[e] = wsum(part[e]);
        if (lane == 0) {
            float s[16], bb[16];
#pragma unroll
            for (int e = 0; e < 16; ++e) { s[e] = sigmoidf_(part[e]); bb[e] = s[e] + p.b_router[e]; }
            float bestscore = -1e30f; int be0 = 0, be1 = 1; float bs0 = 0.f, bs1 = 0.f;
#pragma unroll
            for (int g = 0; g < 4; ++g) {
                int i1 = 0; float m1 = bb[g * 4]; float s1 = s[g * 4];
#pragma unroll
                for (int i = 1; i < 4; ++i) if (bb[g * 4 + i] > m1) { m1 = bb[g * 4 + i]; i1 = i; s1 = s[g * 4 + i]; }
                int i2 = -1; float m2 = -1e30f; float s2 = 0.f;
#pragma unroll
                for (int i = 0; i < 4; ++i) if (i != i1 && bb[g * 4 + i] > m2) { m2 = bb[g * 4 + i]; i2 = i; s2 = s[g * 4 + i]; }
                float gs = m1 + m2;
                if (gs > bestscore) { bestscore = gs; be0 = g * 4 + i1; be1 = g * 4 + i2; bs0 = s1; bs1 = s2; }
            }
            float inv = 1.f / (bs0 + bs1);
            int p0 = atomicAdd(&cnt[be0], 1);
            lts[(size_t)be0 * TALL + p0] = r * 2; lw[(size_t)be0 * TALL + p0] = bs0 * inv;
            int p1 = atomicAdd(&cnt[be1], 1);
            lts[(size_t)be1 * TALL + p1] = r * 2 + 1; lw[(size_t)be1 * TALL + p1] = bs1 * inv;
        }
    }
}

__device__ void phase_final(const Params& p) {
    const int tid = otid(), wave = tid >> 6, lane = tid & 63;
    const float* mod = (const float*)(p.ws + OFF_MOD);
    const bf16* YB = (const bf16*)(p.ws + OFF_YB);
    for (int r = blockIdx.x * 8 + wave; r < TLAT; r += gridDim.x * 8) {
        const int v = r / SEQ;
        float* xr = p.out + (size_t)r * D;
        const float* gt2 = mod + (size_t)(1 * 5 + v) * 6144 + 5 * 1024;
        float4 xv[4];
#pragma unroll
        for (int j = 0; j < 4; ++j) {
            int col = j * 256 + lane * 4;
            float4 a = *(const float4*)(xr + col); float4 g = *(const float4*)(gt2 + col);
            uint2 y0 = *(const uint2*)(YB + (size_t)(r * 2) * D + col), y1 = *(const uint2*)(YB + (size_t)(r * 2 + 1) * D + col);
            a.x += g.x * (lo2f(y0.x) + lo2f(y1.x)); a.y += g.y * (hi2f(y0.x) + hi2f(y1.x));
            a.z += g.z * (lo2f(y0.y) + lo2f(y1.y)); a.w += g.w * (hi2f(y0.y) + hi2f(y1.y));
            xv[j] = a;
        }
        float ss = 0;
#pragma unroll
        for (int j = 0; j < 4; ++j) ss += xv[j].x * xv[j].x + xv[j].y * xv[j].y + xv[j].z * xv[j].z + xv[j].w * xv[j].w;
        ss = wsum(ss);
        const float rstd = rsqrtf(ss * (1.f / 1024.f) + EPS);
#pragma unroll
        for (int j = 0; j < 4; ++j) {
            int col = j * 256 + lane * 4;
            float4 g = *(const float4*)(p.g_final + col);
            float4 o; o.x = xv[j].x * rstd * g.x; o.y = xv[j].y * rstd * g.y; o.z = xv[j].z * rstd * g.z; o.w = xv[j].w * rstd * g.w;
            *(float4*)(xr + col) = o;
        }
    }
}

constexpr int LDS_ROW = 144;
constexpr int A_STAGE = 256 * LDS_ROW;
constexpr int B_STAGE = 128 * LDS_ROW;
constexpr int STAGE = A_STAGE + B_STAGE;
constexpr int GEMM_LDS = 2 * STAGE;
constexpr int CT_LD = 132;

template <int MI>
__device__ __forceinline__ void zero_acc(f32x16 (&acc)[MI][2]) {
#pragma unroll
    for (int a = 0; a < MI; ++a)
#pragma unroll
        for (int b = 0; b < 2; ++b)
#pragma unroll
            for (int r = 0; r < 16; ++r) acc[a][b][r] = 0.f;
}

__device__ __forceinline__ uint4 scale8(uint4 u, float sc) {
    uint4 o;
    o.x = pack2(lo2f(u.x) * sc, hi2f(u.x) * sc); o.y = pack2(lo2f(u.y) * sc, hi2f(u.y) * sc);
    o.z = pack2(lo2f(u.z) * sc, hi2f(u.z) * sc); o.w = pack2(lo2f(u.w) * sc, hi2f(u.w) * sc);
    return o;
}
template <int MI, bool BS = false>
__device__ __forceinline__ void gemm_mainloop(f32x16 (&acc)[MI][2], const bf16* ap0, const bf16* ap1, const bf16* ap2, const bf16* ap3,
                                              const bf16* bp0, const bf16* bp1, int K, char* smem, float bs0 = 1.f, float bs1 = 1.f) {
    const int tid = otid(), lane = tid & 63, wave = tid >> 6, wm = wave >> 1, wn = wave & 1;
    const int kc = tid & 7, lr = tid >> 3;
    uint4 ra0, ra1, ra2, ra3, rb0, rb1;
    ra0 = *(const uint4*)(ap0 + kc * 8); ra1 = *(const uint4*)(ap1 + kc * 8);
    if (MI == 2) { ra2 = *(const uint4*)(ap2 + kc * 8); ra3 = *(const uint4*)(ap3 + kc * 8); }
    rb0 = *(const uint4*)(bp0 + kc * 8); rb1 = *(const uint4*)(bp1 + kc * 8);
    if (BS) { rb0 = scale8(rb0, bs0); rb1 = scale8(rb1, bs1); }
    {
        char* st = smem;
        *(uint4*)(st + (lr) * LDS_ROW + kc * 16) = ra0; *(uint4*)(st + (lr + 64) * LDS_ROW + kc * 16) = ra1;
        if (MI == 2) { *(uint4*)(st + (lr + 128) * LDS_ROW + kc * 16) = ra2; *(uint4*)(st + (lr + 192) * LDS_ROW + kc * 16) = ra3; }
        *(uint4*)(st + A_STAGE + (lr) * LDS_ROW + kc * 16) = rb0; *(uint4*)(st + A_STAGE + (lr + 64) * LDS_ROW + kc * 16) = rb1;
    }
    __syncthreads();
    const int nk = K >> 6;
    const int aoff = (wm * (32 * MI) + (lane & 31)) * LDS_ROW + (lane >> 5) * 16;
    const int boff = A_STAGE + (wn * 64 + (lane & 31)) * LDS_ROW + (lane >> 5) * 16;
    for (int kt = 0; kt < nk; ++kt) {
        char* cur = smem + (kt & 1) * STAGE;
        const bool more = (kt + 1 < nk);
        if (more) {
            const int ko = (kt + 1) * 64 + kc * 8;
            ra0 = *(const uint4*)(ap0 + ko); ra1 = *(const uint4*)(ap1 + ko);
            if (MI == 2) { ra2 = *(const uint4*)(ap2 + ko); ra3 = *(const uint4*)(ap3 + ko); }
            rb0 = *(const uint4*)(bp0 + ko); rb1 = *(const uint4*)(bp1 + ko);
        }
#pragma unroll
        for (int ks = 0; ks < 4; ++ks) {
            bf16x8 b0 = *(const bf16x8*)(cur + boff + ks * 32);
            bf16x8 b1 = *(const bf16x8*)(cur + boff + 32 * LDS_ROW + ks * 32);
#pragma unroll
            for (int mi = 0; mi < MI; ++mi) {
                bf16x8 a0 = *(const bf16x8*)(cur + aoff + mi * 32 * LDS_ROW + ks * 32);
                acc[mi][0] = __builtin_amdgcn_mfma_f32_32x32x16_bf16(a0, b0, acc[mi][0], 0, 0, 0);
                acc[mi][1] = __builtin_amdgcn_mfma_f32_32x32x16_bf16(a0, b1, acc[mi][1], 0, 0, 0);
            }
        }
        if (more) {
            if (BS) { rb0 = scale8(rb0, bs0); rb1 = scale8(rb1, bs1); }
            char* st = smem + ((kt + 1) & 1) * STAGE;
            *(uint4*)(st + (lr) * LDS_ROW + kc * 16) = ra0; *(uint4*)(st + (lr + 64) * LDS_ROW + kc * 16) = ra1;
            if (MI == 2) { *(uint4*)(st + (lr + 128) * LDS_ROW + kc * 16) = ra2; *(uint4*)(st + (lr + 192) * LDS_ROW + kc * 16) = ra3; }
            *(uint4*)(st + A_STAGE + (lr) * LDS_ROW + kc * 16) = rb0; *(uint4*)(st + A_STAGE + (lr + 64) * LDS_ROW + kc * 16) = rb1;
        }
        __syncthreads();
    }
}

__device__ __forceinline__ void stage_full(const f32x16 (&acc)[1][2], char* smem) {
    const int tid = otid(), lane = tid & 63, wave = tid >> 6, wm = wave >> 1, wn = wave & 1;
    float* Ct = (float*)smem;
#pragma unroll
    for (int ni = 0; ni < 2; ++ni)
#pragma unroll
        for (int r = 0; r < 16; ++r) {
            int row = wm * 32 + (r & 3) + 8 * (r >> 2) + 4 * (lane >> 5);
            int col = wn * 64 + ni * 32 + (lane & 31);
            Ct[row * CT_LD + col] = acc[0][ni][r];
        }
}

__device__ __forceinline__ void stage_half(const f32x16 (&acc)[2][2], int h, char* smem) {
    const int tid = otid(), lane = tid & 63, wave = tid >> 6, wm = wave >> 1, wn = wave & 1;
    float* Ct = (float*)smem;
    if ((wm >> 1) == h) {
#pragma unroll
        for (int mi = 0; mi < 2; ++mi)
#pragma unroll
            for (int ni = 0; ni < 2; ++ni)
#pragma unroll
                for (int r = 0; r < 16; ++r) {
                    int row = (wm & 1) * 64 + mi * 32 + (r & 3) + 8 * (r >> 2) + 4 * (lane >> 5);
                    int col = wn * 64 + ni * 32 + (lane & 31);
                    Ct[row * CT_LD + col] = acc[mi][ni][r];
                }
    }
}

__device__ __forceinline__ void store32_bf16(bf16* dst, const float (&v)[32]) {
#pragma unroll
    for (int i = 0; i < 4; ++i) {
        uint4 o; o.x = pack2(v[i * 8 + 0], v[i * 8 + 1]); o.y = pack2(v[i * 8 + 2], v[i * 8 + 3]);
        o.z = pack2(v[i * 8 + 4], v[i * 8 + 5]); o.w = pack2(v[i * 8 + 6], v[i * 8 + 7]);
        *(uint4*)(dst + i * 8) = o;
    }
}

__device__ void epi_inproj(const Params& p, int l, const float* Ct, int mrow0, int n0) {
    const int tid = otid(), r = tid >> 2, q = tid & 3;
    const int row = mrow0 + r;
    const bool isctx = row >= TLAT;
    const int t = row & (SEQ - 1);
    const int prow = t >> 6, pcol = t & 63;
    unsigned char* ws = p.ws;
    bf16* dst; int ld, coff, rope = 0; const float* gain = nullptr; float scale = 1.f;
    if (n0 < 512)       { dst = (bf16*)(ws + OFF_QR); ld = 512;  coff = n0;        rope = 128; }
    else if (n0 < 1024) { dst = (bf16*)(ws + OFF_KR); ld = 512;  coff = n0 - 512;  rope = 128; scale = 0.08838834764831845f; }
    else if (n0 < 2048) { dst = (bf16*)(ws + OFF_VR); ld = 1024; coff = n0 - 1024; }
    else if (n0 < 3072) { dst = (bf16*)(ws + OFF_UR); ld = 1024; coff = n0 - 2048; }
    else if (n0 < 4096) { dst = (bf16*)(ws + OFF_QS); ld = 1024; coff = n0 - 3072; rope = 64; scale = 0.125f; }
    else if (n0 < 4224) { dst = (bf16*)(ws + OFF_KS); ld = 128;  coff = 0;         rope = 64; }
    else if (n0 < 4352) { dst = (bf16*)(ws + OFF_VS); ld = 128;  coff = 0; }
    else if (n0 < 5376) { dst = (bf16*)(ws + OFF_QA); ld = 1024; coff = n0 - 4352; rope = 128; gain = p.gq + l * 128; }
    else if (n0 < 5632) { dst = (bf16*)(ws + OFF_KA); ld = 256;  coff = n0 - 5376; rope = 128; gain = p.gk + l * 128; }
    else                { dst = (bf16*)(ws + OFF_VA); ld = 256;  coff = n0 - 5632; }
    if (isctx) rope = 0;
    const float* rp = (const float*)(ws + OFF_ROPE);
    const float* src = Ct + r * CT_LD + 32 * q;
    float rstd = 1.f;
    if (gain) {
        float ss = 0;
#pragma unroll 8
        for (int j = 0; j < 32; ++j) ss += src[j] * src[j];
        ss += __shfl_xor(ss, 1, 64); ss += __shfl_xor(ss, 2, 64);
        rstd = rsqrtf(ss * (1.f / 128.f) + EPS);
    }
    bf16* drow = dst + (size_t)row * ld + coff + 32 * q;
#pragma unroll 1
    for (int c = 0; c < 4; ++c) {
        float v[8], o[8];
#pragma unroll
        for (int j = 0; j < 8; ++j) v[j] = src[c * 8 + j];
        if (gain) {
#pragma unroll
            for (int j = 0; j < 8; ++j) v[j] = v[j] * rstd * gain[32 * q + c * 8 + j];
        }
        if (rope == 128) {
            const float* psrc = Ct + r * CT_LD + 32 * (q ^ 1) + c * 8;
            const int pos = (q >> 1) ? pcol : prow;
            const float* cs = rp + pos * 32 + c * 8; const float* sn = rp + 2048 + pos * 32 + c * 8;
#pragma unroll
            for (int j = 0; j < 8; ++j) {
                float pv = psrc[j];
                if (gain) pv = pv * rstd * gain[32 * (q ^ 1) + c * 8 + j];
                float cc = cs[j], sv = sn[j];
                o[j] = (q & 1) ? (pv * sv + v[j] * cc) : (v[j] * cc - pv * sv);
            }
        } else if (rope == 64) {
            const float* psrc = src + ((c ^ 2) * 8);
            const int pos = (q & 1) ? pcol : prow;
            const float* cs = rp + 4096 + pos * 16 + (c & 1) * 8; const float* sn = rp + 4096 + 1024 + pos * 16 + (c & 1) * 8;
#pragma unroll
            for (int j = 0; j < 8; ++j) {
                float pv = psrc[j];
                float cc = cs[j], sv = sn[j];
                o[j] = (c < 2) ? (v[j] * cc - pv * sv) : (pv * sv + v[j] * cc);
            }
        } else {
#pragma unroll
            for (int j = 0; j < 8; ++j) o[j] = v[j];
        }
        uint4 ov;
        ov.x = pack2(o[0] * scale, o[1] * scale); ov.y = pack2(o[2] * scale, o[3] * scale);
        ov.z = pack2(o[4] * scale, o[5] * scale); ov.w = pack2(o[6] * scale, o[7] * scale);
        *(uint4*)(drow + c * 8) = ov;
    }
}

__device__ void epi_plain_bf16(const float* Ct, bf16* dst, int ld, int mrow0, int n0) {
    const int tid = otid(), r = tid >> 2, q = tid & 3;
    float v[32];
    const float* src = Ct + r * CT_LD + 32 * q;
#pragma unroll
    for (int j = 0; j < 32; ++j) v[j] = src[j];
    store32_bf16(dst + (size_t)(mrow0 + r) * ld + n0 + 32 * q, v);
}

__device__ void epi_outproj(const Params& p, int l, const float* Ct, int mrow0, int n0) {
    const int tid = otid(), r = tid >> 2, q = tid & 3;
    const int row = mrow0 + r;
    const bool isctx = row >= TLAT; const int v = isctx ? 4 : row / SEQ;
    const float* gt = (const float*)(p.ws + OFF_MOD) + (size_t)(l * 5 + v) * 6144 + 2048 + n0 + 32 * q;
    float* CX = (float*)(p.ws + OFF_CX);
    const float* xin; float* xo;
    if (isctx) { xo = CX + (size_t)(row - TLAT) * D + n0 + 32 * q; xin = (l == 0) ? p.ctx + (size_t)(row - TLAT) * D + n0 + 32 * q : xo; }
    else { xo = p.out + (size_t)row * D + n0 + 32 * q; xin = (l == 0) ? p.x + (size_t)row * D + n0 + 32 * q : xo; }
    const float* src = Ct + r * CT_LD + 32 * q;
#pragma unroll
    for (int i = 0; i < 8; ++i) {
        float4 a = *(const float4*)(xin + i * 4); float4 g = *(const float4*)(gt + i * 4);
        a.x += g.x * src[i * 4 + 0]; a.y += g.y * src[i * 4 + 1]; a.z += g.z * src[i * 4 + 2]; a.w += g.w * src[i * 4 + 3];
        *(float4*)(xo + i * 4) = a;
    }
}

__device__ __forceinline__ float log_sigmoid_(float x) { return -log1pf(expf(-x)); }

__device__ void epi_ret_transposed(const Params& p, int l, const float* Ct, int mrow0, int n0) {
    const int tid = otid(), c = tid & 127, q = tid >> 7;
    const bool isctx = mrow0 >= TLAT;
    const int b = isctx ? (mrow0 - TLAT) / CTXL : mrow0 / SEQ;
    const int key0 = isctx ? 4096 + (mrow0 - TLAT - b * CTXL) : mrow0 - b * SEQ;
    if (n0 >= 1024) {
        bf16* dst;
        if (n0 == 4224) dst = (bf16*)(p.ws + OFF_VS) + ((size_t)(b * 2) * 64 + c) * KEYS + key0 + 32 * q;
        else { const int h = (n0 - 1024) >> 8, e = ((n0 - 1024) & 255) + c; dst = (bf16*)(p.ws + OFF_VR) + ((size_t)(b * 4 + h) * 256 + e) * KEYS + key0 + 32 * q; }
#pragma unroll
        for (int g = 0; g < 4; ++g) {
            float v[8];
#pragma unroll
            for (int j = 0; j < 8; ++j) v[j] = Ct[(32 * q + g * 8 + j) * CT_LD + c];
            uint4 o; o.x = pack2(v[0], v[1]); o.y = pack2(v[2], v[3]); o.z = pack2(v[4], v[5]); o.w = pack2(v[6], v[7]);
            *(uint4*)(dst + g * 8) = o;
        }
    } else {
        const int h = (n0 - 512) >> 7;
        const float lgf = log_sigmoid_(p.ret_logit[l * 8 + h]), lgb = log_sigmoid_(p.ret_logit[l * 8 + 4 + h]);
        const float* rp = (const float*)(p.ws + OFF_ROPE);
        const int a = c >> 6, rr = c & 63, first = rr < 32, pc = first ? c + 32 : c - 32, idx = rr & 31;
        bf16* df = (bf16*)(p.ws + OFF_KFT) + ((size_t)(b * 4 + h) * 128 + c) * KEYS + key0 + 32 * q;
        bf16* db = (bf16*)(p.ws + OFF_KBT) + ((size_t)(b * 4 + h) * 128 + c) * KEYS + key0 + 32 * q;
#pragma unroll 1
        for (int g = 0; g < 4; ++g) {
            float vf[8], vb[8];
#pragma unroll
            for (int j = 0; j < 8; ++j) {
                const int tk = 32 * q + g * 8 + j;
                float x = Ct[tk * CT_LD + c];
                if (!isctx) {
                    float px = Ct[tk * CT_LD + pc];
                    const int t = key0 + tk; const int pos = a ? (t & 63) : (t >> 6);
                    float cs = rp[pos * 32 + idx], sn = rp[2048 + pos * 32 + idx];
                    x = first ? (x * cs - px * sn) : (px * sn + x * cs);
                }
                x *= 0.08838834764831845f;
                vf[j] = x * expf((float)(127 - tk) * lgf);
                vb[j] = x * expf((float)tk * lgb);
            }
            uint4 o; o.x = pack2(vf[0], vf[1]); o.y = pack2(vf[2], vf[3]); o.z = pack2(vf[4], vf[5]); o.w = pack2(vf[6], vf[7]);
            *(uint4*)(df + g * 8) = o;
            o.x = pack2(vb[0], vb[1]); o.y = pack2(vb[2], vb[3]); o.z = pack2(vb[4], vb[5]); o.w = pack2(vb[6], vb[7]);
            *(uint4*)(db + g * 8) = o;
        }
    }
}

__device__ void phase_inproj(const Params& p, int l, char* smem) {
    const int tid = otid(), lr = tid >> 3;
    const bf16* H = (const bf16*)(p.ws + OFF_H);
    const bf16* Wt = (const bf16*)(p.ws + OFF_WT);
    constexpr int NTN = DQKV / 128;
    constexpr int NTM = TALL / 256;
    for (int t = blockIdx.x; t < NTM * NTN; t += gridDim.x) {
        const int mt = t / NTN, nt = t % NTN;
        const int m0 = mt * 256, n0 = nt * 128;
        f32x16 acc[2][2]; zero_acc<2>(acc);
        const bf16* a = H + (size_t)(m0 + lr) * 1024;
        const bf16* b = Wt + (size_t)(n0 + lr) * 1024;
        gemm_mainloop<2>(acc, a, a + 64 * 1024, a + 128 * 1024, a + 192 * 1024, b, b + 64 * 1024, 1024, smem);
        for (int h = 0; h < 2; ++h) {
            stage_half(acc, h, smem);
            __syncthreads();
            if (n0 < 1024 || (n0 >= 2048 && n0 != 4224)) epi_inproj(p, l, (const float*)smem, m0 + h * 128, n0);
            if ((n0 >= 512 && n0 < 2048) || n0 == 4224) epi_ret_transposed(p, l, (const float*)smem, m0 + h * 128, n0);
            __syncthreads();
        }
    }
}

__device__ void phase_merge(const Params& p, int l, char* smem) {
    const int tid = otid(), lr = tid >> 3;
    const bf16* H = (const bf16*)(p.ws + OFF_H);
    const bf16* Wt = (const bf16*)(p.ws + OFF_WT);
    bf16* Y = (bf16*)(p.ws + OFF_Y);
    const int M = (l == 0) ? TALL : TLAT;
    const int ntm = M / 128;
    for (int t = blockIdx.x; t < ntm * 8; t += gridDim.x) {
        const int mt = t >> 3, nt = t & 7;
        const int m0 = mt * 128, n0 = nt * 128;
        f32x16 yacc[1][2]; zero_acc<1>(yacc);
#pragma unroll 1
        for (int br = 0; br < 3; ++br) {
            unsigned gp[2][8];
            {
                f32x16 acc[1][2]; zero_acc<1>(acc);
                const bf16* a = H + (size_t)(m0 + lr) * 1024;
                const bf16* b = Wt + (size_t)(DQKV + br * 1024 + n0 + lr) * 1024;
                gemm_mainloop<1>(acc, a, a + 64 * 1024, a, a, b, b + 64 * 1024, 1024, smem);
#pragma unroll
                for (int ni = 0; ni < 2; ++ni)
#pragma unroll
                    for (int r = 0; r < 8; ++r) gp[ni][r] = pack2(sigmoidf_(acc[0][ni][2 * r]), sigmoidf_(acc[0][ni][2 * r + 1]));
            }
            {
                f32x16 acc[1][2]; zero_acc<1>(acc);
                const bf16* O = (const bf16*)(p.ws + (br == 0 ? OFF_UR : br == 1 ? OFF_QS : OFF_QA));
                const bf16* a = O + (size_t)(m0 + lr) * 1024;
                const bf16* b = Wt + (size_t)DIN * 1024 + (size_t)br * 1024 * 1024 + (size_t)(n0 + lr) * 1024;
                gemm_mainloop<1>(acc, a, a + 64 * 1024, a, a, b, b + 64 * 1024, 1024, smem);
#pragma unroll
                for (int ni = 0; ni < 2; ++ni)
#pragma unroll
                    for (int r = 0; r < 8; ++r) {
                        yacc[0][ni][2 * r] += lo2f(gp[ni][r]) * acc[0][ni][2 * r];
                        yacc[0][ni][2 * r + 1] += hi2f(gp[ni][r]) * acc[0][ni][2 * r + 1];
                    }
            }
        }
        stage_full(yacc, smem);
        __syncthreads();
        epi_plain_bf16((const float*)smem, Y, 1024, m0, n0);
        __syncthreads();
    }
}

__device__ void phase_outproj(const Params& p, int l, char* smem) {
    const int tid = otid(), lr = tid >> 3;
    const bf16* Y = (const bf16*)(p.ws + OFF_Y);
    const bf16* Wt = (const bf16*)(p.ws + OFF_WT) + (size_t)DIN * 1024 + (size_t)3 * 1024 * 1024;
    const int M = (l == 0) ? TALL : TLAT;
    const int ntm = M / 256;
    for (int t = blockIdx.x; t < ntm * 8; t += gridDim.x) {
        const int mt = t >> 3, nt = t & 7;
        const int m0 = mt * 256, n0 = nt * 128;
        f32x16 acc[2][2]; zero_acc<2>(acc);
        const bf16* a = Y + (size_t)(m0 + lr) * 1024;
        const bf16* b = Wt + (size_t)(n0 + lr) * 1024;
        gemm_mainloop<2>(acc, a, a + 64 * 1024, a + 128 * 1024, a + 192 * 1024, b, b + 64 * 1024, 1024, smem);
        for (int h = 0; h < 2; ++h) {
            stage_half(acc, h, smem);
            __syncthreads();
            epi_outproj(p, l, (const float*)smem, m0 + h * 128, n0);
            __syncthreads();
        }
    }
}

__device__ __forceinline__ bool moe_find(const int* cnt, int tile, int& e, int& mt, int& rowbase, int& ce) {
    int acc_t = 0, acc_r = 0;
    for (int i = 0; i < 16; ++i) {
        int c = cnt[i]; int nt = (c + 255) >> 8;
        if (tile < acc_t + nt) { e = i; mt = tile - acc_t; rowbase = acc_r; ce = c; return true; }
        acc_t += nt; acc_r += c;
    }
    return false;
}

__device__ void phase_moe1(const Params& p, int l, char* smem) {
    const int tid = otid(), lr = tid >> 3;
    const int* cnt = (const int*)(p.ws + OFF_CTL) + l * 16;
    const int* lts = (const int*)(p.ws + OFF_LTS);
    const bf16* H = (const bf16*)(p.ws + OFF_H);
    bf16* HB = (bf16*)(p.ws + OFF_HB);
    int total = 0;
    for (int i = 0; i < 16; ++i) total += (cnt[i] + 255) >> 8;
    for (int t = blockIdx.x; t < total * 8; t += gridDim.x) {
        const int tile = t >> 3, nt = t & 7;
        int e, mt, rowbase, ce;
        moe_find(cnt, tile, e, mt, rowbase, ce);
        const int* le = lts + (size_t)e * TALL;
        const bf16* ap[4];
#pragma unroll
        for (int i = 0; i < 4; ++i) {
            int idx = mt * 256 + lr + 64 * i; if (idx >= ce) idx = ce - 1;
            ap[i] = H + (size_t)(le[idx] >> 1) * 1024;
        }
        const bf16* b = (const bf16*)(p.ws + OFF_WGU) + (size_t)e * 1024 * 1024 + (size_t)(nt * 128 + lr) * 1024;
        f32x16 acc[2][2]; zero_acc<2>(acc);
        gemm_mainloop<2>(acc, ap[0], ap[1], ap[2], ap[3], b, b + 64 * 1024, 1024, smem);
        for (int h = 0; h < 2; ++h) {
            stage_half(acc, h, smem);
            __syncthreads();
            {
                const float* Ct = (const float*)smem;
                const int r = tid >> 2, q = tid & 3;
                const int idx = mt * 256 + h * 128 + r;
                if (idx < ce) {
                    const float* src = Ct + r * CT_LD;
                    uint4 o0, o1; float hv[16];
#pragma unroll
                    for (int j = 0; j < 16; ++j) { float g = src[16 * q + j], u = src[64 + 16 * q + j]; hv[j] = siluf_(g) * u; }
                    o0.x = pack2(hv[0], hv[1]); o0.y = pack2(hv[2], hv[3]); o0.z = pack2(hv[4], hv[5]); o0.w = pack2(hv[6], hv[7]);
                    o1.x = pack2(hv[8], hv[9]); o1.y = pack2(hv[10], hv[11]); o1.z = pack2(hv[12], hv[13]); o1.w = pack2(hv[14], hv[15]);
                    bf16* d = HB + (size_t)(rowbase + idx) * 512 + nt * 64 + 16 * q;
                    *(uint4*)d = o0; *(uint4*)(d + 8) = o1;
                }
            }
            __syncthreads();
        }
    }
}

__device__ void phase_moe2(const Params& p, int l, char* smem) {
    const int tid = otid(), lr = tid >> 3;
    const int* cnt = (const int*)(p.ws + OFF_CTL) + l * 16;
    const int* lts = (const int*)(p.ws + OFF_LTS);
    const float* lw = (const float*)(p.ws + OFF_LW);
    const bf16* HB = (const bf16*)(p.ws + OFF_HB);
    bf16* YB = (bf16*)(p.ws + OFF_YB);
    int total = 0;
    for (int i = 0; i < 16; ++i) total += (cnt[i] + 255) >> 8;
    for (int t = blockIdx.x; t < total * 8; t += gridDim.x) {
        const int tile = t >> 3, nt = t & 7;
        int e, mt, rowbase, ce;
        moe_find(cnt, tile, e, mt, rowbase, ce);
        const bf16* ap[4];
#pragma unroll
        for (int i = 0; i < 4; ++i) {
            int idx = mt * 256 + lr + 64 * i; if (idx >= ce) idx = ce - 1;
            ap[i] = HB + (size_t)(rowbase + idx) * 512;
        }
        const bf16* b = (const bf16*)(p.ws + OFF_WD) + (size_t)e * 1024 * 512 + (size_t)(nt * 128 + lr) * 512;
        f32x16 acc[2][2]; zero_acc<2>(acc);
        gemm_mainloop<2>(acc, ap[0], ap[1], ap[2], ap[3], b, b + 64 * 512, 512, smem);
        for (int h = 0; h < 2; ++h) {
            stage_half(acc, h, smem);
            __syncthreads();
            {
                const float* Ct = (const float*)smem;
                const int r = tid >> 2, q = tid & 3;
                const int idx = mt * 256 + h * 128 + r;
                if (idx < ce) {
                    const int ts = lts[(size_t)e * TALL + idx]; const float w = lw[(size_t)e * TALL + idx];
                    const float* src = Ct + r * CT_LD + 32 * q;
                    float v[32];
#pragma unroll
                    for (int j = 0; j < 32; ++j) v[j] = src[j] * w;
                    store32_bf16(YB + (size_t)ts * 1024 + nt * 128 + 32 * q, v);
                }
            }
            __syncthreads();
        }
    }
}

__device__ __forceinline__ void unpack8(uint4 u, float (&f)[8]) {
    f[0] = lo2f(u.x); f[1] = hi2f(u.x); f[2] = lo2f(u.y); f[3] = hi2f(u.y); f[4] = lo2f(u.z); f[5] = hi2f(u.z); f[6] = lo2f(u.w); f[7] = hi2f(u.w);
}

__device__ void ga_naive_item(const Params& p, int item, char* smem) {
    const int tid = otid(), wave = tid >> 6, lane = tid & 63;
    float* qs = (float*)smem;
    float* inv = qs + 512;
    float* sc = qs + 528;
    bf16* QA = (bf16*)(p.ws + OFF_QA); const bf16* KA = (const bf16*)(p.ws + OFF_KA); const bf16* VA = (const bf16*)(p.ws + OFF_VA);
    int b, kvh, qrow, nkeys, keybase_lat, keybase_ctx, nlat;
    if (item < 32768) { b = item >> 13; kvh = (item >> 12) & 1; int n = item & 4095; qrow = b * SEQ + n; nkeys = 4352; nlat = 4096; }
    else { int j = item - 32768; b = j >> 9; kvh = (j >> 8) & 1; int n = j & 255; qrow = TLAT + b * CTXL + n; nkeys = 256; nlat = 0; }
    keybase_lat = b * SEQ; keybase_ctx = TLAT + b * CTXL;
    qs[tid] = bf2f(QA[(size_t)qrow * 1024 + kvh * 512 + tid]);
    __syncthreads();
    for (int m = tid; m < nkeys; m += NT) {
        const int krow = m < nlat ? keybase_lat + m : keybase_ctx + (m - nlat);
        const uint4* kp = (const uint4*)(KA + (size_t)krow * 256 + kvh * 128);
        float d0 = 0, d1 = 0, d2 = 0, d3 = 0;
#pragma unroll 4
        for (int c = 0; c < 16; ++c) {
            float kf[8]; unpack8(kp[c], kf);
#pragma unroll
            for (int j = 0; j < 8; ++j) { d0 += qs[c * 8 + j] * kf[j]; d1 += qs[128 + c * 8 + j] * kf[j]; d2 += qs[256 + c * 8 + j] * kf[j]; d3 += qs[384 + c * 8 + j] * kf[j]; }
        }
        sc[m] = d0; sc[4352 + m] = d1; sc[2 * 4352 + m] = d2; sc[3 * 4352 + m] = d3;
    }
    __syncthreads();
    if (wave < 4) {
        float* s = sc + wave * 4352;
        float mx = -1e30f;
        for (int m = lane; m < nkeys; m += 64) mx = fmaxf(mx, s[m]);
        mx = wmax(mx);
        float sum = 0;
        for (int m = lane; m < nkeys; m += 64) { float e = expf(s[m] - mx); s[m] = e; sum += e; }
        sum = wsum(sum);
        if (lane == 0) inv[wave] = 1.f / sum;
    }
    __syncthreads();
    {
        const int head = tid >> 7, d = tid & 127;
        const float* s = sc + head * 4352;
        float acc = 0;
        for (int m = 0; m < nkeys; ++m) {
            const int krow = m < nlat ? keybase_lat + m : keybase_ctx + (m - nlat);
            acc += s[m] * bf2f(VA[(size_t)krow * 256 + kvh * 128 + d]);
        }
        QA[(size_t)qrow * 1024 + kvh * 512 + tid] = f2bf(acc * inv[head]);
    }
    __syncthreads();
}

__device__ void swa_naive_item(const Params& p, int l, int item, char* smem) {
    const int tid = otid(), wave = tid >> 6, lane = tid & 63;
    float* qs = (float*)smem;
    float* inv = qs + 512;
    float* sc = qs + 528;
    bf16* QS = (bf16*)(p.ws + OFF_QS); const bf16* KS = (const bf16*)(p.ws + OFF_KS); const bf16* VS = (const bf16*)(p.ws + OFF_VS);
    int b, kvh, qrow, nl, lo;
    if (item < 32768) { b = item >> 13; kvh = (item >> 12) & 1; int n = item & 4095; qrow = b * SEQ + n; lo = n - 128 < 0 ? 0 : n - 128; int hi = n + 128 > SEQ - 1 ? SEQ - 1 : n + 128; nl = hi - lo + 1; }
    else { int j = item - 32768; b = j >> 9; kvh = (j >> 8) & 1; int n = j & 255; qrow = TLAT + b * CTXL + n; nl = 0; lo = 0; }
    const int ntot = nl + 256;
    const int kb_lat = b * SEQ + lo, kb_ctx = TLAT + b * CTXL;
    qs[tid] = bf2f(QS[(size_t)qrow * 1024 + kvh * 512 + tid]);
    __syncthreads();
    for (int kk = tid; kk < ntot; kk += NT) {
        const int krow = kk < nl ? kb_lat + kk : kb_ctx + (kk - nl);
        const uint4* kp = (const uint4*)(KS + (size_t)krow * 128 + kvh * 64);
        uint4 kr[8];
#pragma unroll
        for (int c = 0; c < 8; ++c) kr[c] = kp[c];
#pragma unroll 1
        for (int h = 0; h < 8; ++h) {
            float dd = 0.f;
            const float* qh = qs + h * 64;
#pragma unroll
            for (int c = 0; c < 8; ++c) {
                float kf[8]; unpack8(kr[c], kf);
#pragma unroll
                for (int j = 0; j < 8; ++j) dd += qh[c * 8 + j] * kf[j];
            }
            sc[h * 520 + kk] = dd;
        }
    }
    __syncthreads();
    {
        float* s = sc + wave * 520;
        const float sk = p.sink[l * 16 + kvh * 8 + wave];
        float mx = sk;
        for (int m = lane; m < ntot; m += 64) mx = fmaxf(mx, s[m]);
        mx = wmax(mx);
        float sum = 0;
        for (int m = lane; m < ntot; m += 64) { float e = expf(s[m] - mx); s[m] = e; sum += e; }
        sum = wsum(sum) + expf(sk - mx);
        if (lane == 0) inv[wave] = 1.f / sum;
    }
    __syncthreads();
    {
        const int head = tid >> 6, d = tid & 63;
        const float* s = sc + head * 520;
        float acc = 0;
        for (int kk = 0; kk < ntot; ++kk) {
            const int krow = kk < nl ? kb_lat + kk : kb_ctx + (kk - nl);
            acc += s[kk] * bf2f(VS[(size_t)krow * 128 + kvh * 64 + d]);
        }
        QS[(size_t)qrow * 1024 + kvh * 512 + tid] = f2bf(acc * inv[head]);
    }
    __syncthreads();
}

__device__ void ret_naive_item(const Params& p, int l, int item, char* smem) {
    const int tid = otid(), wave = tid >> 6, lane = tid & 63;
    float* qs = (float*)smem;
    float* red = qs + 128;
    float* sc = qs + 528;
    const bf16* QR = (const bf16*)(p.ws + OFF_QR); const bf16* KR = (const bf16*)(p.ws + OFF_KR); const bf16* VR = (const bf16*)(p.ws + OFF_VR);
    bf16* UR = (bf16*)(p.ws + OFF_UR);
    int b, h, n, qrow, nkeys, nlat; bool isctx;
    if (item < 65536) { b = item >> 14; h = (item >> 12) & 3; n = item & 4095; qrow = b * SEQ + n; nkeys = 4352; nlat = 4096; isctx = false; }
    else { int j = item - 65536; b = j >> 10; h = (j >> 8) & 3; n = j & 255; qrow = TLAT + b * CTXL + n; nkeys = 256; nlat = 0; isctx = true; }
    const float xf = p.ret_logit[l * 8 + h], xb = p.ret_logit[l * 8 + 4 + h];
    const float lgf = -log1pf(expf(-xf)), lgb = -log1pf(expf(-xb));
    const int kb_lat = b * SEQ, kb_ctx = TLAT + b * CTXL;
    if (tid < 128) qs[tid] = bf2f(QR[(size_t)qrow * 512 + h * 128 + tid]);
    __syncthreads();
    for (int m = tid; m < nkeys; m += NT) {
        const int krow = m < nlat ? kb_lat + m : kb_ctx + (m - nlat);
        const uint4* kp = (const uint4*)(KR + (size_t)krow * 512 + h * 128);
        float d0 = 0;
#pragma unroll 4
        for (int c = 0; c < 16; ++c) {
            float kf[8]; unpack8(kp[c], kf);
#pragma unroll
            for (int j = 0; j < 8; ++j) d0 += qs[c * 8 + j] * kf[j];
        }
        float dec;
        if (isctx) { int dd = n - m; dec = dd >= 0 ? expf((float)dd * lgf) : expf((float)(-dd) * lgb); }
        else if (m < nlat) { int dd = n - m; dec = dd >= 0 ? expf((float)dd * lgf) : expf((float)(-dd) * lgb); }
        else { int j = m - nlat; dec = expf((float)(n + 256 - j) * lgf) + expf((float)(SEQ - n + j) * lgb); }
        sc[m] = d0 * dec;
    }
    __syncthreads();
    const int e = tid & 255, half = tid >> 8;
    float acc = 0;
    {
        const int mh = nkeys >> 1;
        for (int m = half * mh; m < half * mh + mh; ++m) {
            const int krow = m < nlat ? kb_lat + m : kb_ctx + (m - nlat);
            acc += sc[m] * bf2f(VR[(size_t)krow * 1024 + h * 256 + e]);
        }
    }
    if (half == 1) red[e] = acc;
    __syncthreads();
    float ss = 0;
    if (half == 0) { acc += red[e]; ss = acc * acc; }
    ss = wsum(ss);
    if (lane == 0) red[256 + wave] = ss;
    __syncthreads();
    if (half == 0) {
        float tot = red[256] + red[257] + red[258] + red[259];
        float rstd = rsqrtf(tot * (1.f / 256.f) + EPS);
        size_t idx = (size_t)qrow * 1024 + h * 256 + e;
        float u = bf2f(UR[idx]);
        UR[idx] = f2bf(acc * rstd * siluf_(u));
    }
    __syncthreads();
}


namespace ga {
using s16x4  = __attribute__((ext_vector_type(4))) short;
using u32x4  = __attribute__((ext_vector_type(4))) unsigned;
constexpr int QBLK = 32, KVBLK = 64;
constexpr float SCALE = 0.088388347648318440f;
constexpr float THR = 8.f;
constexpr int LDQ = 1024, LDK = 256, LDO = 1024;
constexpr int SHM_V = KVBLK * 128 * 2, SHM_K = KVBLK * 128 * 2;
constexpr int SHM_ATTN = 2 * SHM_V + 2 * SHM_K + 8 * 64 * 4;
#define KSWZ(row, colB) ((row) * 256 + ((colB) ^ (((row) & 7) << 4)))
#define SBAR() __builtin_amdgcn_sched_barrier(0)
__device__ __forceinline__ int crow(int r, int hi) { return (r & 3) + 8 * (r >> 2) + 4 * hi; }
__device__ __forceinline__ unsigned cvtpk(float lo, float hi) {
  unsigned r; asm volatile("v_cvt_pk_bf16_f32 %0, %1, %2" : "=v"(r) : "v"(lo), "v"(hi)); return r;
}
__device__ __forceinline__ void partialSM(f32x16& p0, f32x16& p1, float& m_reg, float& mn, float& alpha) {
  constexpr float C = SCALE * 1.4426950408889634f;
  float pmax = p0[0];
#pragma unroll
  for (int r = 1; r < 16; ++r) pmax = fmaxf(pmax, p0[r]);
#pragma unroll
  for (int r = 0; r < 16; ++r) pmax = fmaxf(pmax, p1[r]);
  { auto rr = __builtin_amdgcn_permlane32_swap(__float_as_uint(pmax), __float_as_uint(pmax), false, false);
    pmax = fmaxf(__uint_as_float(rr[0]), __uint_as_float(rr[1])); }
  if (__builtin_expect(__all(pmax - m_reg <= THR / SCALE), 1)) { mn = m_reg; alpha = 1.f; }
  else { mn = fmaxf(m_reg, pmax); alpha = __builtin_amdgcn_exp2f((m_reg - mn) * C); m_reg = mn; }
  float mnC = -mn * C;
#pragma unroll
  for (int r = 0; r < 16; ++r) p0[r] = fmaf(p0[r], C, mnC);
#pragma unroll
  for (int r = 0; r < 16; ++r) p1[r] = fmaf(p1[r], C, mnC);
#pragma unroll
  for (int r = 0; r < 16; ++r) p0[r] = __builtin_amdgcn_exp2f(p0[r]);
}
__device__ __forceinline__ void finishSM(f32x16& p0, f32x16& p1, float alpha, float& l_reg, bf16x8& pa0, bf16x8& pa1, bf16x8& pa2, bf16x8& pa3) {
#pragma unroll
  for (int r = 0; r < 16; ++r) p1[r] = __builtin_amdgcn_exp2f(p1[r]);
  float ps = 0;
#pragma unroll
  for (int r = 0; r < 16; ++r) ps += p0[r];
#pragma unroll
  for (int r = 0; r < 16; ++r) ps += p1[r];
  { auto rr = __builtin_amdgcn_permlane32_swap(__float_as_uint(ps), __float_as_uint(ps), false, false);
    ps = __uint_as_float(rr[0]) + __uint_as_float(rr[1]); }
  l_reg = l_reg * alpha + ps;
#define PK4(P, BASE, OUT) do { unsigned a0 = cvtpk(P[BASE + 0], P[BASE + 1]), a1 = cvtpk(P[BASE + 2], P[BASE + 3]);   \
    unsigned b0 = cvtpk(P[BASE + 4], P[BASE + 5]), b1 = cvtpk(P[BASE + 6], P[BASE + 7]);                              \
    auto r0 = __builtin_amdgcn_permlane32_swap(a0, b0, false, false); auto r1 = __builtin_amdgcn_permlane32_swap(a1, b1, false, false); \
    u32x4 w = {r0[0], r1[0], r0[1], r1[1]}; OUT = *reinterpret_cast<bf16x8*>(&w); } while (0)
  PK4(p0, 0, pa0); PK4(p0, 8, pa1); PK4(p1, 0, pa2); PK4(p1, 8, pa3);
#undef PK4
}
__device__ __forceinline__ void qkt(f32x16& p0, f32x16& p1, const char* Ks, const bf16x8* qr, int r32, int hi) {
  p0 = f32x16{}; p1 = f32x16{};
#pragma unroll
  for (int d0 = 0; d0 < 8; ++d0) { int cb = (d0 * 16 + hi * 8) * 2;
    bf16x8 b0 = *reinterpret_cast<const bf16x8*>(Ks + KSWZ(r32, cb));
    bf16x8 b1 = *reinterpret_cast<const bf16x8*>(Ks + KSWZ(32 + r32, cb));
    p0 = __builtin_amdgcn_mfma_f32_32x32x16_bf16(b0, qr[d0], p0, 0, 0, 0);
    p1 = __builtin_amdgcn_mfma_f32_32x32x16_bf16(b1, qr[d0], p1, 0, 0, 0); }
}
__device__ __forceinline__ int v_st(int k, int c) { const int kk = (k & ~0xC) | ((k & 4) << 1) | ((k & 8) >> 1); return ((kk >> 3) * 4 + (c >> 5)) * 512 + ((kk & 7) * 32 + (c & 31)) * 2; }
__device__ __forceinline__ int v_rd_base(int lane) { return ((lane & 3) << 3) | (((lane >> 2) & 3) << 6) | (((lane >> 4) & 1) << 5) | (((lane >> 5) & 1) << 8); }
constexpr int v_rd_off(int d0, int ks, int half) { return d0 * 512 + ks * 4096 + half * 2048; }
template <int OFF> __device__ __forceinline__ s16x4 tr_read(int vb) {
  s16x4 r; asm volatile("ds_read_b64_tr_b16 %0, %1 offset:%2" : "=&v"(r) : "v"(vb), "i"(OFF) : "memory"); return r;
}
template <int D0> __device__ __forceinline__ void pv_one(f32x16& od, int vb, bf16x8 pa0, bf16x8 pa1, bf16x8 pa2, bf16x8 pa3) {
  const s16x4 l0 = tr_read<v_rd_off(D0, 0, 0)>(vb), h0 = tr_read<v_rd_off(D0, 0, 1)>(vb), l1 = tr_read<v_rd_off(D0, 1, 0)>(vb), h1 = tr_read<v_rd_off(D0, 1, 1)>(vb);
  const s16x4 l2 = tr_read<v_rd_off(D0, 2, 0)>(vb), h2 = tr_read<v_rd_off(D0, 2, 1)>(vb), l3 = tr_read<v_rd_off(D0, 3, 0)>(vb), h3 = tr_read<v_rd_off(D0, 3, 1)>(vb);
  asm volatile("s_waitcnt lgkmcnt(0)" ::: "memory"); SBAR();
#define PK(L, H) (bf16x8){L[0], L[1], L[2], L[3], H[0], H[1], H[2], H[3]}
  od = __builtin_amdgcn_mfma_f32_32x32x16_bf16(pa0, PK(l0, h0), od, 0, 0, 0);
  od = __builtin_amdgcn_mfma_f32_32x32x16_bf16(pa1, PK(l1, h1), od, 0, 0, 0);
  od = __builtin_amdgcn_mfma_f32_32x32x16_bf16(pa2, PK(l2, h2), od, 0, 0, 0);
  od = __builtin_amdgcn_mfma_f32_32x32x16_bf16(pa3, PK(l3, h3), od, 0, 0, 0);
#undef PK
}
__device__ __forceinline__ void pv_d0(f32x16* o, int vb, bf16x8 pa0, bf16x8 pa1, bf16x8 pa2, bf16x8 pa3) {
  pv_one<0>(o[0], vb, pa0, pa1, pa2, pa3); pv_one<1>(o[1], vb, pa0, pa1, pa2, pa3); pv_one<2>(o[2], vb, pa0, pa1, pa2, pa3); pv_one<3>(o[3], vb, pa0, pa1, pa2, pa3);
}

__device__ __forceinline__ void attn_dense_body(bf16* Qb, const bf16* Klat, const bf16* Vlat, const bf16* Kctx, const bf16* Vctx,
                                                int nlat, int seq, char* lds) {
  const int tid = otid(), wid = tid >> 6, lane = tid & 63, r32 = lane & 31, hi = lane >> 5;
  char* V_lds = lds; char* K_lds = lds + 2 * SHM_V;
  float* wsl = (float*)(lds + 2 * SHM_V + 2 * SHM_K) + wid * 64; float* li_l = wsl; float* al_l = wsl + 32;
  float m_reg = -1e30f, l_reg = 0; f32x16 o[4] = {}; bf16x8 qr[8];
  const bf16* Qw = Qb + (long)(wid * QBLK + r32) * LDQ + hi * 8;
#pragma unroll
  for (int d0 = 0; d0 < 8; ++d0) qr[d0] = *reinterpret_cast<const bf16x8*>(Qw + d0 * 16);
  const int sr = tid >> 4, sc = (tid & 15) * 8, vst0 = v_st(sr, sc), vst1 = v_st(32 + sr, sc);
  const int vb0 = (int)(uintptr_t)V_lds + v_rd_base(lane);
  struct { bf16x8 vs0, vs1, ks0, ks1; } sr_[2];
#define KVROW(k0) ((k0) < nlat ? (long)(k0) * LDK : (long)((k0) - nlat) * LDK)
#define SLOAD(i, k0) do { const bf16* kb_ = ((k0) < nlat ? Klat : Kctx) + KVROW(k0); const bf16* vb_ = ((k0) < nlat ? Vlat : Vctx) + KVROW(k0); \
    sr_[i].vs0 = *reinterpret_cast<const bf16x8*>(vb_ + (long)sr * LDK + sc); sr_[i].vs1 = *reinterpret_cast<const bf16x8*>(vb_ + (long)(32 + sr) * LDK + sc); \
    sr_[i].ks0 = *reinterpret_cast<const bf16x8*>(kb_ + (long)sr * LDK + sc); sr_[i].ks1 = *reinterpret_cast<const bf16x8*>(kb_ + (long)(32 + sr) * LDK + sc); } while (0)
#define SWRITE(b, i) do { *(bf16x8*)(V_lds + (b) * SHM_V + vst0) = sr_[i].vs0;          \
    *(bf16x8*)(V_lds + (b) * SHM_V + vst1) = sr_[i].vs1; int kc = sc * 2;               \
    *(bf16x8*)(K_lds + (b) * SHM_K + KSWZ(sr, kc)) = sr_[i].ks0;                       \
    *(bf16x8*)(K_lds + (b) * SHM_K + KSWZ(32 + sr, kc)) = sr_[i].ks1; } while (0)
#define SWAIT() asm volatile("s_waitcnt vmcnt(4)" ::: "memory")
#define RESC(a) do { if (__any((a) < 1.f)) { if (hi == 0) al_l[r32] = (a); asm volatile("s_waitcnt lgkmcnt(0)" ::: "memory"); \
    _Pragma("unroll") for (int d = 0; d < 4; ++d) _Pragma("unroll") for (int r = 0; r < 16; ++r) o[d][r] *= al_l[crow(r, hi)]; } } while (0)
  f32x16 pA0, pA1, pB0, pB1; float mnA, mnB, alA, alB; bf16x8 pa0, pa1, pa2, pa3; const int NTL = seq / KVBLK;
  constexpr int SE = 0, SO = 1;
  SLOAD(SE, 0); asm volatile("s_waitcnt vmcnt(0)" ::: "memory"); SWRITE(0, SE); __syncthreads();
  qkt(pA0, pA1, K_lds, qr, r32, hi); partialSM(pA0, pA1, m_reg, mnA, alA);
  SLOAD(SO, KVBLK); if (2 < NTL) SLOAD(SE, 2 * KVBLK);
  SWAIT(); SWRITE(1, SO); __syncthreads();
  for (int j = 1; j + 1 < NTL; j += 2) {
    SBAR(); qkt(pB0, pB1, K_lds + SHM_K, qr, r32, hi);
    finishSM(pA0, pA1, alA, l_reg, pa0, pa1, pa2, pa3); SBAR();
    SLOAD(SO, (j + 2) * KVBLK); SBAR();
    pv_d0(o, vb0, pa0, pa1, pa2, pa3); partialSM(pB0, pB1, m_reg, mnB, alB);
    __syncthreads(); SWAIT(); SWRITE(0, SE);
    RESC(alB); __syncthreads();
    SBAR(); qkt(pA0, pA1, K_lds, qr, r32, hi);
    finishSM(pB0, pB1, alB, l_reg, pa0, pa1, pa2, pa3); SBAR();
    if (j + 3 < NTL) SLOAD(SE, (j + 3) * KVBLK); SBAR();
    pv_d0(o, vb0 + (int)SHM_V, pa0, pa1, pa2, pa3); partialSM(pA0, pA1, m_reg, mnA, alA);
    __syncthreads(); SWAIT(); SWRITE(1, SO);
    RESC(alA); __syncthreads();
  }
  SBAR(); qkt(pB0, pB1, K_lds + SHM_K, qr, r32, hi);
  finishSM(pA0, pA1, alA, l_reg, pa0, pa1, pa2, pa3); SBAR();
  pv_d0(o, vb0, pa0, pa1, pa2, pa3); partialSM(pB0, pB1, m_reg, mnB, alB);
  __syncthreads(); RESC(alB);
  finishSM(pB0, pB1, alB, l_reg, pa0, pa1, pa2, pa3); SBAR();
  pv_d0(o, vb0 + (int)SHM_V, pa0, pa1, pa2, pa3);
  if (hi == 0) li_l[r32] = l_reg; asm volatile("s_waitcnt lgkmcnt(0)" ::: "memory");
  float rli[16];
#pragma unroll
  for (int r = 0; r < 16; ++r) rli[r] = __builtin_amdgcn_rcpf(li_l[crow(r, hi)]);
  bf16* Ow = Qb + (long)(wid * QBLK) * LDO;
#pragma unroll
  for (int r = 0; r < 16; ++r) { int orow = crow(r, hi);
#pragma unroll
    for (int d0 = 0; d0 < 4; ++d0) Ow[(long)orow * LDO + d0 * 32 + r32] = f2bf(o[d0][r] * rli[r]); }
  __syncthreads();
#undef KVROW
#undef SLOAD
#undef SWRITE
#undef SWAIT
#undef RESC
}
#undef KSWZ
}

__device__ void phase_ga(const Params& p, int l, char* smem) {
    bf16* QA = (bf16*)(p.ws + OFF_QA); const bf16* KA = (const bf16*)(p.ws + OFF_KA); const bf16* VA = (const bf16*)(p.ws + OFF_VA);
    const int nitems = 512 + (l == 0 ? 32 : 0);
    for (int it = blockIdx.x; it < nitems; it += gridDim.x) {
        if (it < 512) {
            const int pair = it & 7, j = it >> 3, hg = j >> 4, qb = j & 15, b = pair >> 1, kvh = pair & 1, head = kvh * 4 + hg;
            ga::attn_dense_body(QA + (size_t)(b * SEQ + qb * 256) * 1024 + head * 128,
                                KA + (size_t)(b * SEQ) * 256 + kvh * 128, VA + (size_t)(b * SEQ) * 256 + kvh * 128,
                                KA + (size_t)(TLAT + b * CTXL) * 256 + kvh * 128, VA + (size_t)(TLAT + b * CTXL) * 256 + kvh * 128,
                                4096, 4352, smem);
        } else {
            const int j = it - 512, b = j >> 3, head = j & 7, kvh = head >> 2;
            const bf16* kc = KA + (size_t)(TLAT + b * CTXL) * 256 + kvh * 128; const bf16* vc = VA + (size_t)(TLAT + b * CTXL) * 256 + kvh * 128;
            ga::attn_dense_body(QA + (size_t)(TLAT + b * CTXL) * 1024 + head * 128, kc, vc, kc, vc, 0, 256, smem);
        }
    }
}


__device__ __forceinline__ int chunk_key0(int c) { return c < 32 ? c * 128 : 4096 + (c - 32) * 128; }

__device__ void phase_ret1(const Params& p, int l, char* smem) {
    const int tid = otid(), lr = tid >> 3;
    const bf16* VT = (const bf16*)(p.ws + OFF_VR);
    bf16* F = (bf16*)(p.ws + OFF_F);
    for (int it = blockIdx.x; it < 16 * 34 * 2; it += gridDim.x) {
        const int dir = it & 1, j = it >> 1, c = j % 34, bh = j / 34;
        const int key0 = chunk_key0(c);
        const bf16* KT = (const bf16*)(p.ws + (dir ? OFF_KBT : OFF_KFT));
        const bf16* a = VT + ((size_t)bh * 256 + lr) * KEYS + key0;
        const bf16* b = KT + ((size_t)bh * 128 + lr) * KEYS + key0;
        f32x16 acc[2][2]; zero_acc<2>(acc);
        gemm_mainloop<2>(acc, a, a + 64 * KEYS, a + 128 * KEYS, a + 192 * KEYS, b, b + 64 * KEYS, 128, smem);
        bf16* dst = F + ((size_t)(dir * 16 + bh) * 34 + c) * 32768;
        for (int h = 0; h < 2; ++h) {
            stage_half(acc, h, smem);
            __syncthreads();
            epi_plain_bf16((const float*)smem, dst, 128, h * 128, 0);
            __syncthreads();
        }
    }
}

__device__ void phase_ret_scan(const Params& p, int l) {
    const int tid = otid();
    unsigned* F = (unsigned*)(p.ws + OFF_F);
    for (int g = blockIdx.x * NT + tid; g < 2 * 16 * 16384; g += gridDim.x * NT) {
        const int e2 = g & 16383, bh = (g >> 14) & 15, dir = g >> 18, h = bh & 3;
        const float lg = log_sigmoid_(p.ret_logit[l * 8 + dir * 4 + h]);
        const float g128 = expf(128.f * lg);
        unsigned* base = F + (size_t)(dir * 16 + bh) * 34 * 16384 + e2;
        float s0 = 0.f, s1 = 0.f;
        for (int k = 0; k < 34; ++k) {
            int c;
            if (dir == 0) c = k == 0 ? 32 : (k == 1 ? 33 : k - 2);
            else c = k == 0 ? 33 : (k == 1 ? 32 : 33 - k);
            unsigned* ptr = base + (size_t)c * 16384;
            unsigned u = *ptr;
            *ptr = pack2(s0, s1);
            s0 = g128 * s0 + lo2f(u); s1 = g128 * s1 + hi2f(u);
        }
    }
}

__device__ void phase_ret3(const Params& p, int l, char* smem) {
    const int tid = otid(), lane = tid & 63, wave = tid >> 6, wm = wave >> 1, wn = wave & 1, lr = tid >> 3;
    const bf16* QR = (const bf16*)(p.ws + OFF_QR); const bf16* KR = (const bf16*)(p.ws + OFF_KR);
    const bf16* VT = (const bf16*)(p.ws + OFF_VR); bf16* UR = (bf16*)(p.ws + OFF_UR);
    const bf16* F = (const bf16*)(p.ws + OFF_F);
    bf16* SMs = (bf16*)(p.ws + OFF_SM) + (size_t)blockIdx.x * 128 * 128;
    float* red = (float*)(smem + 100 * 1024);
    const int nitems = 512 + (l == 0 ? 32 : 0);
    for (int it = blockIdx.x; it < nitems; it += gridDim.x) {
        int b, h, c;
        if (it < 512) { c = it & 31; h = (it >> 5) & 3; b = it >> 7; }
        else { int j = it - 512; c = 32 + (j & 1); h = (j >> 1) & 3; b = j >> 3; }
        const int bh = b * 4 + h;
        const int key0 = chunk_key0(c);
        const int row0 = c < 32 ? b * SEQ + c * 128 : TLAT + b * CTXL + (c - 32) * 128;
        const float lgf = log_sigmoid_(p.ret_logit[l * 8 + h]), lgb = log_sigmoid_(p.ret_logit[l * 8 + 4 + h]);
        const bf16* qrow = QR + (size_t)(row0 + lr) * 512 + h * 128;
        {
            f32x16 acc[1][2]; zero_acc<1>(acc);
            const bf16* kb = KR + (size_t)(row0 + lr) * 512 + h * 128;
            gemm_mainloop<1>(acc, qrow, qrow + 64 * 512, qrow, qrow, kb, kb + 64 * 512, 128, smem);
            stage_full(acc, smem);
            __syncthreads();
            const float* Ct = (const float*)smem;
            const int r = tid >> 2, q = tid & 3;
            float v[32];
#pragma unroll
            for (int jj = 0; jj < 32; ++jj) {
                const int j = 32 * q + jj; const int dd = r - j;
                const float dec = dd >= 0 ? expf((float)dd * lgf) : expf((float)(-dd) * lgb);
                v[jj] = Ct[r * CT_LD + j] * dec;
            }
            store32_bf16(SMs + (size_t)r * 128 + 32 * q, v);
            __threadfence_block();
            __syncthreads();
        }
        f32x16 acc[2][2]; zero_acc<2>(acc);
        {
            const bf16* a = VT + ((size_t)bh * 256 + lr) * KEYS + key0;
            const bf16* bb = SMs + (size_t)lr * 128;
            gemm_mainloop<2>(acc, a, a + 64 * KEYS, a + 128 * KEYS, a + 192 * KEYS, bb, bb + 64 * 128, 128, smem);
        }
        {
            const bf16* a = F + ((size_t)(0 * 16 + bh) * 34 + c) * 32768 + (size_t)lr * 128;
            gemm_mainloop<2, true>(acc, a, a + 64 * 128, a + 128 * 128, a + 192 * 128, qrow, qrow + 64 * 512, 128, smem,
                                   expf((float)(lr + 1) * lgf), expf((float)(lr + 65) * lgf));
        }
        {
            const bf16* a = F + ((size_t)(1 * 16 + bh) * 34 + c) * 32768 + (size_t)lr * 128;
            gemm_mainloop<2, true>(acc, a, a + 64 * 128, a + 128 * 128, a + 192 * 128, qrow, qrow + 64 * 512, 128, smem,
                                   expf((float)(128 - lr) * lgb), expf((float)(64 - lr) * lgb));
        }
        {
            float ss0 = 0.f, ss1 = 0.f;
#pragma unroll
            for (int mi = 0; mi < 2; ++mi)
#pragma unroll
                for (int r = 0; r < 16; ++r) { ss0 += acc[mi][0][r] * acc[mi][0][r]; ss1 += acc[mi][1][r] * acc[mi][1][r]; }
            ss0 += __shfl_xor(ss0, 32, 64); ss1 += __shfl_xor(ss1, 32, 64);
            if (lane < 32) { red[wm * 128 + wn * 64 + lane] = ss0; red[wm * 128 + wn * 64 + 32 + lane] = ss1; }
            __syncthreads();
            if (tid < 128) red[512 + tid] = rsqrtf((red[tid] + red[128 + tid] + red[256 + tid] + red[384 + tid]) * (1.f / 256.f) + EPS);
            __syncthreads();
        }
        for (int h2 = 0; h2 < 2; ++h2) {
            float* Ct = (float*)smem;
            if ((wm >> 1) == h2) {
#pragma unroll
                for (int mi = 0; mi < 2; ++mi)
#pragma unroll
                    for (int ni = 0; ni < 2; ++ni)
#pragma unroll
                        for (int r = 0; r < 16; ++r) {
                            const int el = (wm & 1) * 64 + mi * 32 + (r & 3) + 8 * (r >> 2) + 4 * (lane >> 5);
                            const int i = wn * 64 + ni * 32 + (lane & 31);
                            Ct[i * 133 + el] = acc[mi][ni][r];
                        }
            }
            __syncthreads();
            {
                const int i = tid >> 2, qq = tid & 3;
                const float rs = red[512 + i];
                bf16* up = UR + (size_t)(row0 + i) * 1024 + h * 256 + h2 * 128 + 32 * qq;
#pragma unroll
                for (int g = 0; g < 4; ++g) {
                    uint4 uu = *(const uint4*)(up + g * 8);
                    float uf[8]; unpack8(uu, uf);
                    float o[8];
#pragma unroll
                    for (int j = 0; j < 8; ++j) o[j] = Ct[i * 133 + 32 * qq + g * 8 + j] * rs * siluf_(uf[j]);
                    uint4 ov; ov.x = pack2(o[0], o[1]); ov.y = pack2(o[2], o[3]); ov.z = pack2(o[4], o[5]); ov.w = pack2(o[6], o[7]);
                    *(uint4*)(up + g * 8) = ov;
                }
            }
            __syncthreads();
        }
    }
}


namespace swa {
constexpr int KROWB = 144, VROWB = 136;
constexpr int KT_BYTES = 64 * KROWB, VT_BYTES = 64 * VROWB, BUF_BYTES = KT_BYTES + VT_BYTES;
constexpr float LOG2E = 1.4426950408889634f;
constexpr float THR = 8.f;
__device__ __forceinline__ int crow(int r, int hi) { return (r & 3) + 8 * (r >> 2) + 4 * hi; }

__device__ __forceinline__ void body(const Params& p, int l, int b, int kvh, int qrow0, int q0pos, char* lds) {
    const int tid = otid(), wid = tid >> 6, lane = tid & 63, r32 = lane & 31, hi = lane >> 5;
    bf16* QS = (bf16*)(p.ws + OFF_QS); const bf16* KS = (const bf16*)(p.ws + OFF_KS); const bf16* VT = (const bf16*)(p.ws + OFF_VS);
    float* wsl = (float*)(lds + 2 * BUF_BYTES) + wid * 64; float* li_l = wsl; float* al_l = wsl + 32;
    const int head = kvh * 8 + wid;
    const float sinkv = p.sink[l * 16 + head];
    float m_reg = sinkv, l_reg = 1.f;
    f32x16 o[2] = {};
    bf16x8 qr[4];
    bf16* Qw = QS + (size_t)(qrow0 + r32) * 1024 + head * 64 + hi * 8;
#pragma unroll
    for (int d0 = 0; d0 < 4; ++d0) qr[d0] = *reinterpret_cast<const bf16x8*>(Qw + d0 * 16);
    int t0 = 0, nloc = 0;
    if (q0pos >= 0) {
        const int lo = q0pos - 128 < 0 ? 0 : q0pos - 128, hiq = q0pos + 160 > SEQ ? SEQ : q0pos + 160;
        t0 = lo >> 6; nloc = ((hiq - 1) >> 6) - t0 + 1;
    }
    const int ntiles = nloc + 4;
    const int sk = tid >> 3, sch = tid & 7;
    const bf16* vtb = VT + ((size_t)(b * 2 + kvh) * 64 + sk) * KEYS + sch * 8;
    uint4 rk, rv;
#define TLOAD(t) do { const int t_ = (t); const bool loc_ = t_ < nloc; const int key0_ = loc_ ? (t0 + t_) * 64 : 4096 + (t_ - nloc) * 64; \
        const int krow_ = loc_ ? b * SEQ + key0_ : TLAT + b * CTXL + (t_ - nloc) * 64; \
        rk = *(const uint4*)(KS + (size_t)(krow_ + sk) * 128 + kvh * 64 + sch * 8); rv = *(const uint4*)(vtb + key0_); } while (0)
#define TWRITE(buf) do { char* kb_ = lds + (buf) * BUF_BYTES; *(uint4*)(kb_ + sk * KROWB + sch * 16) = rk; \
        char* vb_ = kb_ + KT_BYTES + sk * VROWB + sch * 16; *(uint2*)vb_ = make_uint2(rv.x, rv.y); *(uint2*)(vb_ + 8) = make_uint2(rv.z, rv.w); } while (0)
    TLOAD(0); TWRITE(0); __syncthreads();
    for (int t = 0; t < ntiles; ++t) {
        const char* Kb = lds + (t & 1) * BUF_BYTES; const char* Vb = Kb + KT_BYTES;
        const bool more = t + 1 < ntiles;
        if (more) TLOAD(t + 1);
        f32x16 p0 = {}, p1 = {};
#pragma unroll
        for (int d0 = 0; d0 < 4; ++d0) {
            bf16x8 k0 = *reinterpret_cast<const bf16x8*>(Kb + r32 * KROWB + (d0 * 16 + hi * 8) * 2);
            bf16x8 k1 = *reinterpret_cast<const bf16x8*>(Kb + (32 + r32) * KROWB + (d0 * 16 + hi * 8) * 2);
            p0 = __builtin_amdgcn_mfma_f32_32x32x16_bf16(k0, qr[d0], p0, 0, 0, 0);
            p1 = __builtin_amdgcn_mfma_f32_32x32x16_bf16(k1, qr[d0], p1, 0, 0, 0);
        }
        if (t < nloc) {
            const int kbase = (t0 + t) * 64 - (q0pos + r32);
#pragma unroll
            for (int r = 0; r < 16; ++r) {
                int d0_ = kbase + crow(r, hi); int d1_ = d0_ + 32;
                if (d0_ < -128 || d0_ > 128) p0[r] = -1e30f;
                if (d1_ < -128 || d1_ > 128) p1[r] = -1e30f;
            }
        }
        float pmax = p0[0];
#pragma unroll
        for (int r = 1; r < 16; ++r) pmax = fmaxf(pmax, p0[r]);
#pragma unroll
        for (int r = 0; r < 16; ++r) pmax = fmaxf(pmax, p1[r]);
        { auto rr = __builtin_amdgcn_permlane32_swap(__float_as_uint(pmax), __float_as_uint(pmax), false, false);
          pmax = fmaxf(__uint_as_float(rr[0]), __uint_as_float(rr[1])); }
        float alpha = 1.f;
        if (!__all(pmax - m_reg <= THR)) {
            const float mn = fmaxf(m_reg, pmax);
            alpha = __builtin_amdgcn_exp2f((m_reg - mn) * LOG2E); m_reg = mn;
            if (hi == 0) al_l[r32] = alpha;
            asm volatile("s_waitcnt lgkmcnt(0)" ::: "memory");
#pragma unroll
            for (int d = 0; d < 2; ++d)
#pragma unroll
                for (int r = 0; r < 16; ++r) o[d][r] *= al_l[crow(r, hi)];
        }
        const float mC = -m_reg * LOG2E;
        float ps = 0.f;
#pragma unroll
        for (int r = 0; r < 16; ++r) { p0[r] = __builtin_amdgcn_exp2f(fmaf(p0[r], LOG2E, mC)); ps += p0[r]; }
#pragma unroll
        for (int r = 0; r < 16; ++r) { p1[r] = __builtin_amdgcn_exp2f(fmaf(p1[r], LOG2E, mC)); ps += p1[r]; }
        { auto rr = __builtin_amdgcn_permlane32_swap(__float_as_uint(ps), __float_as_uint(ps), false, false);
          ps = __uint_as_float(rr[0]) + __uint_as_float(rr[1]); }
        l_reg = l_reg * alpha + ps;
#pragma unroll
        for (int s4 = 0; s4 < 4; ++s4) {
            unsigned w0, w1, w2, w3;
            if (s4 < 2) { w0 = pack2(p0[8 * s4 + 0], p0[8 * s4 + 1]); w1 = pack2(p0[8 * s4 + 2], p0[8 * s4 + 3]); w2 = pack2(p0[8 * s4 + 4], p0[8 * s4 + 5]); w3 = pack2(p0[8 * s4 + 6], p0[8 * s4 + 7]); }
            else { const int s2 = s4 - 2; w0 = pack2(p1[8 * s2 + 0], p1[8 * s2 + 1]); w1 = pack2(p1[8 * s2 + 2], p1[8 * s2 + 3]); w2 = pack2(p1[8 * s2 + 4], p1[8 * s2 + 5]); w3 = pack2(p1[8 * s2 + 6], p1[8 * s2 + 7]); }
            ga::u32x4 pw = {w0, w1, w2, w3};
            bf16x8 pa = *reinterpret_cast<bf16x8*>(&pw);
#pragma unroll
            for (int db = 0; db < 2; ++db) {
                const char* vp = Vb + (db * 32 + r32) * VROWB + (16 * s4 + 4 * hi) * 2;
                uint2 lo = *(const uint2*)vp, hi2 = *(const uint2*)(vp + 16);
                ga::u32x4 bw = {lo.x, lo.y, hi2.x, hi2.y};
                bf16x8 vb = *reinterpret_cast<bf16x8*>(&bw);
                o[db] = __builtin_amdgcn_mfma_f32_32x32x16_bf16(pa, vb, o[db], 0, 0, 0);
            }
        }
        if (more) TWRITE((t + 1) & 1);
        __syncthreads();
    }
    if (hi == 0) li_l[r32] = l_reg;
    asm volatile("s_waitcnt lgkmcnt(0)" ::: "memory");
    bf16* Ow = QS + (size_t)qrow0 * 1024 + head * 64;
#pragma unroll
    for (int r = 0; r < 16; ++r) {
        const int orow = crow(r, hi); const float rl = 1.f / li_l[orow];
#pragma unroll
        for (int db = 0; db < 2; ++db) Ow[(size_t)orow * 1024 + db * 32 + r32] = f2bf(o[db][r] * rl);
    }
    __syncthreads();
#undef TLOAD
#undef TWRITE
}
}

__device__ void phase_swa(const Params& p, int l, char* smem) {
    const int nitems = 1024 + (l == 0 ? 64 : 0);
    for (int it = blockIdx.x; it < nitems; it += gridDim.x) {
        if (it < 1024) {
            const int pair = it & 7, j = it >> 3, b = pair >> 1, kvh = pair & 1;
            swa::body(p, l, b, kvh, b * SEQ + j * 32, j * 32, smem);
        } else {
            const int j = it - 1024, pair = j & 7, qb = j >> 3, b = pair >> 1, kvh = pair & 1;
            swa::body(p, l, b, kvh, TLAT + b * CTXL + qb * 32, -1, smem);
        }
    }
}

__device__ void phase_mixers_naive(const Params& p, int l, char* smem) {
    const int n_sw = 32768 + (l == 0 ? 2048 : 0);
    for (int it = blockIdx.x; it < n_sw; it += gridDim.x) swa_naive_item(p, l, it, smem);
}

constexpr int PH_PER_LAYER = 10;
constexpr int NPHASE = 2 + 2 * PH_PER_LAYER;
constexpr int LDS_BYTES = GEMM_LDS;

__device__ void run_phase(const Params& p, int ph, char* smem) {
#ifndef PHASE_MASK
    if (ph == 0) { phase0(p, smem); return; }
    if (ph == NPHASE - 1) { phase_final(p); return; }
#else
    if (ph == 0 || ph == NPHASE - 1) return;
#endif
    const int l = (ph - 1) / PH_PER_LAYER, s = (ph - 1) % PH_PER_LAYER;
#ifdef PHASE_MASK
    if (!((PHASE_MASK >> s) & 1)) return;
#endif
    switch (s) {
        case 0: phase_norm1(p, l); break;
        case 1: phase_inproj(p, l, smem); break;
        case 2: phase_ga(p, l, smem); phase_ret1(p, l, smem); phase_swa(p, l, smem); break;
        case 3: phase_ret_scan(p, l); break;
        case 4: phase_ret3(p, l, smem); break;
        case 5: phase_merge(p, l, smem); break;
        case 6: phase_outproj(p, l, smem); break;
        case 7: {
            phase_norm2(p, l);
            for (int it = blockIdx.x; it < MOE_CONV_TILES; it += gridDim.x) moe_conv_item(p, l, it, smem);
            if (l == 0) for (int it = blockIdx.x; it < CONV_TILES_LAYER; it += gridDim.x) conv_item(p, 1, it, smem);
        } break;
        case 8: phase_moe1(p, l, smem); break;
        case 9: phase_moe2(p, l, smem); break;
    }
}

__global__ void __launch_bounds__(NT, 2) mega(Params p) {
    extern __shared__ __attribute__((aligned(16))) char smem[];
    cg::grid_group grid = cg::this_grid();
    for (int ph = p.ph_lo; ph < p.ph_hi; ++ph) {
        run_phase(p, ph, smem);
        if (ph + 1 < p.ph_hi) grid.sync();
    }
}

extern "C" void kernel_launch(void* const* d_in, const int* in_sizes, int n_in, void* d_out, int out_size, void* d_ws, size_t ws_size,
                              hipStream_t stream) {
    static int grid_blocks = 0;
    if (!grid_blocks) {
        int dev = 0, cus = 0, per_cu = 0;
        hipGetDevice(&dev);
        hipDeviceGetAttribute(&cus, hipDeviceAttributeMultiprocessorCount, dev);
        hipFuncSetAttribute((const void*)mega, hipFuncAttributeMaxDynamicSharedMemorySize, LDS_BYTES);
        hipOccupancyMaxActiveBlocksPerMultiprocessor(&per_cu, (const void*)mega, NT, LDS_BYTES);
        if (per_cu < 1) { fprintf(stderr, "occupancy query returned %d\n", per_cu); per_cu = 1; }
        if (per_cu > 1) per_cu = 1;
        grid_blocks = cus * per_cu; if (grid_blocks > MAXBLK) grid_blocks = MAXBLK;
        if (ws_size < WS_END) fprintf(stderr, "workspace too small: %zu < %zu\n", ws_size, (size_t)WS_END);
    }
    Params p{};
    const float** f = (const float**)&p;
    for (int i = 0; i < 23; ++i) f[i] = (const float*)d_in[i];
    p.out = (float*)d_out; p.ws = (unsigned char*)d_ws;
#if MULTI_LAUNCH
    for (int ph = 0; ph < NPHASE; ++ph) {
        p.ph_lo = ph; p.ph_hi = ph + 1;
        hipLaunchKernelGGL(mega, dim3(grid_blocks), dim3(NT), LDS_BYTES, stream, p);
    }
#else
    p.ph_lo = 0; p.ph_hi = NPHASE;
    void* args[] = {&p};
    hipError_t e = hipLaunchCooperativeKernel((const void*)mega, dim3(grid_blocks), dim3(NT), args, LDS_BYTES, stream);
    if (e != hipSuccess) fprintf(stderr, "cooperative launch failed: %s (grid %d)\n", hipGetErrorString(e), grid_blocks);
#endif
}
```

```cpp
#include <hip/hip_runtime.h>
#include <hip/hip_cooperative_groups.h>
#include <cstdio>
#include <cstdint>
namespace cg = cooperative_groups;

#ifndef MULTI_LAUNCH
#define MULTI_LAUNCH 0
#endif

typedef unsigned short bf16;
typedef __attribute__((ext_vector_type(8))) short bf16x8;
typedef __attribute__((ext_vector_type(16))) float f32x16;

constexpr int NT = 512;
constexpr int D = 1024, NB = 4, SEQ = 4096, CTXL = 256;
constexpr int TLAT = NB * SEQ, TCTX = NB * CTXL, TALL = TLAT + TCTX;
constexpr int DIN = 8960, DQKV = 5888;
constexpr int NEXP = 16, DEXP = 512;
constexpr float EPS = 1e-6f;

constexpr size_t OFF_CTL  = 0;
constexpr size_t OFF_BAR  = 4096;
constexpr size_t OFF_LTS  = 4096 + 16384;
constexpr size_t OFF_LW   = OFF_LTS + (size_t)16 * TALL * 4;
constexpr size_t OFF_MOD  = OFF_LW + (size_t)16 * TALL * 4;
constexpr size_t OFF_ROPE = OFF_MOD + (size_t)2 * 5 * 6144 * 4;
constexpr size_t OFF_CX   = OFF_ROPE + 32768;
constexpr size_t OFF_H    = OFF_CX + (size_t)TCTX * D * 4;
constexpr size_t OFF_QR   = OFF_H + (size_t)TALL * 1024 * 2;
constexpr size_t OFF_KR   = OFF_QR + (size_t)TALL * 512 * 2;
constexpr size_t OFF_VR   = OFF_KR + (size_t)TALL * 512 * 2;
constexpr size_t OFF_UR   = OFF_VR + (size_t)TALL * 1024 * 2;
constexpr size_t OFF_QS   = OFF_UR + (size_t)TALL * 1024 * 2;
constexpr size_t OFF_KS   = OFF_QS + (size_t)TALL * 1024 * 2;
constexpr size_t OFF_VS   = OFF_KS + (size_t)TALL * 128 * 2;
constexpr size_t OFF_QA   = OFF_VS + (size_t)TALL * 128 * 2;
constexpr size_t OFF_KA   = OFF_QA + (size_t)TALL * 1024 * 2;
constexpr size_t OFF_VA   = OFF_KA + (size_t)TALL * 256 * 2;
constexpr size_t OFF_F    = OFF_VA + (size_t)TALL * 256 * 2;
constexpr size_t F_BYTES  = (size_t)71303168;
constexpr size_t OFF_WT   = OFF_F + F_BYTES;
constexpr size_t WT_LAYER = ((size_t)DIN * 1024 + 4 * 1024 * 1024) * 2;
constexpr size_t OFF_KFT  = OFF_WT + WT_LAYER;
constexpr size_t OFF_KBT  = OFF_KFT + (size_t)16 * 128 * 4352 * 2;
constexpr size_t OFF_SM   = OFF_KBT + (size_t)16 * 128 * 4352 * 2;
constexpr int MAXBLK = 320;
constexpr size_t WS_END   = OFF_SM + (size_t)MAXBLK * 128 * 128 * 2;
constexpr int KEYS = 4352;
constexpr size_t OFF_Y    = OFF_QR;
constexpr size_t OFF_HB   = OFF_VR;
constexpr size_t OFF_YB   = OFF_QS;
constexpr size_t OFF_WGU  = OFF_F;
constexpr size_t OFF_WD   = OFF_F + (size_t)16 * 1024 * 1024 * 2;

struct Params {
    const float *x, *c, *ctx, *c_ctx, *w_mod, *b_mod, *g1, *g2, *w_in, *ret_logit, *sink, *gq, *gk,
                *w_br_ret, *w_br_swa, *w_br_ga, *w_out, *w_router, *b_router, *w_gate, *w_up, *w_down, *g_final;
    float* out;
    unsigned char* ws;
    int ph_lo, ph_hi;
};

__device__ __forceinline__ int otid() { int t = threadIdx.x; asm volatile("" : "+v"(t)); return t; }
__device__ __forceinline__ bf16 f2bf(float f) { unsigned u = __float_as_uint(f); u += 0x7fffu + ((u >> 16) & 1u); return (bf16)(u >> 16); }
__device__ __forceinline__ float bf2f(bf16 h) { return __uint_as_float(((unsigned)h) << 16); }
__device__ __forceinline__ unsigned pack2(float a, float b) { return (unsigned)f2bf(a) | ((unsigned)f2bf(b) << 16); }
__device__ __forceinline__ float lo2f(unsigned u) { return __uint_as_float(u << 16); }
__device__ __forceinline__ float hi2f(unsigned u) { return __uint_as_float(u & 0xffff0000u); }
__device__ __forceinline__ float wsum(float v) {
#pragma unroll
    for (int o = 32; o > 0; o >>= 1) v += __shfl_xor(v, o, 64);
    return v;
}
__device__ __forceinline__ float wmax(float v) {
#pragma unroll
    for (int o = 32; o > 0; o >>= 1) v = fmaxf(v, __shfl_xor(v, o, 64));
    return v;
}
__device__ __forceinline__ float sigmoidf_(float x) { return 1.f / (1.f + expf(-x)); }
__device__ __forceinline__ float siluf_(float x) { return x / (1.f + expf(-x)); }

__device__ void mod_item(const Params& p, int item, char* smem) {
    float* sc = (float*)smem;
    float* red = sc + 5 * 1024;
    const int tid = otid();
    for (int i = tid; i < 5 * 1024; i += NT) {
        int v = i >> 10, k = i & 1023;
        float xv = v < 4 ? p.c[v * 1024 + k] : p.c_ctx[k];
        sc[i] = siluf_(xv);
    }
    __syncthreads();
    const int l = item / 96, cgp = item % 96, cc = tid & 63, ks = tid >> 6;
    const float* w = p.w_mod + (size_t)l * 1024 * 6144 + cgp * 64 + cc;
    float a0 = 0, a1 = 0, a2 = 0, a3 = 0, a4 = 0;
    for (int k = ks * 128; k < ks * 128 + 128; ++k) {
        float wv = w[(size_t)k * 6144];
        a0 += sc[k] * wv; a1 += sc[1024 + k] * wv; a2 += sc[2048 + k] * wv; a3 += sc[3072 + k] * wv; a4 += sc[4096 + k] * wv;
    }
    red[(ks * 5 + 0) * 64 + cc] = a0; red[(ks * 5 + 1) * 64 + cc] = a1; red[(ks * 5 + 2) * 64 + cc] = a2;
    red[(ks * 5 + 3) * 64 + cc] = a3; red[(ks * 5 + 4) * 64 + cc] = a4;
    __syncthreads();
    if (tid < 320) {
        int v = tid >> 6, c2 = tid & 63; float s = 0;
        for (int k2 = 0; k2 < 8; ++k2) s += red[(k2 * 5 + v) * 64 + c2];
        float* mod = (float*)(p.ws + OFF_MOD);
        mod[(size_t)(l * 5 + v) * 6144 + cgp * 64 + c2] = s + p.b_mod[l * 6144 + cgp * 64 + c2];
    }
    __syncthreads();
}

__device__ void transpose_tile(const float* src, int ld_src, bf16* dst, int ld_dst, char* smem) {
    float* t = (float*)smem;
    const int tid = otid();
#pragma unroll
    for (int i = 0; i < 8; ++i) { int kk = (tid >> 6) + 8 * i, nn = tid & 63; t[kk * 65 + nn] = src[(size_t)kk * ld_src + nn]; }
    __syncthreads();
    const int nn = tid >> 3, kc = tid & 7;
    uint4 o;
    o.x = pack2(t[(kc * 8 + 0) * 65 + nn], t[(kc * 8 + 1) * 65 + nn]);
    o.y = pack2(t[(kc * 8 + 2) * 65 + nn], t[(kc * 8 + 3) * 65 + nn]);
    o.z = pack2(t[(kc * 8 + 4) * 65 + nn], t[(kc * 8 + 5) * 65 + nn]);
    o.w = pack2(t[(kc * 8 + 6) * 65 + nn], t[(kc * 8 + 7) * 65 + nn]);
    *(uint4*)(dst + (size_t)nn * ld_dst + kc * 8) = o;
    __syncthreads();
}

constexpr int CONV_TILES_LAYER = 2240 + 1024;
__device__ void conv_item(const Params& p, int l, int it, char* smem) {
    bf16* wt = (bf16*)(p.ws + OFF_WT);
    if (it < 2240) {
        int kt = it / 140, nt = it % 140;
        transpose_tile(p.w_in + (size_t)l * 1024 * DIN + (size_t)kt * 64 * DIN + nt * 64, DIN, wt + (size_t)nt * 64 * 1024 + kt * 64, 1024, smem);
    } else {
        int j = it - 2240; int mtx = j >> 8; int r = j & 255; int kt = r >> 4, nt = r & 15;
        const float* src = (mtx == 0 ? p.w_br_ret : mtx == 1 ? p.w_br_swa : mtx == 2 ? p.w_br_ga : p.w_out) + (size_t)l * 1024 * 1024;
        bf16* dst = wt + (size_t)DIN * 1024 + (size_t)mtx * 1024 * 1024;
        transpose_tile(src + (size_t)kt * 64 * 1024 + nt * 64, 1024, dst + (size_t)nt * 64 * 1024 + kt * 64, 1024, smem);
    }
}
constexpr int MOE_CONV_TILES = 16 * 384;
__device__ void moe_conv_item(const Params& p, int l, int it, char* smem) {
    int e = it / 384, r = it % 384;
    bf16* wgu = (bf16*)(p.ws + OFF_WGU) + (size_t)e * 1024 * 1024;
    bf16* wd = (bf16*)(p.ws + OFF_WD) + (size_t)e * 1024 * 512;
    if (r < 256) {
        int up = r >> 7; int q = r & 127; int kt = q >> 3, nt = q & 7;
        const float* src = (up ? p.w_up : p.w_gate) + ((size_t)(l * 16 + e) * 1024 + (size_t)kt * 64) * 512 + nt * 64;
        transpose_tile(src, 512, wgu + (size_t)(nt * 128 + up * 64) * 1024 + kt * 64, 1024, smem);
    } else {
        int q = r - 256; int kt = q >> 4, nt = q & 15;
        const float* src = p.w_down + ((size_t)(l * 16 + e) * 512 + (size_t)kt * 64) * 1024 + nt * 64;
        transpose_tile(src, 1024, wd + (size_t)nt * 64 * 512 + kt * 64, 512, smem);
    }
}

__device__ void phase0(const Params& p, char* smem) {
    const int tid = otid();
    if (blockIdx.x == 0) {
        int* ctl = (int*)(p.ws + OFF_CTL);
        if (tid < 64) ctl[tid] = 0;
        float* rp = (float*)(p.ws + OFF_ROPE);
        for (int i = tid; i < 64 * 32; i += NT) {
            int pos = i >> 5, j = i & 31;
            float fr = powf(10000.f, -(float)j / 32.f); float a = (float)pos * fr;
            rp[i] = cosf(a); rp[2048 + i] = sinf(a);
        }
        for (int i = tid; i < 64 * 16; i += NT) {
            int pos = i >> 4, j = i & 15;
            float fr = powf(10000.f, -(float)j / 16.f); float a = (float)pos * fr;
            rp[4096 + i] = cosf(a); rp[4096 + 1024 + i] = sinf(a);
        }
    }
    const int nitems = 192 + CONV_TILES_LAYER;
    for (int it = blockIdx.x; it < nitems; it += gridDim.x) {
        if (it < 192) mod_item(p, it, smem);
        else conv_item(p, 0, it - 192, smem);
    }
}

__device__ void phase_norm1(const Params& p, int l) {
    const int tid = otid(), wave = tid >> 6, lane = tid & 63;
    const float* mod = (const float*)(p.ws + OFF_MOD);
    float* CX = (float*)(p.ws + OFF_CX);
    const bf16* YB = (const bf16*)(p.ws + OFF_YB);
    bf16* H = (bf16*)(p.ws + OFF_H);
    for (int r = blockIdx.x * 8 + wave; r < TALL; r += gridDim.x * 8) {
        const bool isctx = r >= TLAT; const int v = isctx ? 4 : r / SEQ;
        float4 xv[4];
        if (l == 0) {
            const float* xin = isctx ? p.ctx + (size_t)(r - TLAT) * D : p.x + (size_t)r * D;
#pragma unroll
            for (int j = 0; j < 4; ++j) xv[j] = *(const float4*)(xin + j * 256 + lane * 4);
        } else {
            float* xr = isctx ? CX + (size_t)(r - TLAT) * D : p.out + (size_t)r * D;
            const float* gt2 = mod + (size_t)((l - 1) * 5 + v) * 6144 + 5 * 1024;
#pragma unroll
            for (int j = 0; j < 4; ++j) {
                int col = j * 256 + lane * 4;
                float4 a = *(const float4*)(xr + col); float4 g = *(const float4*)(gt2 + col);
                uint2 y0 = *(const uint2*)(YB + (size_t)(r * 2) * D + col), y1 = *(const uint2*)(YB + (size_t)(r * 2 + 1) * D + col);
                a.x += g.x * (lo2f(y0.x) + lo2f(y1.x)); a.y += g.y * (hi2f(y0.x) + hi2f(y1.x));
                a.z += g.z * (lo2f(y0.y) + lo2f(y1.y)); a.w += g.w * (hi2f(y0.y) + hi2f(y1.y));
                *(float4*)(xr + col) = a; xv[j] = a;
            }
        }
        float ss = 0;
#pragma unroll
        for (int j = 0; j < 4; ++j) ss += xv[j].x * xv[j].x + xv[j].y * xv[j].y + xv[j].z * xv[j].z + xv[j].w * xv[j].w;
        ss = wsum(ss);
        const float rstd = rsqrtf(ss * (1.f / 1024.f) + EPS);
        const float* md = mod + (size_t)(l * 5 + v) * 6144;
#pragma unroll
        for (int j = 0; j < 4; ++j) {
            int col = j * 256 + lane * 4;
            float4 g = *(const float4*)(p.g1 + l * 1024 + col), sh = *(const float4*)(md + col), sc = *(const float4*)(md + 1024 + col);
            float h0 = xv[j].x * rstd * g.x * (1.f + sc.x) + sh.x, h1 = xv[j].y * rstd * g.y * (1.f + sc.y) + sh.y;
            float h2 = xv[j].z * rstd * g.z * (1.f + sc.z) + sh.z, h3 = xv[j].w * rstd * g.w * (1.f + sc.w) + sh.w;
            uint2 o; o.x = pack2(h0, h1); o.y = pack2(h2, h3);
            *(uint2*)(H + (size_t)r * D + col) = o;
        }
    }
}

__device__ void phase_norm2(const Params& p, int l) {
    const int tid = otid(), wave = tid >> 6, lane = tid & 63;
    const float* mod = (const float*)(p.ws + OFF_MOD);
    const float* CX = (const float*)(p.ws + OFF_CX);
    bf16* H = (bf16*)(p.ws + OFF_H);
    int* cnt = (int*)(p.ws + OFF_CTL) + l * 16;
    int* lts = (int*)(p.ws + OFF_LTS);
    float* lw = (float*)(p.ws + OFF_LW);
    const int nrows = (l == 0) ? TALL : TLAT;
    for (int r = blockIdx.x * 8 + wave; r < nrows; r += gridDim.x * 8) {
        const bool isctx = r >= TLAT; const int v = isctx ? 4 : r / SEQ;
        const float* xr = isctx ? CX + (size_t)(r - TLAT) * D : p.out + (size_t)r * D;
        float4 xv[4];
#pragma unroll
        for (int j = 0; j < 4; ++j) xv[j] = *(const float4*)(xr + j * 256 + lane * 4);
        float ss = 0;
#pragma unroll
        for (int j = 0; j < 4; ++j) ss += xv[j].x * xv[j].x + xv[j].y * xv[j].y + xv[j].z * xv[j].z + xv[j].w * xv[j].w;
        ss = wsum(ss);
        const float rstd = rsqrtf(ss * (1.f / 1024.f) + EPS);
        const float* md = mod + (size_t)(l * 5 + v) * 6144;
        float part[16];
#pragma unroll
        for (int e = 0; e < 16; ++e) part[e] = 0.f;
#pragma unroll
        for (int j = 0; j < 4; ++j) {
            int col = j * 256 + lane * 4;
            float4 g = *(const float4*)(p.g2 + l * 1024 + col), sh = *(const float4*)(md + 3072 + col), sc = *(const float4*)(md + 4096 + col);
            float hv[4];
            hv[0] = xv[j].x * rstd * g.x * (1.f + sc.x) + sh.x; hv[1] = xv[j].y * rstd * g.y * (1.f + sc.y) + sh.y;
            hv[2] = xv[j].z * rstd * g.z * (1.f + sc.z) + sh.z; hv[3] = xv[j].w * rstd * g.w * (1.f + sc.w) + sh.w;
            uint2 o; o.x = pack2(hv[0], hv[1]); o.y = pack2(hv[2], hv[3]);
            *(uint2*)(H + (size_t)r * D + col) = o;
#pragma unroll
            for (int i = 0; i < 4; ++i) {
                const float4* wr = (const float4*)(p.w_router + (size_t)(col + i) * 16);
                float4 w0 = wr[0], w1 = wr[1], w2 = wr[2], w3 = wr[3];
                part[0] += hv[i] * w0.x; part[1] += hv[i] * w0.y; part[2] += hv[i] * w0.z; part[3] += hv[i] * w0.w;
                part[4] += hv[i] * w1.x; part[5] += hv[i] * w1.y; part[6] += hv[i] * w1.z; part[7] += hv[i] * w1.w;
                part[8] += hv[i] * w2.x; part[9] += hv[i] * w2.y; part[10] += hv[i] * w2.z; part[11] += hv[i] * w2.w;
                part[12] += hv[i] * w3.x; part[13] += hv[i] * w3.y; part[14] += hv[i] * w3.z; part[15] += hv[i] * w3.w;
            }
        }
#pragma unroll
        for (int e = 0; e < 16; ++e) part[e] = wsum(part[e]);
        if (lane == 0) {
            float s[16], bb[16];
#pragma unroll
            for (int e = 0; e < 16; ++e) { s[e] = sigmoidf_(part[e]); bb[e] = s[e] + p.b_router[e]; }
            float bestscore = -1e30f; int be0 = 0, be1 = 1; float bs0 = 0.f, bs1 = 0.f;
#pragma unroll
            for (int g = 0; g < 4; ++g) {
                int i1 = 0; float m1 = bb[g * 4]; float s1 = s[g * 4];
#pragma unroll
                for (int i = 1; i < 4; ++i) if (bb[g * 4 + i] > m1) { m1 = bb[g * 4 + i]; i1 = i; s1 = s[g * 4 + i]; }
                int i2 = -1; float m2 = -1e30f; float s2 = 0.f;
#pragma unroll
                for (int i = 0; i < 4; ++i) if (i != i1 && bb[g * 4 + i] > m2) { m2 = bb[g * 4 + i]; i2 = i; s2 = s[g * 4 + i]; }
                float gs = m1 + m2;
                if (gs > bestscore) { bestscore = gs; be0 = g * 4 + i1; be1 = g * 4 + i2; bs0 = s1; bs1 = s2; }
            }
            float inv = 1.f / (bs0 + bs1);
            int p0 = atomicAdd(&cnt[be0], 1);
            lts[(size_t)be0 * TALL + p0] = r * 2; lw[(size_t)be0 * TALL + p0] = bs0 * inv;
            int p1 = atomicAdd(&cnt[be1], 1);
            lts[(size_t)be1 * TALL + p1] = r * 2 + 1; lw[(size_t)be1 * TALL + p1] = bs1 * inv;
        }
    }
}

__device__ void phase_final(const Params& p) {
    const int tid = otid(), wave = tid >> 6, lane = tid & 63;
    const float* mod = (const float*)(p.ws + OFF_MOD);
    const bf16* YB = (const bf16*)(p.ws + OFF_YB);
    for (int r = blockIdx.x * 8 + wave; r < TLAT; r += gridDim.x * 8) {
        const int v = r / SEQ;
        float* xr = p.out + (size_t)r * D;
        const float* gt2 = mod + (size_t)(1 * 5 + v) * 6144 + 5 * 1024;
        float4 xv[4];
#pragma unroll
        for (int j = 0; j < 4; ++j) {
            int col = j * 256 + lane * 4;
            float4 a = *(const float4*)(xr + col); float4 g = *(const float4*)(gt2 + col);
            uint2 y0 = *(const uint2*)(YB + (size_t)(r * 2) * D + col), y1 = *(const uint2*)(YB + (size_t)(r * 2 + 1) * D + col);
            a.x += g.x * (lo2f(y0.x) + lo2f(y1.x)); a.y += g.y * (hi2f(y0.x) + hi2f(y1.x));
            a.z += g.z * (lo2f(y0.y) + lo2f(y1.y)); a.w += g.w * (hi2f(y0.y) + hi2f(y1.y));
            xv[j] = a;
        }
        float ss = 0;
#pragma unroll
        for (int j = 0; j < 4; ++j) ss += xv[j].x * xv[j].x + xv[j].y * xv[j].y + xv[j].z * xv[j].z + xv[j].w * xv[j].w;
        ss = wsum(ss);
        const float rstd = rsqrtf(ss * (1.f / 1024.f) + EPS);
#pragma unroll
        for (int j = 0; j < 4; ++j) {
            int col = j * 256 + lane * 4;
            float4 g = *(const float4*)(p.g_final + col);
            float4 o; o.x = xv[j].x * rstd * g.x; o.y = xv[j].y * rstd * g.y; o.z = xv[j].z * rstd * g.z; o.w = xv[j].w * rstd * g.w;
            *(float4*)(xr + col) = o;
        }
    }
}

constexpr int LDS_ROW = 144;
constexpr int A_STAGE = 256 * LDS_ROW;
constexpr int B_STAGE = 128 * LDS_ROW;
constexpr int STAGE = A_STAGE + B_STAGE;
constexpr int GEMM_LDS = 2 * STAGE;
constexpr int CT_LD = 132;

template <int MI>
__device__ __forceinline__ void zero_acc(f32x16 (&acc)[MI][2]) {
#pragma unroll
    for (int a = 0; a < MI; ++a)
#pragma unroll
        for (int b = 0; b < 2; ++b)
#pragma unroll
            for (int r = 0; r < 16; ++r) acc[a][b][r] = 0.f;
}

__device__ __forceinline__ uint4 scale8(uint4 u, float sc) {
    uint4 o;
    o.x = pack2(lo2f(u.x) * sc, hi2f(u.x) * sc); o.y = pack2(lo2f(u.y) * sc, hi2f(u.y) * sc);
    o.z = pack2(lo2f(u.z) * sc, hi2f(u.z) * sc); o.w = pack2(lo2f(u.w) * sc, hi2f(u.w) * sc);
    return o;
}
template <int MI, bool BS = false>
__device__ __forceinline__ void gemm_mainloop(f32x16 (&acc)[MI][2], const bf16* ap0, const bf16* ap1, const bf16* ap2, const bf16* ap3,
                                              const bf16* bp0, const bf16* bp1, int K, char* smem, float bs0 = 1.f, float bs1 = 1.f) {
    const int tid = otid(), lane = tid & 63, wave = tid >> 6, wm = wave >> 1, wn = wave & 1;
    const int kc = tid & 7, lr = tid >> 3;
    uint4 ra0, ra1, ra2, ra3, rb0, rb1;
    ra0 = *(const uint4*)(ap0 + kc * 8); ra1 = *(const uint4*)(ap1 + kc * 8);
    if (MI == 2) { ra2 = *(const uint4*)(ap2 + kc * 8); ra3 = *(const uint4*)(ap3 + kc * 8); }
    rb0 = *(const uint4*)(bp0 + kc * 8); rb1 = *(const uint4*)(bp1 + kc * 8);
    if (BS) { rb0 = scale8(rb0, bs0); rb1 = scale8(rb1, bs1); }
    {
        char* st = smem;
        *(uint4*)(st + (lr) * LDS_ROW + kc * 16) = ra0; *(uint4*)(st + (lr + 64) * LDS_ROW + kc * 16) = ra1;
        if (MI == 2) { *(uint4*)(st + (lr + 128) * LDS_ROW + kc * 16) = ra2; *(uint4*)(st + (lr + 192) * LDS_ROW + kc * 16) = ra3; }
        *(uint4*)(st + A_STAGE + (lr) * LDS_ROW + kc * 16) = rb0; *(uint4*)(st + A_STAGE + (lr + 64) * LDS_ROW + kc * 16) = rb1;
    }
    __syncthreads();
    const int nk = K >> 6;
    const int aoff = (wm * (32 * MI) + (lane & 31)) * LDS_ROW + (lane >> 5) * 16;
    const int boff = A_STAGE + (wn * 64 + (lane & 31)) * LDS_ROW + (lane >> 5) * 16;
    for (int kt = 0; kt < nk; ++kt) {
        char* cur = smem + (kt & 1) * STAGE;
        const bool more = (kt + 1 < nk);
        if (more) {
            const int ko = (kt + 1) * 64 + kc * 8;
            ra0 = *(const uint4*)(ap0 + ko); ra1 = *(const uint4*)(ap1 + ko);
            if (MI == 2) { ra2 = *(const uint4*)(ap2 + ko); ra3 = *(const uint4*)(ap3 + ko); }
            rb0 = *(const uint4*)(bp0 + ko); rb1 = *(const uint4*)(bp1 + ko);
        }
#pragma unroll
        for (int ks = 0; ks < 4; ++ks) {
            bf16x8 b0 = *(const bf16x8*)(cur + boff + ks * 32);
            bf16x8 b1 = *(const bf16x8*)(cur + boff + 32 * LDS_ROW + ks * 32);
#pragma unroll
            for (int mi = 0; mi < MI; ++mi) {
                bf16x8 a0 = *(const bf16x8*)(cur + aoff + mi * 32 * LDS_ROW + ks * 32);
                acc[mi][0] = __builtin_amdgcn_mfma_f32_32x32x16_bf16(a0, b0, acc[mi][0], 0, 0, 0);
                acc[mi][1] = __builtin_amdgcn_mfma_f32_32x32x16_bf16(a0, b1, acc[mi][1], 0, 0, 0);
            }
        }
        if (more) {
            if (BS) { rb0 = scale8(rb0, bs0); rb1 = scale8(rb1, bs1); }
            char* st = smem + ((kt + 1) & 1) * STAGE;
            *(uint4*)(st + (lr) * LDS_ROW + kc * 16) = ra0; *(uint4*)(st + (lr + 64) * LDS_ROW + kc * 16) = ra1;
            if (MI == 2) { *(uint4*)(st + (lr + 128) * LDS_ROW + kc * 16) = ra2; *(uint4*)(st + (lr + 192) * LDS_ROW + kc * 16) = ra3; }
            *(uint4*)(st + A_STAGE + (lr) * LDS_ROW + kc * 16) = rb0; *(uint4*)(st + A_STAGE + (lr + 64) * LDS_ROW + kc * 16) = rb1;
        }
        __syncthreads();
    }
}

__device__ __forceinline__ void stage_full(const f32x16 (&acc)[1][2], char* smem) {
    const int tid = otid(), lane = tid & 63, wave = tid >> 6, wm = wave >> 1, wn = wave & 1;
    float* Ct = (float*)smem;
#pragma unroll
    for (int ni = 0; ni < 2; ++ni)
#pragma unroll
        for (int r = 0; r < 16; ++r) {
            int row = wm * 32 + (r & 3) + 8 * (r >> 2) + 4 * (lane >> 5);
            int col = wn * 64 + ni * 32 + (lane & 31);
            Ct[row * CT_LD + col] = acc[0][ni][r];
        }
}

__device__ __forceinline__ void stage_half(const f32x16 (&acc)[2][2], int h, char* smem) {
    const int tid = otid(), lane = tid & 63, wave = tid >> 6, wm = wave >> 1, wn = wave & 1;
    float* Ct = (float*)smem;
    if ((wm >> 1) == h) {
#pragma unroll
        for (int mi = 0; mi < 2; ++mi)
#pragma unroll
            for (int ni = 0; ni < 2; ++ni)
#pragma unroll
                for (int r = 0; r < 16; ++r) {
                    int row = (wm & 1) * 64 + mi * 32 + (r & 3) + 8 * (r >> 2) + 4 * (lane >> 5);
                    int col = wn * 64 + ni * 32 + (lane & 31);
                    Ct[row * CT_LD + col] = acc[mi][ni][r];
                }
    }
}

__device__ __forceinline__ void store32_bf16(bf16* dst, const float (&v)[32]) {
#pragma unroll
    for (int i = 0; i < 4; ++i) {
        uint4 o; o.x = pack2(v[i * 8 + 0], v[i * 8 + 1]); o.y = pack2(v[i * 8 + 2], v[i * 8 + 3]);
        o.z = pack2(v[i * 8 + 4], v[i * 8 + 5]); o.w = pack2(v[i * 8 + 6], v[i * 8 + 7]);
        *(uint4*)(dst + i * 8) = o;
    }
}

__device__ void epi_inproj(const Params& p, int l, const float* Ct, int mrow0, int n0) {
    const int tid = otid(), r = tid >> 2, q = tid & 3;
    const int row = mrow0 + r;
    const bool isctx = row >= TLAT;
    const int t = row & (SEQ - 1);
    const int prow = t >> 6, pcol = t & 63;
    unsigned char* ws = p.ws;
    bf16* dst; int ld, coff, rope = 0; const float* gain = nullptr; float scale = 1.f;
    if (n0 < 512)       { dst = (bf16*)(ws + OFF_QR); ld = 512;  coff = n0;        rope = 128; }
    else if (n0 < 1024) { dst = (bf16*)(ws + OFF_KR); ld = 512;  coff = n0 - 512;  rope = 128; scale = 0.08838834764831845f; }
    else if (n0 < 2048) { dst = (bf16*)(ws + OFF_VR); ld = 1024; coff = n0 - 1024; }
    else if (n0 < 3072) { dst = (bf16*)(ws + OFF_UR); ld = 1024; coff = n0 - 2048; }
    else if (n0 < 4096) { dst = (bf16*)(ws + OFF_QS); ld = 1024; coff = n0 - 3072; rope = 64; scale = 0.125f; }
    else if (n0 < 4224) { dst = (bf16*)(ws + OFF_KS); ld = 128;  coff = 0;         rope = 64; }
    else if (n0 < 4352) { dst = (bf16*)(ws + OFF_VS); ld = 128;  coff = 0; }
    else if (n0 < 5376) { dst = (bf16*)(ws + OFF_QA); ld = 1024; coff = n0 - 4352; rope = 128; gain = p.gq + l * 128; }
    else if (n0 < 5632) { dst = (bf16*)(ws + OFF_KA); ld = 256;  coff = n0 - 5376; rope = 128; gain = p.gk + l * 128; }
    else                { dst = (bf16*)(ws + OFF_VA); ld = 256;  coff = n0 - 5632; }
    if (isctx) rope = 0;
    const float* rp = (const float*)(ws + OFF_ROPE);
    const float* src = Ct + r * CT_LD + 32 * q;
    float rstd = 1.f;
    if (gain) {
        float ss = 0;
#pragma unroll 8
        for (int j = 0; j < 32; ++j) ss += src[j] * src[j];
        ss += __shfl_xor(ss, 1, 64); ss += __shfl_xor(ss, 2, 64);
        rstd = rsqrtf(ss * (1.f / 128.f) + EPS);
    }
    bf16* drow = dst + (size_t)row * ld + coff + 32 * q;
#pragma unroll 1
    for (int c = 0; c < 4; ++c) {
        float v[8], o[8];
#pragma unroll
        for (int j = 0; j < 8; ++j) v[j] = src[c * 8 + j];
        if (gain) {
#pragma unroll
            for (int j = 0; j < 8; ++j) v[j] = v[j] * rstd * gain[32 * q + c * 8 + j];
        }
        if (rope == 128) {
            const float* psrc = Ct + r * CT_LD + 32 * (q ^ 1) + c * 8;
            const int pos = (q >> 1) ? pcol : prow;
            const float* cs = rp + pos * 32 + c * 8; const float* sn = rp + 2048 + pos * 32 + c * 8;
#pragma unroll
            for (int j = 0; j < 8; ++j) {
                float pv = psrc[j];
                if (gain) pv = pv * rstd * gain[32 * (q ^ 1) + c * 8 + j];
                float cc = cs[j], sv = sn[j];
                o[j] = (q & 1) ? (pv * sv + v[j] * cc) : (v[j] * cc - pv * sv);
            }
        } else if (rope == 64) {
            const float* psrc = src + ((c ^ 2) * 8);
            const int pos = (q & 1) ? pcol : prow;
            const float* cs = rp + 4096 + pos * 16 + (c & 1) * 8; const float* sn = rp + 4096 + 1024 + pos * 16 + (c & 1) * 8;
#pragma unroll
            for (int j = 0; j < 8; ++j) {
                float pv = psrc[j];
                float cc = cs[j], sv = sn[j];
                o[j] = (c < 2) ? (v[j] * cc - pv * sv) : (pv * sv + v[j] * cc);
            }
        } else {
#pragma unroll
            for (int j = 0; j < 8; ++j) o[j] = v[j];
        }
        uint4 ov;
        ov.x = pack2(o[0] * scale, o[1] * scale); ov.y = pack2(o[2] * scale, o[3] * scale);
        ov.z = pack2(o[4] * scale, o[5] * scale); ov.w = pack2(o[6] * scale, o[7] * scale);
        *(uint4*)(drow + c * 8) = ov;
    }
}

__device__ void epi_plain_bf16(const float* Ct, bf16* dst, int ld, int mrow0, int n0) {
    const int tid = otid(), r = tid >> 2, q = tid & 3;
    float v[32];
    const float* src = Ct + r * CT_LD + 32 * q;
#pragma unroll
    for (int j = 0; j < 32; ++j) v[j] = src[j];
    store32_bf16(dst + (size_t)(mrow0 + r) * ld + n0 + 32 * q, v);
}

__device__ void epi_outproj(const Params& p, int l, const float* Ct, int mrow0, int n0) {
    const int tid = otid(), r = tid >> 2, q = tid & 3;
    const int row = mrow0 + r;
    const bool isctx = row >= TLAT; const int v = isctx ? 4 : row / SEQ;
    const float* gt = (const float*)(p.ws + OFF_MOD) + (size_t)(l * 5 + v) * 6144 + 2048 + n0 + 32 * q;
    float* CX = (float*)(p.ws + OFF_CX);
    const float* xin; float* xo;
    if (isctx) { xo = CX + (size_t)(row - TLAT) * D + n0 + 32 * q; xin = (l == 0) ? p.ctx + (size_t)(row - TLAT) * D + n0 + 32 * q : xo; }
    else { xo = p.out + (size_t)row * D + n0 + 32 * q; xin = (l == 0) ? p.x + (size_t)row * D + n0 + 32 * q : xo; }
    const float* src = Ct + r * CT_LD + 32 * q;
#pragma unroll
    for (int i = 0; i < 8; ++i) {
        float4 a = *(const float4*)(xin + i * 4); float4 g = *(const float4*)(gt + i * 4);
        a.x += g.x * src[i * 4 + 0]; a.y += g.y * src[i * 4 + 1]; a.z += g.z * src[i * 4 + 2]; a.w += g.w * src[i * 4 + 3];
        *(float4*)(xo + i * 4) = a;
    }
}

__device__ __forceinline__ float log_sigmoid_(float x) { return -log1pf(expf(-x)); }

__device__ void epi_ret_transposed(const Params& p, int l, const float* Ct, int mrow0, int n0) {
    const int tid = otid(), c = tid & 127, q = tid >> 7;
    const bool isctx = mrow0 >= TLAT;
    const int b = isctx ? (mrow0 - TLAT) / CTXL : mrow0 / SEQ;
    const int key0 = isctx ? 4096 + (mrow0 - TLAT - b * CTXL) : mrow0 - b * SEQ;
    if (n0 >= 1024) {
        bf16* dst;
        if (n0 == 4224) dst = (bf16*)(p.ws + OFF_VS) + ((size_t)(b * 2) * 64 + c) * KEYS + key0 + 32 * q;
        else { const int h = (n0 - 1024) >> 8, e = ((n0 - 1024) & 255) + c; dst = (bf16*)(p.ws + OFF_VR) + ((size_t)(b * 4 + h) * 256 + e) * KEYS + key0 + 32 * q; }
#pragma unroll
        for (int g = 0; g < 4; ++g) {
            float v[8];
#pragma unroll
            for (int j = 0; j < 8; ++j) v[j] = Ct[(32 * q + g * 8 + j) * CT_LD + c];
            uint4 o; o.x = pack2(v[0], v[1]); o.y = pack2(v[2], v[3]); o.z = pack2(v[4], v[5]); o.w = pack2(v[6], v[7]);
            *(uint4*)(dst + g * 8) = o;
        }
    } else {
        const int h = (n0 - 512) >> 7;
        const float lgf = log_sigmoid_(p.ret_logit[l * 8 + h]), lgb = log_sigmoid_(p.ret_logit[l * 8 + 4 + h]);
        const float* rp = (const float*)(p.ws + OFF_ROPE);
        const int a = c >> 6, rr = c & 63, first = rr < 32, pc = first ? c + 32 : c - 32, idx = rr & 31;
        bf16* df = (bf16*)(p.ws + OFF_KFT) + ((size_t)(b * 4 + h) * 128 + c) * KEYS + key0 + 32 * q;
        bf16* db = (bf16*)(p.ws + OFF_KBT) + ((size_t)(b * 4 + h) * 128 + c) * KEYS + key0 + 32 * q;
#pragma unroll 1
        for (int g = 0; g < 4; ++g) {
            float vf[8], vb[8];
#pragma unroll
            for (int j = 0; j < 8; ++j) {
                const int tk = 32 * q + g * 8 + j;
                float x = Ct[tk * CT_LD + c];
                if (!isctx) {
                    float px = Ct[tk * CT_LD + pc];
                    const int t = key0 + tk; const int pos = a ? (t & 63) : (t >> 6);
                    float cs = rp[pos * 32 + idx], sn = rp[2048 + pos * 32 + idx];
                    x = first ? (x * cs - px * sn) : (px * sn + x * cs);
                }
                x *= 0.08838834764831845f;
                vf[j] = x * expf((float)(127 - tk) * lgf);
                vb[j] = x * expf((float)tk * lgb);
            }
            uint4 o; o.x = pack2(vf[0], vf[1]); o.y = pack2(vf[2], vf[3]); o.z = pack2(vf[4], vf[5]); o.w = pack2(vf[6], vf[7]);
            *(uint4*)(df + g * 8) = o;
            o.x = pack2(vb[0], vb[1]); o.y = pack2(vb[2], vb[3]); o.z = pack2(vb[4], vb[5]); o.w = pack2(vb[6], vb[7]);
            *(uint4*)(db + g * 8) = o;
        }
    }
}

__device__ void phase_inproj(const Params& p, int l, char* smem) {
    const int tid = otid(), lr = tid >> 3;
    const bf16* H = (const bf16*)(p.ws + OFF_H);
    const bf16* Wt = (const bf16*)(p.ws + OFF_WT);
    constexpr int NTN = DQKV / 128;
    constexpr int NTM = TALL / 256;
    for (int t = blockIdx.x; t < NTM * NTN; t += gridDim.x) {
        const int mt = t / NTN, nt = t % NTN;
        const int m0 = mt * 256, n0 = nt * 128;
        f32x16 acc[2][2]; zero_acc<2>(acc);
        const bf16* a = H + (size_t)(m0 + lr) * 1024;
        const bf16* b = Wt + (size_t)(n0 + lr) * 1024;
        gemm_mainloop<2>(acc, a, a + 64 * 1024, a + 128 * 1024, a + 192 * 1024, b, b + 64 * 1024, 1024, smem);
        for (int h = 0; h < 2; ++h) {
            stage_half(acc, h, smem);
            __syncthreads();
            if (n0 < 1024 || (n0 >= 2048 && n0 != 4224)) epi_inproj(p, l, (const float*)smem, m0 + h * 128, n0);
            if ((n0 >= 512 && n0 < 2048) || n0 == 4224) epi_ret_transposed(p, l, (const float*)smem, m0 + h * 128, n0);
            __syncthreads();
        }
    }
}

__device__ void phase_merge(const Params& p, int l, char* smem) {
    const int tid = otid(), lr = tid >> 3;
    const bf16* H = (const bf16*)(p.ws + OFF_H);
    const bf16* Wt = (const bf16*)(p.ws + OFF_WT);
    bf16* Y = (bf16*)(p.ws + OFF_Y);
    const int M = (l == 0) ? TALL : TLAT;
    const int ntm = M / 128;
    for (int t = blockIdx.x; t < ntm * 8; t += gridDim.x) {
        const int mt = t >> 3, nt = t & 7;
        const int m0 = mt * 128, n0 = nt * 128;
        f32x16 yacc[1][2]; zero_acc<1>(yacc);
#pragma unroll 1
        for (int br = 0; br < 3; ++br) {
            unsigned gp[2][8];
            {
                f32x16 acc[1][2]; zero_acc<1>(acc);
                const bf16* a = H + (size_t)(m0 + lr) * 1024;
                const bf16* b = Wt + (size_t)(DQKV + br * 1024 + n0 + lr) * 1024;
                gemm_mainloop<1>(acc, a, a + 64 * 1024, a, a, b, b + 64 * 1024, 1024, smem);
#pragma unroll
                for (int ni = 0; ni < 2; ++ni)
#pragma unroll
                    for (int r = 0; r < 8; ++r) gp[ni][r] = pack2(sigmoidf_(acc[0][ni][2 * r]), sigmoidf_(acc[0][ni][2 * r + 1]));
            }
            {
                f32x16 acc[1][2]; zero_acc<1>(acc);
                const bf16* O = (const bf16*)(p.ws + (br == 0 ? OFF_UR : br == 1 ? OFF_QS : OFF_QA));
                const bf16* a = O + (size_t)(m0 + lr) * 1024;
                const bf16* b = Wt + (size_t)DIN * 1024 + (size_t)br * 1024 * 1024 + (size_t)(n0 + lr) * 1024;
                gemm_mainloop<1>(acc, a, a + 64 * 1024, a, a, b, b + 64 * 1024, 1024, smem);
#pragma unroll
                for (int ni = 0; ni < 2; ++ni)
#pragma unroll
                    for (int r = 0; r < 8; ++r) {
                        yacc[0][ni][2 * r] += lo2f(gp[ni][r]) * acc[0][ni][2 * r];
                        yacc[0][ni][2 * r + 1] += hi2f(gp[ni][r]) * acc[0][ni][2 * r + 1];
                    }
            }
        }
        stage_full(yacc, smem);
        __syncthreads();
        epi_plain_bf16((const float*)smem, Y, 1024, m0, n0);
        __syncthreads();
    }
}

__device__ void phase_outproj(const Params& p, int l, char* smem) {
    const int tid = otid(), lr = tid >> 3;
    const bf16* Y = (const bf16*)(p.ws + OFF_Y);
    const bf16* Wt = (const bf16*)(p.ws + OFF_WT) + (size_t)DIN * 1024 + (size_t)3 * 1024 * 1024;
    const int M = (l == 0) ? TALL : TLAT;
    const int ntm = M / 256;
    for (int t = blockIdx.x; t < ntm * 8; t += gridDim.x) {
        const int mt = t >> 3, nt = t & 7;
        const int m0 = mt * 256, n0 = nt * 128;
        f32x16 acc[2][2]; zero_acc<2>(acc);
        const bf16* a = Y + (size_t)(m0 + lr) * 1024;
        const bf16* b = Wt + (size_t)(n0 + lr) * 1024;
        gemm_mainloop<2>(acc, a, a + 64 * 1024, a + 128 * 1024, a + 192 * 1024, b, b + 64 * 1024, 1024, smem);
        for (int h = 0; h < 2; ++h) {
            stage_half(acc, h, smem);
            __syncthreads();
            epi_outproj(p, l, (const float*)smem, m0 + h * 128, n0);
            __syncthreads();
        }
    }
}

__device__ __forceinline__ bool moe_find(const int* cnt, int tile, int& e, int& mt, int& rowbase, int& ce) {
    int acc_t = 0, acc_r = 0;
    for (int i = 0; i < 16; ++i) {
        int c = cnt[i]; int nt = (c + 255) >> 8;
        if (tile < acc_t + nt) { e = i; mt = tile - acc_t; rowbase = acc_r; ce = c; return true; }
        acc_t += nt; acc_r += c;
    }
    return false;
}

__device__ void phase_moe1(const Params& p, int l, char* smem) {
    const int tid = otid(), lr = tid >> 3;
    const int* cnt = (const int*)(p.ws + OFF_CTL) + l * 16;
    const int* lts = (const int*)(p.ws + OFF_LTS);
    const bf16* H = (const bf16*)(p.ws + OFF_H);
    bf16* HB = (bf16*)(p.ws + OFF_HB);
    int total = 0;
    for (int i = 0; i < 16; ++i) total += (cnt[i] + 255) >> 8;
    for (int t = blockIdx.x; t < total * 8; t += gridDim.x) {
        const int tile = t >> 3, nt = t & 7;
        int e, mt, rowbase, ce;
        moe_find(cnt, tile, e, mt, rowbase, ce);
        const int* le = lts + (size_t)e * TALL;
        const bf16* ap[4];
#pragma unroll
        for (int i = 0; i < 4; ++i) {
            int idx = mt * 256 + lr + 64 * i; if (idx >= ce) idx = ce - 1;
            ap[i] = H + (size_t)(le[idx] >> 1) * 1024;
        }
        const bf16* b = (const bf16*)(p.ws + OFF_WGU) + (size_t)e * 1024 * 1024 + (size_t)(nt * 128 + lr) * 1024;
        f32x16 acc[2][2]; zero_acc<2>(acc);
        gemm_mainloop<2>(acc, ap[0], ap[1], ap[2], ap[3], b, b + 64 * 1024, 1024, smem);
        for (int h = 0; h < 2; ++h) {
            stage_half(acc, h, smem);
            __syncthreads();
            {
                const float* Ct = (const float*)smem;
                const int r = tid >> 2, q = tid & 3;
                const int idx = mt * 256 + h * 128 + r;
                if (idx < ce) {
                    const float* src = Ct + r * CT_LD;
                    uint4 o0, o1; float hv[16];
#pragma unroll
                    for (int j = 0; j < 16; ++j) { float g = src[16 * q + j], u = src[64 + 16 * q + j]; hv[j] = siluf_(g) * u; }
                    o0.x = pack2(hv[0], hv[1]); o0.y = pack2(hv[2], hv[3]); o0.z = pack2(hv[4], hv[5]); o0.w = pack2(hv[6], hv[7]);
                    o1.x = pack2(hv[8], hv[9]); o1.y = pack2(hv[10], hv[11]); o1.z = pack2(hv[12], hv[13]); o1.w = pack2(hv[14], hv[15]);
                    bf16* d = HB + (size_t)(rowbase + idx) * 512 + nt * 64 + 16 * q;
                    *(uint4*)d = o0; *(uint4*)(d + 8) = o1;
                }
            }
            __syncthreads();
        }
    }
}

__device__ void phase_moe2(const Params& p, int l, char* smem) {
    const int tid = otid(), lr = tid >> 3;
    const int* cnt = (const int*)(p.ws + OFF_CTL) + l * 16;
    const int* lts = (const int*)(p.ws + OFF_LTS);
    const float* lw = (const float*)(p.ws + OFF_LW);
    const bf16* HB = (const bf16*)(p.ws + OFF_HB);
    bf16* YB = (bf16*)(p.ws + OFF_YB);
    int total = 0;
    for (int i = 0; i < 16; ++i) total += (cnt[i] + 255) >> 8;
    for (int t = blockIdx.x; t < total * 8; t += gridDim.x) {
        const int tile = t >> 3, nt = t & 7;
        int e, mt, rowbase, ce;
        moe_find(cnt, tile, e, mt, rowbase, ce);
        const bf16* ap[4];
#pragma unroll
        for (int i = 0; i < 4; ++i) {
            int idx = mt * 256 + lr + 64 * i; if (idx >= ce) idx = ce - 1;
            ap[i] = HB + (size_t)(rowbase + idx) * 512;
        }
        const bf16* b = (const bf16*)(p.ws + OFF_WD) + (size_t)e * 1024 * 512 + (size_t)(nt * 128 + lr) * 512;
        f32x16 acc[2][2]; zero_acc<2>(acc);
        gemm_mainloop<2>(acc, ap[0], ap[1], ap[2], ap[3], b, b + 64 * 512, 512, smem);
        for (int h = 0; h < 2; ++h) {
            stage_half(acc, h, smem);
            __syncthreads();
            {
                const float* Ct = (const float*)smem;
                const int r = tid >> 2, q = tid & 3;
                const int idx = mt * 256 + h * 128 + r;
                if (idx < ce) {
                    const int ts = lts[(size_t)e * TALL + idx]; const float w = lw[(size_t)e * TALL + idx];
                    const float* src = Ct + r * CT_LD + 32 * q;
                    float v[32];
#pragma unroll
                    for (int j = 0; j < 32; ++j) v[j] = src[j] * w;
                    store32_bf16(YB + (size_t)ts * 1024 + nt * 128 + 32 * q, v);
                }
            }
            __syncthreads();
        }
    }
}

__device__ __forceinline__ void unpack8(uint4 u, float (&f)[8]) {
    f[0] = lo2f(u.x); f[1] = hi2f(u.x); f[2] = lo2f(u.y); f[3] = hi2f(u.y); f[4] = lo2f(u.z); f[5] = hi2f(u.z); f[6] = lo2f(u.w); f[7] = hi2f(u.w);
}

__device__ void ga_naive_item(const Params& p, int item, char* smem) {
    const int tid = otid(), wave = tid >> 6, lane = tid & 63;
    float* qs = (float*)smem;
    float* inv = qs + 512;
    float* sc = qs + 528;
    bf16* QA = (bf16*)(p.ws + OFF_QA); const bf16* KA = (const bf16*)(p.ws + OFF_KA); const bf16* VA = (const bf16*)(p.ws + OFF_VA);
    int b, kvh, qrow, nkeys, keybase_lat, keybase_ctx, nlat;
    if (item < 32768) { b = item >> 13; kvh = (item >> 12) & 1; int n = item & 4095; qrow = b * SEQ + n; nkeys = 4352; nlat = 4096; }
    else { int j = item - 32768; b = j >> 9; kvh = (j >> 8) & 1; int n = j & 255; qrow = TLAT + b * CTXL + n; nkeys = 256; nlat = 0; }
    keybase_lat = b * SEQ; keybase_ctx = TLAT + b * CTXL;
    qs[tid] = bf2f(QA[(size_t)qrow * 1024 + kvh * 512 + tid]);
    __syncthreads();
    for (int m = tid; m < nkeys; m += NT) {
        const int krow = m < nlat ? keybase_lat + m : keybase_ctx + (m - nlat);
        const uint4* kp = (const uint4*)(KA + (size_t)krow * 256 + kvh * 128);
        float d0 = 0, d1 = 0, d2 = 0, d3 = 0;
#pragma unroll 4
        for (int c = 0; c < 16; ++c) {
            float kf[8]; unpack8(kp[c], kf);
#pragma unroll
            for (int j = 0; j < 8; ++j) { d0 += qs[c * 8 + j] * kf[j]; d1 += qs[128 + c * 8 + j] * kf[j]; d2 += qs[256 + c * 8 + j] * kf[j]; d3 += qs[384 + c * 8 + j] * kf[j]; }
        }
        sc[m] = d0; sc[4352 + m] = d1; sc[2 * 4352 + m] = d2; sc[3 * 4352 + m] = d3;
    }
    __syncthreads();
    if (wave < 4) {
        float* s = sc + wave * 4352;
        float mx = -1e30f;
        for (int m = lane; m < nkeys; m += 64) mx = fmaxf(mx, s[m]);
        mx = wmax(mx);
        float sum = 0;
        for (int m = lane; m < nkeys; m += 64) { float e = expf(s[m] - mx); s[m] = e; sum += e; }
        sum = wsum(sum);
        if (lane == 0) inv[wave] = 1.f / sum;
    }
    __syncthreads();
    {
        const int head = tid >> 7, d = tid & 127;
        const float* s = sc + head * 4352;
        float acc = 0;
        for (int m = 0; m < nkeys; ++m) {
            const int krow = m < nlat ? keybase_lat + m : keybase_ctx + (m - nlat);
            acc += s[m] * bf2f(VA[(size_t)krow * 256 + kvh * 128 + d]);
        }
        QA[(size_t)qrow * 1024 + kvh * 512 + tid] = f2bf(acc * inv[head]);
    }
    __syncthreads();
}

__device__ void swa_naive_item(const Params& p, int l, int item, char* smem) {
    const int tid = otid(), wave = tid >> 6, lane = tid & 63;
    float* qs = (float*)smem;
    float* inv = qs + 512;
    float* sc = qs + 528;
    bf16* QS = (bf16*)(p.ws + OFF_QS); const bf16* KS = (const bf16*)(p.ws + OFF_KS); const bf16* VS = (const bf16*)(p.ws + OFF_VS);
    int b, kvh, qrow, nl, lo;
    if (item < 32768) { b = item >> 13; kvh = (item >> 12) & 1; int n = item & 4095; qrow = b * SEQ + n; lo = n - 128 < 0 ? 0 : n - 128; int hi = n + 128 > SEQ - 1 ? SEQ - 1 : n + 128; nl = hi - lo + 1; }
    else { int j = item - 32768; b = j >> 9; kvh = (j >> 8) & 1; int n = j & 255; qrow = TLAT + b * CTXL + n; nl = 0; lo = 0; }
    const int ntot = nl + 256;
    const int kb_lat = b * SEQ + lo, kb_ctx = TLAT + b * CTXL;
    qs[tid] = bf2f(QS[(size_t)qrow * 1024 + kvh * 512 + tid]);
    __syncthreads();
    for (int kk = tid; kk < ntot; kk += NT) {
        const int krow = kk < nl ? kb_lat + kk : kb_ctx + (kk - nl);
        const uint4* kp = (const uint4*)(KS + (size_t)krow * 128 + kvh * 64);
        uint4 kr[8];
#pragma unroll
        for (int c = 0; c < 8; ++c) kr[c] = kp[c];
#pragma unroll 1
        for (int h = 0; h < 8; ++h) {
            float dd = 0.f;
            const float* qh = qs + h * 64;
#pragma unroll
            for (int c = 0; c < 8; ++c) {
                float kf[8]; unpack8(kr[c], kf);
#pragma unroll
                for (int j = 0; j < 8; ++j) dd += qh[c * 8 + j] * kf[j];
            }
            sc[h * 520 + kk] = dd;
        }
    }
    __syncthreads();
    {
        float* s = sc + wave * 520;
        const float sk = p.sink[l * 16 + kvh * 8 + wave];
        float mx = sk;
        for (int m = lane; m < ntot; m += 64) mx = fmaxf(mx, s[m]);
        mx = wmax(mx);
        float sum = 0;
        for (int m = lane; m < ntot; m += 64) { float e = expf(s[m] - mx); s[m] = e; sum += e; }
        sum = wsum(sum) + expf(sk - mx);
        if (lane == 0) inv[wave] = 1.f / sum;
    }
    __syncthreads();
    {
        const int head = tid >> 6, d = tid & 63;
        const float* s = sc + head * 520;
        float acc = 0;
        for (int kk = 0; kk < ntot; ++kk) {
            const int krow = kk < nl ? kb_lat + kk : kb_ctx + (kk - nl);
            acc += s[kk] * bf2f(VS[(size_t)krow * 128 + kvh * 64 + d]);
        }
        QS[(size_t)qrow * 1024 + kvh * 512 + tid] = f2bf(acc * inv[head]);
    }
    __syncthreads();
}

__device__ void ret_naive_item(const Params& p, int l, int item, char* smem) {
    const int tid = otid(), wave = tid >> 6, lane = tid & 63;
    float* qs = (float*)smem;
    float* red = qs + 128;
    float* sc = qs + 528;
    const bf16* QR = (const bf16*)(p.ws + OFF_QR); const bf16* KR = (const bf16*)(p.ws + OFF_KR); const bf16* VR = (const bf16*)(p.ws + OFF_VR);
    bf16* UR = (bf16*)(p.ws + OFF_UR);
    int b, h, n, qrow, nkeys, nlat; bool isctx;
    if (item < 65536) { b = item >> 14; h = (item >> 12) & 3; n = item & 4095; qrow = b * SEQ + n; nkeys = 4352; nlat = 4096; isctx = false; }
    else { int j = item - 65536; b = j >> 10; h = (j >> 8) & 3; n = j & 255; qrow = TLAT + b * CTXL + n; nkeys = 256; nlat = 0; isctx = true; }
    const float xf = p.ret_logit[l * 8 + h], xb = p.ret_logit[l * 8 + 4 + h];
    const float lgf = -log1pf(expf(-xf)), lgb = -log1pf(expf(-xb));
    const int kb_lat = b * SEQ, kb_ctx = TLAT + b * CTXL;
    if (tid < 128) qs[tid] = bf2f(QR[(size_t)qrow * 512 + h * 128 + tid]);
    __syncthreads();
    for (int m = tid; m < nkeys; m += NT) {
        const int krow = m < nlat ? kb_lat + m : kb_ctx + (m - nlat);
        const uint4* kp = (const uint4*)(KR + (size_t)krow * 512 + h * 128);
        float d0 = 0;
#pragma unroll 4
        for (int c = 0; c < 16; ++c) {
            float kf[8]; unpack8(kp[c], kf);
#pragma unroll
            for (int j = 0; j < 8; ++j) d0 += qs[c * 8 + j] * kf[j];
        }
        float dec;
        if (isctx) { int dd = n - m; dec = dd >= 0 ? expf((float)dd * lgf) : expf((float)(-dd) * lgb); }
        else if (m < nlat) { int dd = n - m; dec = dd >= 0 ? expf((float)dd * lgf) : expf((float)(-dd) * lgb); }
        else { int j = m - nlat; dec = expf((float)(n + 256 - j) * lgf) + expf((float)(SEQ - n + j) * lgb); }
        sc[m] = d0 * dec;
    }
    __syncthreads();
    const int e = tid & 255, half = tid >> 8;
    float acc = 0;
    {
        const int mh = nkeys >> 1;
        for (int m = half * mh; m < half * mh + mh; ++m) {
            const int krow = m < nlat ? kb_lat + m : kb_ctx + (m - nlat);
            acc += sc[m] * bf2f(VR[(size_t)krow * 1024 + h * 256 + e]);
        }
    }
    if (half == 1) red[e] = acc;
    __syncthreads();
    float ss = 0;
    if (half == 0) { acc += red[e]; ss = acc * acc; }
    ss = wsum(ss);
    if (lane == 0) red[256 + wave] = ss;
    __syncthreads();
    if (half == 0) {
        float tot = red[256] + red[257] + red[258] + red[259];
        float rstd = rsqrtf(tot * (1.f / 256.f) + EPS);
        size_t idx = (size_t)qrow * 1024 + h * 256 + e;
        float u = bf2f(UR[idx]);
        UR[idx] = f2bf(acc * rstd * siluf_(u));
    }
    __syncthreads();
}


namespace ga {
using s16x4  = __attribute__((ext_vector_type(4))) short;
using u32x4  = __attribute__((ext_vector_type(4))) unsigned;
constexpr int QBLK = 32, KVBLK = 64;
constexpr float SCALE = 0.088388347648318440f;
constexpr float THR = 8.f;
constexpr int LDQ = 1024, LDK = 256, LDO = 1024;
constexpr int SHM_V = KVBLK * 128 * 2, SHM_K = KVBLK * 128 * 2;
constexpr int SHM_ATTN = 2 * SHM_V + 2 * SHM_K + 8 * 64 * 4;
#define KSWZ(row, colB) ((row) * 256 + ((colB) ^ (((row) & 7) << 4)))
#define SBAR() __builtin_amdgcn_sched_barrier(0)
__device__ __forceinline__ int crow(int r, int hi) { return (r & 3) + 8 * (r >> 2) + 4 * hi; }
__device__ __forceinline__ unsigned cvtpk(float lo, float hi) {
  unsigned r; asm volatile("v_cvt_pk_bf16_f32 %0, %1, %2" : "=v"(r) : "v"(lo), "v"(hi)); return r;
}
__device__ __forceinline__ void partialSM(f32x16& p0, f32x16& p1, float& m_reg, float& mn, float& alpha) {
  constexpr float C = SCALE * 1.4426950408889634f;
  float pmax = p0[0];
#pragma unroll
  for (int r = 1; r < 16; ++r) pmax = fmaxf(pmax, p0[r]);
#pragma unroll
  for (int r = 0; r < 16; ++r) pmax = fmaxf(pmax, p1[r]);
  { auto rr = __builtin_amdgcn_permlane32_swap(__float_as_uint(pmax), __float_as_uint(pmax), false, false);
    pmax = fmaxf(__uint_as_float(rr[0]), __uint_as_float(rr[1])); }
  if (__builtin_expect(__all(pmax - m_reg <= THR / SCALE), 1)) { mn = m_reg; alpha = 1.f; }
  else { mn = fmaxf(m_reg, pmax); alpha = __builtin_amdgcn_exp2f((m_reg - mn) * C); m_reg = mn; }
  float mnC = -mn * C;
#pragma unroll
  for (int r = 0; r < 16; ++r) p0[r] = fmaf(p0[r], C, mnC);
#pragma unroll
  for (int r = 0; r < 16; ++r) p1[r] = fmaf(p1[r], C, mnC);
#pragma unroll
  for (int r = 0; r < 16; ++r) p0[r] = __builtin_amdgcn_exp2f(p0[r]);
}
__device__ __forceinline__ void finishSM(f32x16& p0, f32x16& p1, float alpha, float& l_reg, bf16x8& pa0, bf16x8& pa1, bf16x8& pa2, bf16x8& pa3) {
#pragma unroll
  for (int r = 0; r < 16; ++r) p1[r] = __builtin_amdgcn_exp2f(p1[r]);
  float ps = 0;
#pragma unroll
  for (int r = 0; r < 16; ++r) ps += p0[r];
#pragma unroll
  for (int r = 0; r < 16; ++r) ps += p1[r];
  { auto rr = __builtin_amdgcn_permlane32_swap(__float_as_uint(ps), __float_as_uint(ps), false, false);
    ps = __uint_as_float(rr[0]) + __uint_as_float(rr[1]); }
  l_reg = l_reg * alpha + ps;
#define PK4(P, BASE, OUT) do { unsigned a0 = cvtpk(P[BASE + 0], P[BASE + 1]), a1 = cvtpk(P[BASE + 2], P[BASE + 3]);   \
    unsigned b0 = cvtpk(P[BASE + 4], P[BASE + 5]), b1 = cvtpk(P[BASE + 6], P[BASE + 7]);                              \
    auto r0 = __builtin_amdgcn_permlane32_swap(a0, b0, false, false); auto r1 = __builtin_amdgcn_permlane32_swap(a1, b1, false, false); \
    u32x4 w = {r0[0], r1[0], r0[1], r1[1]}; OUT = *reinterpret_cast<bf16x8*>(&w); } while (0)
  PK4(p0, 0, pa0); PK4(p0, 8, pa1); PK4(p1, 0, pa2); PK4(p1, 8, pa3);
#undef PK4
}
__device__ __forceinline__ void qkt(f32x16& p0, f32x16& p1, const char* Ks, const bf16x8* qr, int r32, int hi) {
  p0 = f32x16{}; p1 = f32x16{};
#pragma unroll
  for (int d0 = 0; d0 < 8; ++d0) { int cb = (d0 * 16 + hi * 8) * 2;
    bf16x8 b0 = *reinterpret_cast<const bf16x8*>(Ks + KSWZ(r32, cb));
    bf16x8 b1 = *reinterpret_cast<const bf16x8*>(Ks + KSWZ(32 + r32, cb));
    p0 = __builtin_amdgcn_mfma_f32_32x32x16_bf16(b0, qr[d0], p0, 0, 0, 0);
    p1 = __builtin_amdgcn_mfma_f32_32x32x16_bf16(b1, qr[d0], p1, 0, 0, 0); }
}
__device__ __forceinline__ int v_st(int k, int c) { const int kk = (k & ~0xC) | ((k & 4) << 1) | ((k & 8) >> 1); return ((kk >> 3) * 4 + (c >> 5)) * 512 + ((kk & 7) * 32 + (c & 31)) * 2; }
__device__ __forceinline__ int v_rd_base(int lane) { return ((lane & 3) << 3) | (((lane >> 2) & 3) << 6) | (((lane >> 4) & 1) << 5) | (((lane >> 5) & 1) << 8); }
constexpr int v_rd_off(int d0, int ks, int half) { return d0 * 512 + ks * 4096 + half * 2048; }
template <int OFF> __device__ __forceinline__ s16x4 tr_read(int vb) {
  s16x4 r; asm volatile("ds_read_b64_tr_b16 %0, %1 offset:%2" : "=&v"(r) : "v"(vb), "i"(OFF) : "memory"); return r;
}
template <int D0> __device__ __forceinline__ void pv_one(f32x16& od, int vb, bf16x8 pa0, bf16x8 pa1, bf16x8 pa2, bf16x8 pa3) {
  const s16x4 l0 = tr_read<v_rd_off(D0, 0, 0)>(vb), h0 = tr_read<v_rd_off(D0, 0, 1)>(vb), l1 = tr_read<v_rd_off(D0, 1, 0)>(vb), h1 = tr_read<v_rd_off(D0, 1, 1)>(vb);
  const s16x4 l2 = tr_read<v_rd_off(D0, 2, 0)>(vb), h2 = tr_read<v_rd_off(D0, 2, 1)>(vb), l3 = tr_read<v_rd_off(D0, 3, 0)>(vb), h3 = tr_read<v_rd_off(D0, 3, 1)>(vb);
  asm volatile("s_waitcnt lgkmcnt(0)" ::: "memory"); SBAR();
#define PK(L, H) (bf16x8){L[0], L[1], L[2], L[3], H[0], H[1], H[2], H[3]}
  od = __builtin_amdgcn_mfma_f32_32x32x16_bf16(pa0, PK(l0, h0), od, 0, 0, 0);
  od = __builtin_amdgcn_mfma_f32_32x32x16_bf16(pa1, PK(l1, h1), od, 0, 0, 0);
  od = __builtin_amdgcn_mfma_f32_32x32x16_bf16(pa2, PK(l2, h2), od, 0, 0, 0);
  od = __builtin_amdgcn_mfma_f32_32x32x16_bf16(pa3, PK(l3, h3), od, 0, 0, 0);
#undef PK
}
__device__ __forceinline__ void pv_d0(f32x16* o, int vb, bf16x8 pa0, bf16x8 pa1, bf16x8 pa2, bf16x8 pa3) {
  pv_one<0>(o[0], vb, pa0, pa1, pa2, pa3); pv_one<1>(o[1], vb, pa0, pa1, pa2, pa3); pv_one<2>(o[2], vb, pa0, pa1, pa2, pa3); pv_one<3>(o[3], vb, pa0, pa1, pa2, pa3);
}

__device__ __forceinline__ void attn_dense_body(bf16* Qb, const bf16* Klat, const bf16* Vlat, const bf16* Kctx, const bf16* Vctx,
                                                int nlat, int seq, char* lds) {
  const int tid = otid(), wid = tid >> 6, lane = tid & 63, r32 = lane & 31, hi = lane >> 5;
  char* V_lds = lds; char* K_lds = lds + 2 * SHM_V;
  float* wsl = (float*)(lds + 2 * SHM_V + 2 * SHM_K) + wid * 64; float* li_l = wsl; float* al_l = wsl + 32;
  float m_reg = -1e30f, l_reg = 0; f32x16 o[4] = {}; bf16x8 qr[8];
  const bf16* Qw = Qb + (long)(wid * QBLK + r32) * LDQ + hi * 8;
#pragma unroll
  for (int d0 = 0; d0 < 8; ++d0) qr[d0] = *reinterpret_cast<const bf16x8*>(Qw + d0 * 16);
  const int sr = tid >> 4, sc = (tid & 15) * 8, vst0 = v_st(sr, sc), vst1 = v_st(32 + sr, sc);
  const int vb0 = (int)(uintptr_t)V_lds + v_rd_base(lane);
  struct { bf16x8 vs0, vs1, ks0, ks1; } sr_[2];
#define KVROW(k0) ((k0) < nlat ? (long)(k0) * LDK : (long)((k0) - nlat) * LDK)
#define SLOAD(i, k0) do { const bf16* kb_ = ((k0) < nlat ? Klat : Kctx) + KVROW(k0); const bf16* vb_ = ((k0) < nlat ? Vlat : Vctx) + KVROW(k0); \
    sr_[i].vs0 = *reinterpret_cast<const bf16x8*>(vb_ + (long)sr * LDK + sc); sr_[i].vs1 = *reinterpret_cast<const bf16x8*>(vb_ + (long)(32 + sr) * LDK + sc); \
    sr_[i].ks0 = *reinterpret_cast<const bf16x8*>(kb_ + (long)sr * LDK + sc); sr_[i].ks1 = *reinterpret_cast<const bf16x8*>(kb_ + (long)(32 + sr) * LDK + sc); } while (0)
#define SWRITE(b, i) do { *(bf16x8*)(V_lds + (b) * SHM_V + vst0) = sr_[i].vs0;          \
    *(bf16x8*)(V_lds + (b) * SHM_V + vst1) = sr_[i].vs1; int kc = sc * 2;               \
    *(bf16x8*)(K_lds + (b) * SHM_K + KSWZ(sr, kc)) = sr_[i].ks0;                       \
    *(bf16x8*)(K_lds + (b) * SHM_K + KSWZ(32 + sr, kc)) = sr_[i].ks1; } while (0)
#define SWAIT() asm volatile("s_waitcnt vmcnt(4)" ::: "memory")
#define RESC(a) do { if (__any((a) < 1.f)) { if (hi == 0) al_l[r32] = (a); asm volatile("s_waitcnt lgkmcnt(0)" ::: "memory"); \
    _Pragma("unroll") for (int d = 0; d < 4; ++d) _Pragma("unroll") for (int r = 0; r < 16; ++r) o[d][r] *= al_l[crow(r, hi)]; } } while (0)
  f32x16 pA0, pA1, pB0, pB1; float mnA, mnB, alA, alB; bf16x8 pa0, pa1, pa2, pa3; const int NTL = seq / KVBLK;
  constexpr int SE = 0, SO = 1;
  SLOAD(SE, 0); asm volatile("s_waitcnt vmcnt(0)" ::: "memory"); SWRITE(0, SE); __syncthreads();
  qkt(pA0, pA1, K_lds, qr, r32, hi); partialSM(pA0, pA1, m_reg, mnA, alA);
  SLOAD(SO, KVBLK); if (2 < NTL) SLOAD(SE, 2 * KVBLK);
  SWAIT(); SWRITE(1, SO); __syncthreads();
  for (int j = 1; j + 1 < NTL; j += 2) {
    SBAR(); qkt(pB0, pB1, K_lds + SHM_K, qr, r32, hi);
    finishSM(pA0, pA1, alA, l_reg, pa0, pa1, pa2, pa3); SBAR();
    SLOAD(SO, (j + 2) * KVBLK); SBAR();
    pv_d0(o, vb0, pa0, pa1, pa2, pa3); partialSM(pB0, pB1, m_reg, mnB, alB);
    __syncthreads(); SWAIT(); SWRITE(0, SE);
    RESC(alB); __syncthreads();
    SBAR(); qkt(pA0, pA1, K_lds, qr, r32, hi);
    finishSM(pB0, pB1, alB, l_reg, pa0, pa1, pa2, pa3); SBAR();
    if (j + 3 < NTL) SLOAD(SE, (j + 3) * KVBLK); SBAR();
    pv_d0(o, vb0 + (int)SHM_V, pa0, pa1, pa2, pa3); partialSM(pA0, pA1, m_reg, mnA, alA);
    __syncthreads(); SWAIT(); SWRITE(1, SO);
    RESC(alA); __syncthreads();
  }
  SBAR(); qkt(pB0, pB1, K_lds + SHM_K, qr, r32, hi);
  finishSM(pA0, pA1, alA, l_reg, pa0, pa1, pa2, pa3); SBAR();
  pv_d0(o, vb0, pa0, pa1, pa2, pa3); partialSM(pB0, pB1, m_reg, mnB, alB);
  __syncthreads(); RESC(alB);
  finishSM(pB0, pB1, alB, l_reg, pa0, pa1, pa2, pa3); SBAR();
  pv_d0(o, vb0 + (int)SHM_V, pa0, pa1, pa2, pa3);
  if (hi == 0) li_l[r32] = l_reg; asm volatile("s_waitcnt lgkmcnt(0)" ::: "memory");
  float rli[16];
#pragma unroll
  for (int r = 0; r < 16; ++r) rli[r] = __builtin_amdgcn_rcpf(li_l[crow(r, hi)]);
  bf16* Ow = Qb + (long)(wid * QBLK) * LDO;
#pragma unroll
  for (int r = 0; r < 16; ++r) { int orow = crow(r, hi);
#pragma unroll
    for (int d0 = 0; d0 < 4; ++d0) Ow[(long)orow * LDO + d0 * 32 + r32] = f2bf(o[d0][r] * rli[r]); }
  __syncthreads();
#undef KVROW
#undef SLOAD
#undef SWRITE
#undef SWAIT
#undef RESC
}
#undef KSWZ
}

__device__ void phase_ga(const Params& p, int l, char* smem) {
    bf16* QA = (bf16*)(p.ws + OFF_QA); const bf16* KA = (const bf16*)(p.ws + OFF_KA); const bf16* VA = (const bf16*)(p.ws + OFF_VA);
    const int nitems = 512 + (l == 0 ? 32 : 0);
    for (int it = blockIdx.x; it < nitems; it += gridDim.x) {
        if (it < 512) {
            const int pair = it & 7, j = it >> 3, hg = j >> 4, qb = j & 15, b = pair >> 1, kvh = pair & 1, head = kvh * 4 + hg;
            ga::attn_dense_body(QA + (size_t)(b * SEQ + qb * 256) * 1024 + head * 128,
                                KA + (size_t)(b * SEQ) * 256 + kvh * 128, VA + (size_t)(b * SEQ) * 256 + kvh * 128,
                                KA + (size_t)(TLAT + b * CTXL) * 256 + kvh * 128, VA + (size_t)(TLAT + b * CTXL) * 256 + kvh * 128,
                                4096, 4352, smem);
        } else {
            const int j = it - 512, b = j >> 3, head = j & 7, kvh = head >> 2;
            const bf16* kc = KA + (size_t)(TLAT + b * CTXL) * 256 + kvh * 128; const bf16* vc = VA + (size_t)(TLAT + b * CTXL) * 256 + kvh * 128;
            ga::attn_dense_body(QA + (size_t)(TLAT + b * CTXL) * 1024 + head * 128, kc, vc, kc, vc, 0, 256, smem);
        }
    }
}


__device__ __forceinline__ int chunk_key0(int c) { return c < 32 ? c * 128 : 4096 + (c - 32) * 128; }

__device__ void phase_ret1(const Params& p, int l, char* smem) {
    const int tid = otid(), lr = tid >> 3;
    const bf16* VT = (const bf16*)(p.ws + OFF_VR);
    bf16* F = (bf16*)(p.ws + OFF_F);
    for (int it = blockIdx.x; it < 16 * 34 * 2; it += gridDim.x) {
        const int dir = it & 1, j = it >> 1, c = j % 34, bh = j / 34;
        const int key0 = chunk_key0(c);
        const bf16* KT = (const bf16*)(p.ws + (dir ? OFF_KBT : OFF_KFT));
        const bf16* a = VT + ((size_t)bh * 256 + lr) * KEYS + key0;
        const bf16* b = KT + ((size_t)bh * 128 + lr) * KEYS + key0;
        f32x16 acc[2][2]; zero_acc<2>(acc);
        gemm_mainloop<2>(acc, a, a + 64 * KEYS, a + 128 * KEYS, a + 192 * KEYS, b, b + 64 * KEYS, 128, smem);
        bf16* dst = F + ((size_t)(dir * 16 + bh) * 34 + c) * 32768;
        for (int h = 0; h < 2; ++h) {
            stage_half(acc, h, smem);
            __syncthreads();
            epi_plain_bf16((const float*)smem, dst, 128, h * 128, 0);
            __syncthreads();
        }
    }
}

__device__ void phase_ret_scan(const Params& p, int l) {
    const int tid = otid();
    unsigned* F = (unsigned*)(p.ws + OFF_F);
    for (int g = blockIdx.x * NT + tid; g < 2 * 16 * 16384; g += gridDim.x * NT) {
        const int e2 = g & 16383, bh = (g >> 14) & 15, dir = g >> 18, h = bh & 3;
        const float lg = log_sigmoid_(p.ret_logit[l * 8 + dir * 4 + h]);
        const float g128 = expf(128.f * lg);
        unsigned* base = F + (size_t)(dir * 16 + bh) * 34 * 16384 + e2;
        float s0 = 0.f, s1 = 0.f;
        for (int k = 0; k < 34; ++k) {
            int c;
            if (dir == 0) c = k == 0 ? 32 : (k == 1 ? 33 : k - 2);
            else c = k == 0 ? 33 : (k == 1 ? 32 : 33 - k);
            unsigned* ptr = base + (size_t)c * 16384;
            unsigned u = *ptr;
            *ptr = pack2(s0, s1);
            s0 = g128 * s0 + lo2f(u); s1 = g128 * s1 + hi2f(u);
        }
    }
}

__device__ void phase_ret3(const Params& p, int l, char* smem) {
    const int tid = otid(), lane = tid & 63, wave = tid >> 6, wm = wave >> 1, wn = wave & 1, lr = tid >> 3;
    const bf16* QR = (const bf16*)(p.ws + OFF_QR); const bf16* KR = (const bf16*)(p.ws + OFF_KR);
    const bf16* VT = (const bf16*)(p.ws + OFF_VR); bf16* UR = (bf16*)(p.ws + OFF_UR);
    const bf16* F = (const bf16*)(p.ws + OFF_F);
    bf16* SMs = (bf16*)(p.ws + OFF_SM) + (size_t)blockIdx.x * 128 * 128;
    float* red = (float*)(smem + 100 * 1024);
    const int nitems = 512 + (l == 0 ? 32 : 0);
    for (int it = blockIdx.x; it < nitems; it += gridDim.x) {
        int b, h, c;
        if (it < 512) { c = it & 31; h = (it >> 5) & 3; b = it >> 7; }
        else { int j = it - 512; c = 32 + (j & 1); h = (j >> 1) & 3; b = j >> 3; }
        const int bh = b * 4 + h;
        const int key0 = chunk_key0(c);
        const int row0 = c < 32 ? b * SEQ + c * 128 : TLAT + b * CTXL + (c - 32) * 128;
        const float lgf = log_sigmoid_(p.ret_logit[l * 8 + h]), lgb = log_sigmoid_(p.ret_logit[l * 8 + 4 + h]);
        const bf16* qrow = QR + (size_t)(row0 + lr) * 512 + h * 128;
        {
            f32x16 acc[1][2]; zero_acc<1>(acc);
            const bf16* kb = KR + (size_t)(row0 + lr) * 512 + h * 128;
            gemm_mainloop<1>(acc, qrow, qrow + 64 * 512, qrow, qrow, kb, kb + 64 * 512, 128, smem);
            stage_full(acc, smem);
            __syncthreads();
            const float* Ct = (const float*)smem;
            const int r = tid >> 2, q = tid & 3;
            float v[32];
#pragma unroll
            for (int jj = 0; jj < 32; ++jj) {
                const int j = 32 * q + jj; const int dd = r - j;
                const float dec = dd >= 0 ? expf((float)dd * lgf) : expf((float)(-dd) * lgb);
                v[jj] = Ct[r * CT_LD + j] * dec;
            }
            store32_bf16(SMs + (size_t)r * 128 + 32 * q, v);
            __threadfence_block();
            __syncthreads();
        }
        f32x16 acc[2][2]; zero_acc<2>(acc);
        {
            const bf16* a = VT + ((size_t)bh * 256 + lr) * KEYS + key0;
            const bf16* bb = SMs + (size_t)lr * 128;
            gemm_mainloop<2>(acc, a, a + 64 * KEYS, a + 128 * KEYS, a + 192 * KEYS, bb, bb + 64 * 128, 128, smem);
        }
        {
            const bf16* a = F + ((size_t)(0 * 16 + bh) * 34 + c) * 32768 + (size_t)lr * 128;
            gemm_mainloop<2, true>(acc, a, a + 64 * 128, a + 128 * 128, a + 192 * 128, qrow, qrow + 64 * 512, 128, smem,
                                   expf((float)(lr + 1) * lgf), expf((float)(lr + 65) * lgf));
        }
        {
            const bf16* a = F + ((size_t)(1 * 16 + bh) * 34 + c) * 32768 + (size_t)lr * 128;
            gemm_mainloop<2, true>(acc, a, a + 64 * 128, a + 128 * 128, a + 192 * 128, qrow, qrow + 64 * 512, 128, smem,
                                   expf((float)(128 - lr) * lgb), expf((float)(64 - lr) * lgb));
        }
        {
            float ss0 = 0.f, ss1 = 0.f;
#pragma unroll
            for (int mi = 0; mi < 2; ++mi)
#pragma unroll
                for (int r = 0; r < 16; ++r) { ss0 += acc[mi][0][r] * acc[mi][0][r]; ss1 += acc[mi][1][r] * acc[mi][1][r]; }
            ss0 += __shfl_xor(ss0, 32, 64); ss1 += __shfl_xor(ss1, 32, 64);
            if (lane < 32) { red[wm * 128 + wn * 64 + lane] = ss0; red[wm * 128 + wn * 64 + 32 + lane] = ss1; }
            __syncthreads();
            if (tid < 128) red[512 + tid] = rsqrtf((red[tid] + red[128 + tid] + red[256 + tid] + red[384 + tid]) * (1.f / 256.f) + EPS);
            __syncthreads();
        }
        for (int h2 = 0; h2 < 2; ++h2) {
            float* Ct = (float*)smem;
            if ((wm >> 1) == h2) {
#pragma unroll
                for (int mi = 0; mi < 2; ++mi)
#pragma unroll
                    for (int ni = 0; ni < 2; ++ni)
#pragma unroll
                        for (int r = 0; r < 16; ++r) {
                            const int el = (wm & 1) * 64 + mi * 32 + (r & 3) + 8 * (r >> 2) + 4 * (lane >> 5);
                            const int i = wn * 64 + ni * 32 + (lane & 31);
                            Ct[i * 133 + el] = acc[mi][ni][r];
                        }
            }
            __syncthreads();
            {
                const int i = tid >> 2, qq = tid & 3;
                const float rs = red[512 + i];
                bf16* up = UR + (size_t)(row0 + i) * 1024 + h * 256 + h2 * 128 + 32 * qq;
#pragma unroll
                for (int g = 0; g < 4; ++g) {
                    uint4 uu = *(const uint4*)(up + g * 8);
                    float uf[8]; unpack8(uu, uf);
                    float o[8];
#pragma unroll
                    for (int j = 0; j < 8; ++j) o[j] = Ct[i * 133 + 32 * qq + g * 8 + j] * rs * siluf_(uf[j]);
                    uint4 ov; ov.x = pack2(o[0], o[1]); ov.y = pack2(o[2], o[3]); ov.z = pack2(o[4], o[5]); ov.w = pack2(o[6], o[7]);
                    *(uint4*)(up + g * 8) = ov;
                }
            }
            __syncthreads();
        }
    }
}


namespace swa {
constexpr int KROWB = 144, VROWB = 136;
constexpr int KT_BYTES = 64 * KROWB, VT_BYTES = 64 * VROWB, BUF_BYTES = KT_BYTES + VT_BYTES;
constexpr float LOG2E = 1.4426950408889634f;
constexpr float THR = 8.f;
__device__ __forceinline__ int crow(int r, int hi) { return (r & 3) + 8 * (r >> 2) + 4 * hi; }

__device__ __forceinline__ void body(const Params& p, int l, int b, int kvh, int qrow0, int q0pos, char* lds) {
    const int tid = otid(), wid = tid >> 6, lane = tid & 63, r32 = lane & 31, hi = lane >> 5;
    bf16* QS = (bf16*)(p.ws + OFF_QS); const bf16* KS = (const bf16*)(p.ws + OFF_KS); const bf16* VT = (const bf16*)(p.ws + OFF_VS);
    float* wsl = (float*)(lds + 2 * BUF_BYTES) + wid * 64; float* li_l = wsl; float* al_l = wsl + 32;
    const int head = kvh * 8 + wid;
    const float sinkv = p.sink[l * 16 + head];
    float m_reg = sinkv, l_reg = 1.f;
    f32x16 o[2] = {};
    bf16x8 qr[4];
    bf16* Qw = QS + (size_t)(qrow0 + r32) * 1024 + head * 64 + hi * 8;
#pragma unroll
    for (int d0 = 0; d0 < 4; ++d0) qr[d0] = *reinterpret_cast<const bf16x8*>(Qw + d0 * 16);
    int t0 = 0, nloc = 0;
    if (q0pos >= 0) {
        const int lo = q0pos - 128 < 0 ? 0 : q0pos - 128, hiq = q0pos + 160 > SEQ ? SEQ : q0pos + 160;
        t0 = lo >> 6; nloc = ((hiq - 1) >> 6) - t0 + 1;
    }
    const int ntiles = nloc + 4;
    const int sk = tid >> 3, sch = tid & 7;
    const bf16* vtb = VT + ((size_t)(b * 2 + kvh) * 64 + sk) * KEYS + sch * 8;
    uint4 rk, rv;
#define TLOAD(t) do { const int t_ = (t); const bool loc_ = t_ < nloc; const int key0_ = loc_ ? (t0 + t_) * 64 : 4096 + (t_ - nloc) * 64; \
        const int krow_ = loc_ ? b * SEQ + key0_ : TLAT + b * CTXL + (t_ - nloc) * 64; \
        rk = *(const uint4*)(KS + (size_t)(krow_ + sk) * 128 + kvh * 64 + sch * 8); rv = *(const uint4*)(vtb + key0_); } while (0)
#define TWRITE(buf) do { char* kb_ = lds + (buf) * BUF_BYTES; *(uint4*)(kb_ + sk * KROWB + sch * 16) = rk; \
        char* vb_ = kb_ + KT_BYTES + sk * VROWB + sch * 16; *(uint2*)vb_ = make_uint2(rv.x, rv.y); *(uint2*)(vb_ + 8) = make_uint2(rv.z, rv.w); } while (0)
    TLOAD(0); TWRITE(0); __syncthreads();
    for (int t = 0; t < ntiles; ++t) {
        const char* Kb = lds + (t & 1) * BUF_BYTES; const char* Vb = Kb + KT_BYTES;
        const bool more = t + 1 < ntiles;
        if (more) TLOAD(t + 1);
        f32x16 p0 = {}, p1 = {};
#pragma unroll
        for (int d0 = 0; d0 < 4; ++d0) {
            bf16x8 k0 = *reinterpret_cast<const bf16x8*>(Kb + r32 * KROWB + (d0 * 16 + hi * 8) * 2);
            bf16x8 k1 = *reinterpret_cast<const bf16x8*>(Kb + (32 + r32) * KROWB + (d0 * 16 + hi * 8) * 2);
            p0 = __builtin_amdgcn_mfma_f32_32x32x16_bf16(k0, qr[d0], p0, 0, 0, 0);
            p1 = __builtin_amdgcn_mfma_f32_32x32x16_bf16(k1, qr[d0], p1, 0, 0, 0);
        }
        if (t < nloc) {
            const int kbase = (t0 + t) * 64 - (q0pos + r32);
#pragma unroll
            for (int r = 0; r < 16; ++r) {
                int d0_ = kbase + crow(r, hi); int d1_ = d0_ + 32;
                if (d0_ < -128 || d0_ > 128) p0[r] = -1e30f;
                if (d1_ < -128 || d1_ > 128) p1[r] = -1e30f;
            }
        }
        float pmax = p0[0];
#pragma unroll
        for (int r = 1; r < 16; ++r) pmax = fmaxf(pmax, p0[r]);
#pragma unroll
        for (int r = 0; r < 16; ++r) pmax = fmaxf(pmax, p1[r]);
        { auto rr = __builtin_amdgcn_permlane32_swap(__float_as_uint(pmax), __float_as_uint(pmax), false, false);
          pmax = fmaxf(__uint_as_float(rr[0]), __uint_as_float(rr[1])); }
        float alpha = 1.f;
        if (!__all(pmax - m_reg <= THR)) {
            const float mn = fmaxf(m_reg, pmax);
            alpha = __builtin_amdgcn_exp2f((m_reg - mn) * LOG2E); m_reg = mn;
            if (hi == 0) al_l[r32] = alpha;
            asm volatile("s_waitcnt lgkmcnt(0)" ::: "memory");
#pragma unroll
            for (int d = 0; d < 2; ++d)
#pragma unroll
                for (int r = 0; r < 16; ++r) o[d][r] *= al_l[crow(r, hi)];
        }
        const float mC = -m_reg * LOG2E;
        float ps = 0.f;
#pragma unroll
        for (int r = 0; r < 16; ++r) { p0[r] = __builtin_amdgcn_exp2f(fmaf(p0[r], LOG2E, mC)); ps += p0[r]; }
#pragma unroll
        for (int r = 0; r < 16; ++r) { p1[r] = __builtin_amdgcn_exp2f(fmaf(p1[r], LOG2E, mC)); ps += p1[r]; }
        { auto rr = __builtin_amdgcn_permlane32_swap(__float_as_uint(ps), __float_as_uint(ps), false, false);
          ps = __uint_as_float(rr[0]) + __uint_as_float(rr[1]); }
        l_reg = l_reg * alpha + ps;
#pragma unroll
        for (int s4 = 0; s4 < 4; ++s4) {
            unsigned w0, w1, w2, w3;
            if (s4 < 2) { w0 = pack2(p0[8 * s4 + 0], p0[8 * s4 + 1]); w1 = pack2(p0[8 * s4 + 2], p0[8 * s4 + 3]); w2 = pack2(p0[8 * s4 + 4], p0[8 * s4 + 5]); w3 = pack2(p0[8 * s4 + 6], p0[8 * s4 + 7]); }
            else { const int s2 = s4 - 2; w0 = pack2(p1[8 * s2 + 0], p1[8 * s2 + 1]); w1 = pack2(p1[8 * s2 + 2], p1[8 * s2 + 3]); w2 = pack2(p1[8 * s2 + 4], p1[8 * s2 + 5]); w3 = pack2(p1[8 * s2 + 6], p1[8 * s2 + 7]); }
            ga::u32x4 pw = {w0, w1, w2, w3};
            bf16x8 pa = *reinterpret_cast<bf16x8*>(&pw);
#pragma unroll
            for (int db = 0; db < 2; ++db) {
                const char* vp = Vb + (db * 32 + r32) * VROWB + (16 * s4 + 4 * hi) * 2;
                uint2 lo = *(const uint2*)vp, hi2 = *(const uint2*)(vp + 16);
                ga::u32x4 bw = {lo.x, lo.y, hi2.x, hi2.y};
                bf16x8 vb = *reinterpret_cast<bf16x8*>(&bw);
                o[db] = __builtin_amdgcn_mfma_f32_32x32x16_bf16(pa, vb, o[db], 0, 0, 0);
            }
        }
        if (more) TWRITE((t + 1) & 1);
        __syncthreads();
    }
    if (hi == 0) li_l[r32] = l_reg;
    asm volatile("s_waitcnt lgkmcnt(0)" ::: "memory");
    bf16* Ow = QS + (size_t)qrow0 * 1024 + head * 64;
#pragma unroll
    for (int r = 0; r < 16; ++r) {
        const int orow = crow(r, hi); const float rl = 1.f / li_l[orow];
#pragma unroll
        for (int db = 0; db < 2; ++db) Ow[(size_t)orow * 1024 + db * 32 + r32] = f2bf(o[db][r] * rl);
    }
    __syncthreads();
#undef TLOAD
#undef TWRITE
}
}

__device__ void phase_swa(const Params& p, int l, char* smem) {
    const int nitems = 1024 + (l == 0 ? 64 : 0);
    for (int it = blockIdx.x; it < nitems; it += gridDim.x) {
        if (it < 1024) {
            const int pair = it & 7, j = it >> 3, b = pair >> 1, kvh = pair & 1;
            swa::body(p, l, b, kvh, b * SEQ + j * 32, j * 32, smem);
        } else {
            const int j = it - 1024, pair = j & 7, qb = j >> 3, b = pair >> 1, kvh = pair & 1;
            swa::body(p, l, b, kvh, TLAT + b * CTXL + qb * 32, -1, smem);
        }
    }
}

__device__ void phase_mixers_naive(const Params& p, int l, char* smem) {
    const int n_sw = 32768 + (l == 0 ? 2048 : 0);
    for (int it = blockIdx.x; it < n_sw; it += gridDim.x) swa_naive_item(p, l, it, smem);
}


#define XB_TMO      128
#define XB_XCNT(j)  (256  + 64 * (j))
#define XB_XSUB(j)  (1280 + 64 * (j))
#define XB_XGEN(j)  (2304 + 64 * (j))
#define XB_TOP      3328
#define XB_TOPGEN   3392
#define XCD_BAR_WORDS 3456
#define XB_SPIN_CAP (1u << 22)
#define LAS __attribute__((address_space(3)))
__device__ __forceinline__ unsigned xb_ld(unsigned* p)              { return __hip_atomic_load(p, __ATOMIC_RELAXED, __HIP_MEMORY_SCOPE_AGENT); }
__device__ __forceinline__ unsigned xb_add(unsigned* p, unsigned v) { return __hip_atomic_fetch_add(p, v, __ATOMIC_RELAXED, __HIP_MEMORY_SCOPE_AGENT); }
__device__ __forceinline__ unsigned xb_xcc_id() { return (unsigned)__builtin_amdgcn_s_getreg((3 << 11) | 20) & 0xFu; }
#define XB_SPIN(cond, bar) do { unsigned _sp = 0; while (cond) { __builtin_amdgcn_s_sleep(1); \
    if ((++_sp & 255u) == 0u) { if (xb_ld(&(bar)[XB_TMO])) break; if (_sp > XB_SPIN_CAP) { atomicAdd(&(bar)[XB_TMO], 1u); break; } } } } while (0)
struct XcdBarrier { unsigned* bar; unsigned x; volatile LAS unsigned* st; };
__device__ __forceinline__ XcdBarrier xcd_barrier_post(unsigned* bar, volatile LAS unsigned* st) {
    XcdBarrier b; b.bar = bar; b.x = xb_xcc_id(); b.st = st;
    if (threadIdx.x == 0) (void)xb_add(&bar[XB_XCNT(b.x)], 1u);
    return b;
}
__device__ __forceinline__ void xcd_barrier_complete(unsigned* bar, unsigned x, unsigned& nloc, unsigned& nx) {
    const unsigned G = gridDim.x * gridDim.y * gridDim.z;
    unsigned sum, cnt, mine, sp = 0u;
    for (;;) {
        sum = 0u; cnt = 0u; mine = 0u;
#pragma unroll
        for (unsigned j = 0; j < 16; ++j) { const unsigned c = xb_ld(&bar[XB_XCNT(j)]); sum += c; cnt += (c > 0u) ? 1u : 0u; mine = (j == x) ? c : mine; }
        if (sum == G) break;
        __builtin_amdgcn_s_sleep(1);
        if ((++sp & 255u) == 0u) { if (xb_ld(&bar[XB_TMO])) break; if (sp > XB_SPIN_CAP) { atomicAdd(&bar[XB_TMO], 1u); break; } }
    }
    nloc = mine > 0u ? mine : 1u; nx = cnt > 0u ? cnt : 1u;
}
__device__ __forceinline__ void xcd_barrier(const XcdBarrier& b) {
    asm volatile("s_waitcnt vmcnt(0)" ::: "memory");
    __syncthreads();
    if (threadIdx.x == 0) {
        unsigned* bar = b.bar;
        __builtin_amdgcn_s_waitcnt(0);
        unsigned nloc = b.st[0], nx = b.st[1];
        if (nloc == 0u) { xcd_barrier_complete(bar, b.x, nloc, nx); b.st[0] = nloc; b.st[1] = nx; }
        const unsigned old = xb_add(&bar[XB_XSUB(b.x)], 1u);
        const unsigned gen = old / nloc;
        if (old + 1u == (gen + 1u) * nloc) {
            __builtin_amdgcn_fence(__ATOMIC_RELEASE, "agent");
            asm volatile("s_waitcnt vmcnt(0)" ::: "memory");
            const unsigned og = xb_add(&bar[XB_TOP], 1u);
            const unsigned tg = og / nx;
            if (og + 1u == (tg + 1u) * nx) xb_add(&bar[XB_TOPGEN], 1u);
            else XB_SPIN(xb_ld(&bar[XB_TOPGEN]) == tg, bar);
            __builtin_amdgcn_fence(__ATOMIC_ACQUIRE, "agent");
            xb_add(&bar[XB_XGEN(b.x)], 1u);
            asm volatile("s_waitcnt vmcnt(0)" ::: "memory");
        } else {
            XB_SPIN(xb_ld(&bar[XB_XGEN(b.x)]) == gen, bar);
            __builtin_amdgcn_fence(__ATOMIC_ACQUIRE, "agent");
            asm volatile("s_waitcnt vmcnt(0)" ::: "memory");
        }
    }
    __syncthreads();
}

constexpr int PH_PER_LAYER = 10;
constexpr int NPHASE = 2 + 2 * PH_PER_LAYER;
constexpr int LDS_BYTES = GEMM_LDS;

__device__ void run_phase(const Params& p, int ph, char* smem) {
#ifndef PHASE_MASK
    if (ph == 0) { phase0(p, smem); return; }
    if (ph == NPHASE - 1) { phase_final(p); return; }
#else
    if (ph == 0 || ph == NPHASE - 1) return;
#endif
    const int l = (ph - 1) / PH_PER_LAYER, s = (ph - 1) % PH_PER_LAYER;
#ifdef PHASE_MASK
    if (!((PHASE_MASK >> s) & 1)) return;
#endif
    switch (s) {
        case 0: phase_norm1(p, l); break;
        case 1: phase_inproj(p, l, smem); break;
        case 2: phase_ga(p, l, smem); phase_ret1(p, l, smem); phase_swa(p, l, smem); break;
        case 3: phase_ret_scan(p, l); break;
        case 4: phase_ret3(p, l, smem); break;
        case 5: phase_merge(p, l, smem); break;
        case 6: phase_outproj(p, l, smem); break;
        case 7: {
            phase_norm2(p, l);
            for (int it = blockIdx.x; it < MOE_CONV_TILES; it += gridDim.x) moe_conv_item(p, l, it, smem);
            if (l == 0) for (int it = blockIdx.x; it < CONV_TILES_LAYER; it += gridDim.x) conv_item(p, 1, it, smem);
        } break;
        case 8: phase_moe1(p, l, smem); break;
        case 9: phase_moe2(p, l, smem); break;
    }
}

__global__ void __launch_bounds__(NT, 2) mega(Params p) {
    extern __shared__ __attribute__((aligned(16))) char smem[];
    cg::grid_group grid = cg::this_grid();
    volatile LAS unsigned* st = (volatile LAS unsigned*)(smem + LDS_BYTES);
    if (threadIdx.x < 4) st[threadIdx.x] = 0u;
    __syncthreads();
    XcdBarrier bar = xcd_barrier_post((unsigned*)(p.ws + OFF_BAR), st);
    for (int ph = p.ph_lo; ph < p.ph_hi; ++ph) {
        run_phase(p, ph, smem);
        if (ph + 1 < p.ph_hi) {
            if (ph == p.ph_lo) grid.sync();
            else xcd_barrier(bar);
        }
    }
}

extern "C" void kernel_launch(void* const* d_in, const int* in_sizes, int n_in, void* d_out, int out_size, void* d_ws, size_t ws_size,
                              hipStream_t stream) {
    static int grid_blocks = 0;
    if (!grid_blocks) {
        int dev = 0, cus = 0, per_cu = 0;
        hipGetDevice(&dev);
        hipDeviceGetAttribute(&cus, hipDeviceAttributeMultiprocessorCount, dev);
        hipFuncSetAttribute((const void*)mega, hipFuncAttributeMaxDynamicSharedMemorySize, LDS_BYTES + 16);
        hipOccupancyMaxActiveBlocksPerMultiprocessor(&per_cu, (const void*)mega, NT, LDS_BYTES + 16);
        if (per_cu < 1) { fprintf(stderr, "occupancy query returned %d\n", per_cu); per_cu = 1; }
        if (per_cu > 1) per_cu = 1;
        grid_blocks = cus * per_cu; if (grid_blocks > MAXBLK) grid_blocks = MAXBLK;
        if (ws_size < WS_END) fprintf(stderr, "workspace too small: %zu < %zu\n", ws_size, (size_t)WS_END);
    }
    Params p{};
    const float** f = (const float**)&p;
    for (int i = 0; i < 23; ++i) f[i] = (const float*)d_in[i];
    p.out = (float*)d_out; p.ws = (unsigned char*)d_ws;
#if MULTI_LAUNCH
    for (int ph = 0; ph < NPHASE; ++ph) {
        p.ph_lo = ph; p.ph_hi = ph + 1;
        hipMemsetAsync((char*)d_ws + OFF_BAR, 0, 16384, stream);
        hipLaunchKernelGGL(mega, dim3(grid_blocks), dim3(NT), LDS_BYTES + 16, stream, p);
    }
#else
    p.ph_lo = 0; p.ph_hi = NPHASE;
    void* args[] = {&p};
    hipMemsetAsync((char*)d_ws + OFF_BAR, 0, 16384, stream);
    hipError_t e = hipLaunchCooperativeKernel((const void*)mega, dim3(grid_blocks), dim3(NT), args, LDS_BYTES + 16, stream);
    if (e != hipSuccess) fprintf(stderr, "cooperative launch failed: %s (grid %d)\n", hipGetErrorString(e), grid_blocks);
#endif
}
```

```cpp
#include <hip/hip_runtime.h>
#include <hip/hip_cooperative_groups.h>
#include <cstdio>
#include <cstdint>
namespace cg = cooperative_groups;

#ifndef MULTI_LAUNCH
#define MULTI_LAUNCH 0
#endif

typedef unsigned short bf16;
typedef __attribute__((ext_vector_type(8))) short bf16x8;
typedef __attribute__((ext_vector_type(16))) float f32x16;

constexpr int NT = 512;
constexpr int D = 1024, NB = 4, SEQ = 4096, CTXL = 256;
constexpr int TLAT = NB * SEQ, TCTX = NB * CTXL, TALL = TLAT + TCTX;
constexpr int DIN = 8960, DQKV = 5888;
constexpr int NEXP = 16, DEXP = 512;
constexpr float EPS = 1e-6f;

constexpr size_t OFF_CTL  = 0;
constexpr size_t OFF_BAR  = 4096;
constexpr size_t OFF_LTS  = 4096 + 16384;
constexpr size_t OFF_LW   = OFF_LTS + (size_t)16 * TALL * 4;
constexpr size_t OFF_MOD  = OFF_LW + (size_t)16 * TALL * 4;
constexpr size_t OFF_ROPE = OFF_MOD + (size_t)2 * 5 * 6144 * 4;
constexpr size_t OFF_DEC  = OFF_ROPE + 65536;
constexpr size_t OFF_CX   = OFF_DEC + 32768;
constexpr size_t OFF_H    = OFF_CX + (size_t)TCTX * D * 4;
constexpr size_t OFF_QR   = OFF_H + (size_t)TALL * 1024 * 2;
constexpr size_t OFF_KR   = OFF_QR + (size_t)TALL * 512 * 2;
constexpr size_t OFF_VR   = OFF_KR + (size_t)TALL * 512 * 2;
constexpr size_t OFF_UR   = OFF_VR + (size_t)TALL * 1024 * 2;
constexpr size_t OFF_QS   = OFF_UR + (size_t)TALL * 1024 * 2;
constexpr size_t OFF_KS   = OFF_QS + (size_t)TALL * 1024 * 2;
constexpr size_t OFF_VS   = OFF_KS + (size_t)TALL * 128 * 2;
constexpr size_t OFF_QA   = OFF_VS + (size_t)TALL * 128 * 2;
constexpr size_t OFF_KA   = OFF_QA + (size_t)TALL * 1024 * 2;
constexpr size_t OFF_VA   = OFF_KA + (size_t)TALL * 256 * 2;
constexpr size_t OFF_F    = OFF_VA + (size_t)TALL * 256 * 2;
constexpr size_t F_BYTES  = (size_t)71303168;
constexpr size_t OFF_WT   = OFF_F + F_BYTES;
constexpr int WR_G = 6656, WR_BR = 9728, WR_OUT = 12800, WT_ROWS = 13824;
constexpr size_t WT_LAYER = (size_t)WT_ROWS * 1024 * 2;
constexpr size_t OFF_KFT  = OFF_WT + WT_LAYER;
constexpr size_t OFF_KBT  = OFF_KFT + (size_t)16 * 128 * 4352 * 2;
constexpr size_t OFF_SM   = OFF_KBT + (size_t)16 * 128 * 4352 * 2;
constexpr int MAXBLK = 320;
constexpr size_t OFF_GC   = OFF_SM + (size_t)MAXBLK * 128 * 128 * 2;
constexpr size_t OFF_PC   = OFF_GC + (size_t)3 * 1024 * 1024 * 2;
constexpr size_t WS_END   = OFF_PC + (size_t)3 * 1024 * 1024 * 2;
constexpr int KEYS = 4352;
constexpr size_t OFF_Y    = OFF_QR;
constexpr size_t OFF_HB   = OFF_VR;
constexpr size_t OFF_YB   = OFF_QS;
constexpr size_t OFF_WGU  = OFF_F;
constexpr size_t OFF_WD   = OFF_F + (size_t)16 * 1024 * 1024 * 2;

struct Params {
    const float *x, *c, *ctx, *c_ctx, *w_mod, *b_mod, *g1, *g2, *w_in, *ret_logit, *sink, *gq, *gk,
                *w_br_ret, *w_br_swa, *w_br_ga, *w_out, *w_router, *b_router, *w_gate, *w_up, *w_down, *g_final;
    float* out;
    unsigned char* ws;
    int ph_lo, ph_hi;
};

#ifdef PROBE_A
__device__ unsigned long long g_probe_tA, g_probe_tk;
#define PROBE_MARK(id) do { if ((id) == PROBE_A) { if (blockIdx.x == PROBE_BLK && threadIdx.x == 0) g_probe_tA = __builtin_amdgcn_s_memrealtime(); } \
    if ((id) == PROBE_B) { if (blockIdx.x == PROBE_BLK && threadIdx.x == 0) g_probe_tk = __builtin_amdgcn_s_memrealtime() - g_probe_tA; } } while (0)
#else
#define PROBE_MARK(id) do {} while (0)
#endif
__device__ __forceinline__ int otid() { int t = threadIdx.x; asm volatile("" : "+v"(t)); return t; }
__device__ __forceinline__ bf16 f2bf(float f) { unsigned u = __float_as_uint(f); u += 0x7fffu + ((u >> 16) & 1u); return (bf16)(u >> 16); }
__device__ __forceinline__ float bf2f(bf16 h) { return __uint_as_float(((unsigned)h) << 16); }
typedef float f32x2_t __attribute__((ext_vector_type(2)));
typedef __bf16 bf16x2_t __attribute__((ext_vector_type(2)));
__device__ __forceinline__ unsigned pack2(float a, float b) { f32x2_t v = {a, b}; bf16x2_t r = __builtin_convertvector(v, bf16x2_t); return __builtin_bit_cast(unsigned, r); }
__device__ __forceinline__ float lo2f(unsigned u) { return __uint_as_float(u << 16); }
__device__ __forceinline__ float hi2f(unsigned u) { return __uint_as_float(u & 0xffff0000u); }
__device__ __forceinline__ void unpack8(uint4 u, float (&f)[8]) {
    f[0] = lo2f(u.x); f[1] = hi2f(u.x); f[2] = lo2f(u.y); f[3] = hi2f(u.y); f[4] = lo2f(u.z); f[5] = hi2f(u.z); f[6] = lo2f(u.w); f[7] = hi2f(u.w);
}
__device__ __forceinline__ float shx(float v, int o, int lane) { return __int_as_float(__builtin_amdgcn_ds_bpermute((lane ^ o) << 2, __float_as_int(v))); }
__device__ __forceinline__ int shup(int v, int o, int lane) { return __builtin_amdgcn_ds_bpermute(((lane - o) & 63) << 2, v); }
__device__ __forceinline__ float wsum(float v, int lane) {
#pragma unroll
    for (int o = 32; o > 0; o >>= 1) v += shx(v, o, lane);
    return v;
}
__device__ __forceinline__ float wmax(float v, int lane) {
#pragma unroll
    for (int o = 32; o > 0; o >>= 1) v = fmaxf(v, shx(v, o, lane));
    return v;
}
__device__ __forceinline__ float fexp_(float x) { return __builtin_amdgcn_exp2f(x * 1.4426950408889634f); }
__device__ __forceinline__ float flogsig_(float x) { return -0.6931471805599453f * __builtin_amdgcn_logf(1.f + fexp_(-x)); }
__device__ __forceinline__ float sigmoidf_(float x) { return 1.f / (1.f + expf(-x)); }
__device__ __forceinline__ float siluf_(float x) { return x / (1.f + expf(-x)); }
__device__ __forceinline__ float fsilu_(float x) { return x * __builtin_amdgcn_rcpf(1.f + __builtin_amdgcn_exp2f(-1.4426950408889634f * x)); }

__device__ __forceinline__ void mod_item(const Params& p, int item, char* smem) {
    float* sc = (float*)smem;
    float* red = sc + 5 * 1024;
    const int tid = otid();
    for (int i = tid; i < 5 * 1024; i += NT) {
        int v = i >> 10, k = i & 1023;
        float xv = v < 4 ? p.c[v * 1024 + k] : p.c_ctx[k];
        sc[i] = siluf_(xv);
    }
    __syncthreads();
    const int l = item / 96, cgp = item % 96, cq = tid & 15, ks = tid >> 4;
    const float* w = p.w_mod + (size_t)l * 1024 * 6144 + cgp * 64 + cq * 4;
    float4 a0 = {0, 0, 0, 0}, a1 = a0, a2 = a0, a3 = a0, a4 = a0;
#pragma unroll 8
    for (int kk = 0; kk < 32; ++kk) {
        const int k = ks * 32 + kk;
        const float4 wv = *(const float4*)(w + (size_t)k * 6144);
        const float s0 = sc[k], s1 = sc[1024 + k], s2 = sc[2048 + k], s3 = sc[3072 + k], s4 = sc[4096 + k];
        a0.x += s0 * wv.x; a0.y += s0 * wv.y; a0.z += s0 * wv.z; a0.w += s0 * wv.w;
        a1.x += s1 * wv.x; a1.y += s1 * wv.y; a1.z += s1 * wv.z; a1.w += s1 * wv.w;
        a2.x += s2 * wv.x; a2.y += s2 * wv.y; a2.z += s2 * wv.z; a2.w += s2 * wv.w;
        a3.x += s3 * wv.x; a3.y += s3 * wv.y; a3.z += s3 * wv.z; a3.w += s3 * wv.w;
        a4.x += s4 * wv.x; a4.y += s4 * wv.y; a4.z += s4 * wv.z; a4.w += s4 * wv.w;
    }
    *(float4*)(red + (ks * 5 + 0) * 64 + cq * 4) = a0; *(float4*)(red + (ks * 5 + 1) * 64 + cq * 4) = a1; *(float4*)(red + (ks * 5 + 2) * 64 + cq * 4) = a2;
    *(float4*)(red + (ks * 5 + 3) * 64 + cq * 4) = a3; *(float4*)(red + (ks * 5 + 4) * 64 + cq * 4) = a4;
    __syncthreads();
    if (tid < 320) {
        int v = tid >> 6, c2 = tid & 63; float sum = 0;
        for (int k2 = 0; k2 < 32; ++k2) sum += red[(k2 * 5 + v) * 64 + c2];
        float* mod = (float*)(p.ws + OFF_MOD);
        mod[(size_t)(l * 5 + v) * 6144 + cgp * 64 + c2] = sum + p.b_mod[l * 6144 + cgp * 64 + c2];
    }
    __syncthreads();
}

__device__ __forceinline__ int inproj_col_normal(int unit, int p) {
    const int bj = p >> 7, w = p & 127;
    const int r128 = 128 * (w >> 6) + 64 * ((w >> 5) & 1) + 32 * bj + (w & 31);
    if (unit < 2) return 0 + 256 * unit + r128;
    if (unit < 4) return 512 + 256 * (unit - 2) + r128;
    if (unit < 8) return 2048 + 256 * (unit - 4) + p;
    if (unit < 12) return 3072 + 256 * (unit - 8) + 64 * (w >> 5) + 32 * ((w >> 4) & 1) + 16 * bj + (w & 15);
    if (unit == 12) return 4096 + 64 * ((w >> 5) & 1) + 32 * ((w >> 4) & 1) + 16 * bj + (w & 15);
    if (unit < 17) return 4352 + 256 * (unit - 13) + r128;
    if (unit == 17) return 5376 + r128;
    return 5632 + p;
}
__device__ __forceinline__ int inproj_col_swapped(int sidx, int r) {
    const int ai = r >> 7, w = r & 127;
    if (sidx < 4) return 1024 + 256 * sidx + r;
    if (sidx < 6) return 512 + 128 * (2 * (sidx - 4) + (w >> 6)) + 64 * ((w >> 5) & 1) + 32 * ai + (w & 31);
    return 4224 + (r & 127);
}

constexpr int CONV_NONMOE = 16 * (WT_ROWS / 256);
constexpr int CONV_MOE = 1024 + 512;
struct ConvTile { const float* s[4]; int ld; bf16* dst; int dld; };
__device__ __forceinline__ ConvTile conv_tile_nonmoe(const Params& p, int l, int it) {
    ConvTile t; const int lane64 = otid() & 63;
    const int kt = it & 15, rg = it >> 4;
    t.dst = (bf16*)(p.ws + OFF_WT) + (size_t)rg * 256 * 1024 + kt * 64; t.dld = 1024;
#pragma unroll
    for (int j = 0; j < 4; ++j) {
        const int R = rg * 256 + lane64 + 64 * j;
        const float* src; int ld, col;
        if (R < WR_G) { src = p.w_in + (size_t)l * 1024 * DIN; ld = DIN;
            if (R < 4864) col = inproj_col_normal(R >> 8, R & 255); else col = inproj_col_swapped((R - 4864) >> 8, (R - 4864) & 255); }
        else if (R < WR_BR) { src = p.w_in + (size_t)l * 1024 * DIN; ld = DIN; col = 5888 + (R - WR_G); }
        else if (R < WR_OUT) { const int br = (R - WR_BR) >> 10; src = (br == 0 ? p.w_br_ret : br == 1 ? p.w_br_swa : p.w_br_ga) + (size_t)l * 1024 * 1024; ld = 1024; col = (R - WR_BR) & 1023; }
        else { src = p.w_out + (size_t)l * 1024 * 1024; ld = 1024; col = R - WR_OUT; }
        t.s[j] = src + (size_t)kt * 64 * ld + col; t.ld = ld;
    }
    return t;
}
__device__ __forceinline__ ConvTile conv_tile_moe(const Params& p, int l, int it) {
    ConvTile t; const int lane64 = otid() & 63;
    if (it < 1024) {
        const int kt = it & 15, u = (it >> 4) & 3, e = it >> 6;
        t.dst = (bf16*)(p.ws + OFF_WGU) + ((size_t)e * 1024 + u * 256) * 1024 + kt * 64; t.dld = 1024; t.ld = 512;
#pragma unroll
        for (int j = 0; j < 4; ++j) {
            const float* src = (j < 2 ? p.w_gate : p.w_up) + ((size_t)(l * 16 + e) * 1024 + (size_t)kt * 64) * 512;
            t.s[j] = src + 128 * u + lane64 + 64 * (j & 1);
        }
    } else {
        const int i2 = it - 1024; const int kt = i2 & 7, g = (i2 >> 3) & 3, e = i2 >> 5;
        t.dst = (bf16*)(p.ws + OFF_WD) + ((size_t)e * 1024 + g * 256) * 512 + kt * 64; t.dld = 512; t.ld = 1024;
#pragma unroll
        for (int j = 0; j < 4; ++j) t.s[j] = p.w_down + ((size_t)(l * 16 + e) * 512 + (size_t)kt * 64) * 1024 + 256 * g + lane64 + 64 * j;
    }
    return t;
}
__device__ __forceinline__ void conv_run(const Params& p, int l, int which, char* smem, int b0 = 0) {
    const int tid = otid(), wave = tid >> 6, lane = tid & 63;
    const int ntiles = which ? CONV_MOE : CONV_NONMOE;
    unsigned* T = (unsigned*)smem;
    float va[4][8], vb[4][8];
    if ((int)blockIdx.x < b0) return;
    const int cstride = gridDim.x - b0;
    int it = blockIdx.x - b0;
    if (it >= ntiles) return;
    ConvTile ct = which ? conv_tile_moe(p, l, it) : conv_tile_nonmoe(p, l, it);
#define CONV_LOAD(dstv, tile) do { _Pragma("unroll") for (int j = 0; j < 4; ++j) _Pragma("unroll") for (int r = 0; r < 8; ++r) dstv[j][r] = (tile).s[j][(size_t)(wave * 8 + r) * (tile).ld]; } while (0)
    CONV_LOAD(va, ct);
    for (;;) {
        const int nit = it + cstride; const bool more = nit < ntiles;
        ConvTile nt = ct;
        if (more) { nt = which ? conv_tile_moe(p, l, nit) : conv_tile_nonmoe(p, l, nit); CONV_LOAD(vb, nt); }
#pragma unroll
        for (int j = 0; j < 4; ++j)
#pragma unroll
            for (int r = 0; r < 8; r += 2) T[(lane + 64 * j) * 33 + wave * 4 + (r >> 1)] = pack2(va[j][r], va[j][r + 1]);
        __syncthreads();
        {
            const int n = tid >> 1, half = tid & 1;
            const unsigned* row = T + n * 33 + half * 16;
            uint4 o0, o1, o2, o3;
            o0.x = row[0]; o0.y = row[1]; o0.z = row[2]; o0.w = row[3]; o1.x = row[4]; o1.y = row[5]; o1.z = row[6]; o1.w = row[7];
            o2.x = row[8]; o2.y = row[9]; o2.z = row[10]; o2.w = row[11]; o3.x = row[12]; o3.y = row[13]; o3.z = row[14]; o3.w = row[15];
            uint4* d = (uint4*)(ct.dst + (size_t)n * ct.dld + half * 32);
            d[0] = o0; d[1] = o1; d[2] = o2; d[3] = o3;
        }
        __syncthreads();
        if (!more) break;
        it = nit; ct = nt;
#pragma unroll
        for (int j = 0; j < 4; ++j)
#pragma unroll
            for (int r = 0; r < 8; ++r) va[j][r] = vb[j][r];
    }
#undef CONV_LOAD
}

__device__ __forceinline__ void phase0(const Params& p, char* smem) {
    const int tid = otid();
    if (blockIdx.x == 0) { int* ctl = (int*)(p.ws + OFF_CTL); if (tid < 64) ctl[tid] = 0; }
    {
        const int tb = gridDim.x > 192 ? 192 : 0;
        const int nb = (int)gridDim.x - tb, b0 = (int)blockIdx.x - tb;
        if (b0 >= 0) {
            const int g0 = b0 * NT + otid(); const int gs = nb * NT;
            float* rp = (float*)(p.ws + OFF_ROPE);
            for (int i = g0; i < 64 * 32; i += gs) {
                int pos = i >> 5, j = i & 31;
                float fr = exp2f(-(float)j * (13.287712379549449f / 32.f)); float a = (float)pos * fr;
                rp[i] = cosf(a); rp[2048 + i] = sinf(a);
            }
            for (int i = g0; i < 64 * 16; i += gs) {
                int pos = i >> 4, j = i & 15;
                float fr = exp2f(-(float)j * (13.287712379549449f / 16.f)); float a = (float)pos * fr;
                rp[4096 + i] = cosf(a); rp[4096 + 1024 + i] = sinf(a);
            }
            for (int i = g0; i < 64 * 32; i += gs) {
                int j = i >> 6, pos = i & 63;
                float fr = exp2f(-(float)j * (13.287712379549449f / 32.f)); float a = (float)pos * fr;
                rp[6144 + i] = cosf(a); rp[8192 + i] = sinf(a);
            }
            float* dec = (float*)(p.ws + OFF_DEC);
            if (g0 < 16) { const float x = p.ret_logit[g0]; dec[g0] = flogsig_(x); }
            if (b0 == 0 && tid < 64) {
#pragma unroll
                for (int l2 = 0; l2 < 2; ++l2) {
                    float mq = fmaxf(fabsf(p.gq[l2 * 128 + tid]), fabsf(p.gq[l2 * 128 + 64 + tid])), mk = fmaxf(fabsf(p.gk[l2 * 128 + tid]), fabsf(p.gk[l2 * 128 + 64 + tid]));
                    mq = wmax(mq, tid); mk = wmax(mk, tid);
                    if (tid == 0) dec[16 + l2] = 128.f * mq * mk;
                }
            }
            for (int i = g0; i < 2 * 4 * 128; i += gs) {
                const int j = i & 127, h = (i >> 7) & 3, l = i >> 9;
                const float lgf = flogsig_(p.ret_logit[l * 8 + h]), lgb = flogsig_(p.ret_logit[l * 8 + 4 + h]);
                float* d = dec + 64 + (size_t)((l * 4 + h) * 6) * 128;
                const float ks = 0.08838834764831845f;
                d[j] = ks * fexp_((float)(127 - j) * lgf); d[128 + j] = ks * fexp_((float)j * lgb);
                d[256 + j] = fexp_((float)(j + 1) * lgf); d[384 + j] = fexp_((float)(128 - j) * lgb);
                d[512 + j] = fexp_((float)j * lgf); d[640 + j] = fexp_((float)j * lgb);
            }
        }
    }
    for (int it = blockIdx.x; it < 192; it += gridDim.x) mod_item(p, it, smem);
    conv_run(p, 0, 0, smem);
}

struct RowIn { float4 x[4]; uint2 y0[4], y1[4]; };
__device__ __forceinline__ void norm1_load(const Params& p, int l, int r, int lane, RowIn& d) {
    const bool isctx = r >= TLAT;
    if (l == 0) {
        const float* xin = isctx ? p.ctx + (size_t)(r - TLAT) * D : p.x + (size_t)r * D;
#pragma unroll
        for (int j = 0; j < 4; ++j) d.x[j] = *(const float4*)(xin + j * 256 + lane * 4);
    } else {
        const float* xr = isctx ? (const float*)(p.ws + OFF_CX) + (size_t)(r - TLAT) * D : p.out + (size_t)r * D;
        const bf16* YB = (const bf16*)(p.ws + OFF_YB);
#pragma unroll
        for (int j = 0; j < 4; ++j) {
            const int col = j * 256 + lane * 4;
            d.x[j] = *(const float4*)(xr + col);
            d.y0[j] = *(const uint2*)(YB + (size_t)(r * 2) * D + col); d.y1[j] = *(const uint2*)(YB + (size_t)(r * 2 + 1) * D + col);
        }
    }
}
__device__ __forceinline__ void phase_norm1(const Params& p, int l) {
    const int tid = otid(), wave = tid >> 6, lane = tid & 63;
    const float* mod = (const float*)(p.ws + OFF_MOD);
    float* CX = (float*)(p.ws + OFF_CX);
    bf16* H = (bf16*)(p.ws + OFF_H);
    const int stride = gridDim.x * 8;
    int r = blockIdx.x * 8 + wave;
    RowIn cur, nxt;
    if (r < TALL) norm1_load(p, l, r, lane, cur);
    while (r < TALL) {
        const int rn = r + stride;
        if (rn < TALL) norm1_load(p, l, rn, lane, nxt);
        const bool isctx = r >= TLAT; const int v = isctx ? 4 : r / SEQ;
        float4 xv[4];
        if (l == 0) {
#pragma unroll
            for (int j = 0; j < 4; ++j) xv[j] = cur.x[j];
        } else {
            float* xr = isctx ? CX + (size_t)(r - TLAT) * D : p.out + (size_t)r * D;
            const float* gt2 = mod + (size_t)((l - 1) * 5 + v) * 6144 + 5 * 1024;
#pragma unroll
            for (int j = 0; j < 4; ++j) {
                const int col = j * 256 + lane * 4;
                float4 a = cur.x[j]; const float4 g = *(const float4*)(gt2 + col);
                const uint2 y0 = cur.y0[j], y1 = cur.y1[j];
                a.x += g.x * (lo2f(y0.x) + lo2f(y1.x)); a.y += g.y * (hi2f(y0.x) + hi2f(y1.x));
                a.z += g.z * (lo2f(y0.y) + lo2f(y1.y)); a.w += g.w * (hi2f(y0.y) + hi2f(y1.y));
                *(float4*)(xr + col) = a; xv[j] = a;
            }
        }
        float ss = 0;
#pragma unroll
        for (int j = 0; j < 4; ++j) ss += xv[j].x * xv[j].x + xv[j].y * xv[j].y + xv[j].z * xv[j].z + xv[j].w * xv[j].w;
        ss = wsum(ss, lane);
        const float rstd = rsqrtf(ss * (1.f / 1024.f) + EPS);
        const float* md = mod + (size_t)(l * 5 + v) * 6144;
#pragma unroll
        for (int j = 0; j < 4; ++j) {
            const int col = j * 256 + lane * 4;
            const float4 g = *(const float4*)(p.g1 + l * 1024 + col), sh = *(const float4*)(md + col), sc = *(const float4*)(md + 1024 + col);
            const float h0 = xv[j].x * rstd * g.x * (1.f + sc.x) + sh.x, h1 = xv[j].y * rstd * g.y * (1.f + sc.y) + sh.y;
            const float h2 = xv[j].z * rstd * g.z * (1.f + sc.z) + sh.z, h3 = xv[j].w * rstd * g.w * (1.f + sc.w) + sh.w;
            uint2 o; o.x = pack2(h0, h1); o.y = pack2(h2, h3);
            *(uint2*)(H + (size_t)r * D + col) = o;
        }
        cur = nxt; r = rn;
    }
}

__device__ __forceinline__ int kiter_max(int nrows, int g) { return (nrows + g * 8 - 1) / (g * 8); }
__device__ __forceinline__ void phase_norm2(const Params& p, int l, char* smem) {
    const int tid = otid(), wave = tid >> 6, lane = tid & 63;
    const float* mod = (const float*)(p.ws + OFF_MOD);
    const float* CX = (const float*)(p.ws + OFF_CX);
    bf16* H = (bf16*)(p.ws + OFF_H);
    int* cnt = (int*)(p.ws + OFF_CTL) + l * 16;
    int* lts = (int*)(p.ws + OFF_LTS);
    float* lw = (float*)(p.ws + OFF_LW);
    const int nrows = (l == 0) ? TALL : TLAT;
    int* lcnt = (int*)smem;
    int* rinfo = lcnt + 32;
    float* wrT = (float*)(smem + 4096);
    if (tid < 32) lcnt[tid] = 0;
    for (int i = tid; i < 16 * 1024; i += NT) { const int col = i >> 4, e = i & 15; wrT[e * 1024 + col] = p.w_router[i]; }
    __syncthreads();
    int kiter = 0;
    for (int r = blockIdx.x * 8 + wave; r < nrows; r += gridDim.x * 8, ++kiter) {
        const bool isctx = r >= TLAT; const int v = isctx ? 4 : r / SEQ;
        const float* xr = isctx ? CX + (size_t)(r - TLAT) * D : p.out + (size_t)r * D;
        float4 xv[4];
#pragma unroll
        for (int j = 0; j < 4; ++j) xv[j] = *(const float4*)(xr + j * 256 + lane * 4);
        float ss = 0;
#pragma unroll
        for (int j = 0; j < 4; ++j) ss += xv[j].x * xv[j].x + xv[j].y * xv[j].y + xv[j].z * xv[j].z + xv[j].w * xv[j].w;
        ss = wsum(ss, lane);
        const float rstd = rsqrtf(ss * (1.f / 1024.f) + EPS);
        const float* md = mod + (size_t)(l * 5 + v) * 6144;
        float part[16];
#pragma unroll
        for (int e = 0; e < 16; ++e) part[e] = 0.f;
#pragma unroll
        for (int j = 0; j < 4; ++j) {
            int col = j * 256 + lane * 4;
            float4 g = *(const float4*)(p.g2 + l * 1024 + col), sh = *(const float4*)(md + 3072 + col), sc = *(const float4*)(md + 4096 + col);
            float hv[4];
            hv[0] = xv[j].x * rstd * g.x * (1.f + sc.x) + sh.x; hv[1] = xv[j].y * rstd * g.y * (1.f + sc.y) + sh.y;
            hv[2] = xv[j].z * rstd * g.z * (1.f + sc.z) + sh.z; hv[3] = xv[j].w * rstd * g.w * (1.f + sc.w) + sh.w;
            uint2 o; o.x = pack2(hv[0], hv[1]); o.y = pack2(hv[2], hv[3]);
            *(uint2*)(H + (size_t)r * D + col) = o;
#pragma unroll
            for (int e = 0; e < 16; ++e) {
                const float4 w4 = *(const float4*)(wrT + e * 1024 + col);
                part[e] += hv[0] * w4.x + hv[1] * w4.y + hv[2] * w4.z + hv[3] * w4.w;
            }
        }
#pragma unroll
        for (int e = 0; e < 16; ++e) part[e] = wsum(part[e], lane);
        if (lane == 0) {
            float s[16], bb[16];
#pragma unroll
            for (int e = 0; e < 16; ++e) { s[e] = sigmoidf_(part[e]); bb[e] = s[e] + p.b_router[e]; }
            float bestscore = -1e30f; int be0 = 0, be1 = 1; float bs0 = 0.f, bs1 = 0.f;
#pragma unroll
            for (int g = 0; g < 4; ++g) {
                int i1 = 0; float m1 = bb[g * 4]; float s1 = s[g * 4];
#pragma unroll
                for (int i = 1; i < 4; ++i) if (bb[g * 4 + i] > m1) { m1 = bb[g * 4 + i]; i1 = i; s1 = s[g * 4 + i]; }
                int i2 = -1; float m2 = -1e30f; float s2 = 0.f;
#pragma unroll
                for (int i = 0; i < 4; ++i) if (i != i1 && bb[g * 4 + i] > m2) { m2 = bb[g * 4 + i]; i2 = i; s2 = s[g * 4 + i]; }
                float gs = m1 + m2;
                if (gs > bestscore) { bestscore = gs; be0 = g * 4 + i1; be1 = g * 4 + i2; bs0 = s1; bs1 = s2; }
            }
            float inv = 1.f / (bs0 + bs1);
            const int p0 = atomicAdd(&lcnt[be0], 1), p1 = atomicAdd(&lcnt[be1], 1);
            int* ri = rinfo + (kiter * 8 + wave) * 4;
            ri[0] = be0 | (be1 << 8); ri[1] = p0 | (p1 << 16); ri[2] = __float_as_int(bs0 * inv); ri[3] = __float_as_int(bs1 * inv);
        }
    }
    __syncthreads();
    if (tid < 16) lcnt[16 + tid] = atomicAdd(&cnt[tid], lcnt[tid]);
    __syncthreads();
    {
        const int nent = kiter_max(nrows, gridDim.x) * 16;
        for (int en = tid; en < nent; en += NT) {
            const int s2 = en & 1, w = (en >> 1) & 7, k = en >> 4;
            const int r = blockIdx.x * 8 + w + k * gridDim.x * 8;
            if (r < nrows) {
                const int* ri = rinfo + (k * 8 + w) * 4;
                const int e = (ri[0] >> (8 * s2)) & 255, pos = (ri[1] >> (16 * s2)) & 65535;
                const int gp = lcnt[16 + e] + pos;
                lts[(size_t)e * TALL + gp] = r * 2 + s2; lw[(size_t)e * TALL + gp] = __int_as_float(ri[2 + s2]);
            }
        }
    }
    __syncthreads();
}

__device__ __forceinline__ void phase_final(const Params& p) {
    const int tid = otid(), wave = tid >> 6, lane = tid & 63;
    const float* mod = (const float*)(p.ws + OFF_MOD);
    const int stride = gridDim.x * 8;
    int r = blockIdx.x * 8 + wave;
    RowIn cur, nxt;
    if (r < TLAT) norm1_load(p, 2, r, lane, cur);
    while (r < TLAT) {
        const int rn = r + stride;
        if (rn < TLAT) norm1_load(p, 2, rn, lane, nxt);
        const int v = r / SEQ;
        float* xr = p.out + (size_t)r * D;
        const float* gt2 = mod + (size_t)(1 * 5 + v) * 6144 + 5 * 1024;
        float4 xv[4];
#pragma unroll
        for (int j = 0; j < 4; ++j) {
            const int col = j * 256 + lane * 4;
            float4 a = cur.x[j]; const float4 g = *(const float4*)(gt2 + col);
            const uint2 y0 = cur.y0[j], y1 = cur.y1[j];
            a.x += g.x * (lo2f(y0.x) + lo2f(y1.x)); a.y += g.y * (hi2f(y0.x) + hi2f(y1.x));
            a.z += g.z * (lo2f(y0.y) + lo2f(y1.y)); a.w += g.w * (hi2f(y0.y) + hi2f(y1.y));
            xv[j] = a;
        }
        float ss = 0;
#pragma unroll
        for (int j = 0; j < 4; ++j) ss += xv[j].x * xv[j].x + xv[j].y * xv[j].y + xv[j].z * xv[j].z + xv[j].w * xv[j].w;
        ss = wsum(ss, lane);
        const float rstd = rsqrtf(ss * (1.f / 1024.f) + EPS);
#pragma unroll
        for (int j = 0; j < 4; ++j) {
            const int col = j * 256 + lane * 4;
            const float4 g = *(const float4*)(p.g_final + col);
            float4 o; o.x = xv[j].x * rstd * g.x; o.y = xv[j].y * rstd * g.y; o.z = xv[j].z * rstd * g.z; o.w = xv[j].w * rstd * g.w;
            *(float4*)(xr + col) = o;
        }
        cur = nxt; r = rn;
    }
}

constexpr int LDS_ROW = 144;
constexpr int A_STAGE = 256 * LDS_ROW;
constexpr int B_STAGE = 128 * LDS_ROW;
constexpr int STAGE = A_STAGE + B_STAGE;
constexpr int GEMM_LDS = 2 * STAGE;
constexpr int CT_LD = 132;

template <int MI>
__device__ __forceinline__ void zero_acc(f32x16 (&acc)[MI][2]) {
#pragma unroll
    for (int a = 0; a < MI; ++a)
#pragma unroll
        for (int b = 0; b < 2; ++b)
#pragma unroll
            for (int r = 0; r < 16; ++r) acc[a][b][r] = 0.f;
}

__device__ __forceinline__ uint4 scale8(uint4 u, float sc) {
    uint4 o;
    o.x = pack2(lo2f(u.x) * sc, hi2f(u.x) * sc); o.y = pack2(lo2f(u.y) * sc, hi2f(u.y) * sc);
    o.z = pack2(lo2f(u.z) * sc, hi2f(u.z) * sc); o.w = pack2(lo2f(u.w) * sc, hi2f(u.w) * sc);
    return o;
}
template <int MI, bool BS = false>
__device__ __forceinline__ void gemm_mainloop(f32x16 (&acc)[MI][2], const bf16* ap0, const bf16* ap1, const bf16* ap2, const bf16* ap3,
                                              const bf16* bp0, const bf16* bp1, int K, char* smem, float bs0 = 1.f, float bs1 = 1.f) {
    const int tid = otid(), lane = tid & 63, wave = tid >> 6, wm = wave >> 1, wn = wave & 1;
    const int kc = tid & 7, lr = tid >> 3;
    uint4 ra0, ra1, ra2, ra3, rb0, rb1;
    ra0 = *(const uint4*)(ap0 + kc * 8); ra1 = *(const uint4*)(ap1 + kc * 8);
    if (MI == 2) { ra2 = *(const uint4*)(ap2 + kc * 8); ra3 = *(const uint4*)(ap3 + kc * 8); }
    rb0 = *(const uint4*)(bp0 + kc * 8); rb1 = *(const uint4*)(bp1 + kc * 8);
    if (BS) { rb0 = scale8(rb0, bs0); rb1 = scale8(rb1, bs1); }
    {
        char* st = smem;
        *(uint4*)(st + (lr) * LDS_ROW + kc * 16) = ra0; *(uint4*)(st + (lr + 64) * LDS_ROW + kc * 16) = ra1;
        if (MI == 2) { *(uint4*)(st + (lr + 128) * LDS_ROW + kc * 16) = ra2; *(uint4*)(st + (lr + 192) * LDS_ROW + kc * 16) = ra3; }
        *(uint4*)(st + A_STAGE + (lr) * LDS_ROW + kc * 16) = rb0; *(uint4*)(st + A_STAGE + (lr + 64) * LDS_ROW + kc * 16) = rb1;
    }
    __syncthreads();
    const int nk = K >> 6;
    const int aoff = (wm * (32 * MI) + (lane & 31)) * LDS_ROW + (lane >> 5) * 16;
    const int boff = A_STAGE + (wn * 64 + (lane & 31)) * LDS_ROW + (lane >> 5) * 16;
    for (int kt = 0; kt < nk; ++kt) {
        char* cur = smem + (kt & 1) * STAGE;
        const bool more = (kt + 1 < nk);
        if (more) {
            const int ko = (kt + 1) * 64 + kc * 8;
            ra0 = *(const uint4*)(ap0 + ko); ra1 = *(const uint4*)(ap1 + ko);
            if (MI == 2) { ra2 = *(const uint4*)(ap2 + ko); ra3 = *(const uint4*)(ap3 + ko); }
            rb0 = *(const uint4*)(bp0 + ko); rb1 = *(const uint4*)(bp1 + ko);
        }
#pragma unroll
        for (int ks = 0; ks < 4; ++ks) {
            bf16x8 b0 = *(const bf16x8*)(cur + boff + ks * 32);
            bf16x8 b1 = *(const bf16x8*)(cur + boff + 32 * LDS_ROW + ks * 32);
#pragma unroll
            for (int mi = 0; mi < MI; ++mi) {
                bf16x8 a0 = *(const bf16x8*)(cur + aoff + mi * 32 * LDS_ROW + ks * 32);
                acc[mi][0] = __builtin_amdgcn_mfma_f32_32x32x16_bf16(a0, b0, acc[mi][0], 0, 0, 0);
                acc[mi][1] = __builtin_amdgcn_mfma_f32_32x32x16_bf16(a0, b1, acc[mi][1], 0, 0, 0);
            }
        }
        if (more) {
            if (BS) { rb0 = scale8(rb0, bs0); rb1 = scale8(rb1, bs1); }
            char* st = smem + ((kt + 1) & 1) * STAGE;
            *(uint4*)(st + (lr) * LDS_ROW + kc * 16) = ra0; *(uint4*)(st + (lr + 64) * LDS_ROW + kc * 16) = ra1;
            if (MI == 2) { *(uint4*)(st + (lr + 128) * LDS_ROW + kc * 16) = ra2; *(uint4*)(st + (lr + 192) * LDS_ROW + kc * 16) = ra3; }
            *(uint4*)(st + A_STAGE + (lr) * LDS_ROW + kc * 16) = rb0; *(uint4*)(st + A_STAGE + (lr + 64) * LDS_ROW + kc * 16) = rb1;
        }
        __syncthreads();
    }
}

__device__ __forceinline__ void stage_full(const f32x16 (&acc)[1][2], char* smem) {
    const int tid = otid(), lane = tid & 63, wave = tid >> 6, wm = wave >> 1, wn = wave & 1;
    float* Ct = (float*)smem;
#pragma unroll
    for (int ni = 0; ni < 2; ++ni)
#pragma unroll
        for (int r = 0; r < 16; ++r) {
            int row = wm * 32 + (r & 3) + 8 * (r >> 2) + 4 * (lane >> 5);
            int col = wn * 64 + ni * 32 + (lane & 31);
            Ct[row * CT_LD + col] = acc[0][ni][r];
        }
}

__device__ __forceinline__ void stage_half(const f32x16 (&acc)[2][2], int h, char* smem) {
    const int tid = otid(), lane = tid & 63, wave = tid >> 6, wm = wave >> 1, wn = wave & 1;
    float* Ct = (float*)smem;
    if ((wm >> 1) == h) {
#pragma unroll
        for (int mi = 0; mi < 2; ++mi)
#pragma unroll
            for (int ni = 0; ni < 2; ++ni)
#pragma unroll
                for (int r = 0; r < 16; ++r) {
                    int row = (wm & 1) * 64 + mi * 32 + (r & 3) + 8 * (r >> 2) + 4 * (lane >> 5);
                    int col = wn * 64 + ni * 32 + (lane & 31);
                    Ct[row * CT_LD + col] = acc[mi][ni][r];
                }
    }
}

__device__ __forceinline__ void store32_bf16(bf16* dst, const float (&v)[32]) {
#pragma unroll
    for (int i = 0; i < 4; ++i) {
        uint4 o; o.x = pack2(v[i * 8 + 0], v[i * 8 + 1]); o.y = pack2(v[i * 8 + 2], v[i * 8 + 3]);
        o.z = pack2(v[i * 8 + 4], v[i * 8 + 5]); o.w = pack2(v[i * 8 + 6], v[i * 8 + 7]);
        *(uint4*)(dst + i * 8) = o;
    }
}

__device__ __forceinline__ void epi_plain_bf16(const float* Ct, bf16* dst, int ld, int mrow0, int n0) {
    const int tid = otid(), r = tid >> 2, q = tid & 3;
    float v[32];
    const float* src = Ct + r * CT_LD + 32 * q;
#pragma unroll
    for (int j = 0; j < 32; ++j) v[j] = src[j];
    store32_bf16(dst + (size_t)(mrow0 + r) * ld + n0 + 32 * q, v);
}

__device__ __forceinline__ void epi_outproj(const Params& p, int l, const float* Ct, int mrow0, int n0) {
    const int tid = otid(), r = tid >> 2, q = tid & 3;
    const int row = mrow0 + r;
    const bool isctx = row >= TLAT; const int v = isctx ? 4 : row / SEQ;
    const float* gt = (const float*)(p.ws + OFF_MOD) + (size_t)(l * 5 + v) * 6144 + 2048 + n0 + 32 * q;
    float* CX = (float*)(p.ws + OFF_CX);
    const float* xin; float* xo;
    if (isctx) { xo = CX + (size_t)(row - TLAT) * D + n0 + 32 * q; xin = (l == 0) ? p.ctx + (size_t)(row - TLAT) * D + n0 + 32 * q : xo; }
    else { xo = p.out + (size_t)row * D + n0 + 32 * q; xin = (l == 0) ? p.x + (size_t)row * D + n0 + 32 * q : xo; }
    const float* src = Ct + r * CT_LD + 32 * q;
#pragma unroll
    for (int i = 0; i < 8; ++i) {
        float4 a = *(const float4*)(xin + i * 4); float4 g = *(const float4*)(gt + i * 4);
        a.x += g.x * src[i * 4 + 0]; a.y += g.y * src[i * 4 + 1]; a.z += g.z * src[i * 4 + 2]; a.w += g.w * src[i * 4 + 3];
        *(float4*)(xo + i * 4) = a;
    }
}

__device__ __forceinline__ float log_sigmoid_(float x) { return -log1pf(expf(-x)); }

namespace pg8 {
#define PG8_LAS __attribute__((address_space(3)))
typedef float f32x4 __attribute__((ext_vector_type(4)));
typedef unsigned u32x4 __attribute__((ext_vector_type(4)));
constexpr int BM = 256, BK = 64, HALF = 128, HTB = HALF * BK * 2, STAGE_BYTES = 8 * HTB, NXCD = 8, WGM = 8;
__device__ __forceinline__ int lds_byte(int r, int c) { const int st = (r >> 4) * 2 + (c >> 5), rr = r & 15, cc = c & 31, ob = rr * 64 + cc * 2; return st * 1024 + (ob ^ (((ob >> 9) & 1) << 5)); }
__device__ __forceinline__ void stage_rc(int b, int& R, int& C) { const int st = b / 1024, sb = b % 1024, swz = sb ^ (((sb >> 9) & 1) << 5); R = (st >> 1) * 16 + swz / 64; C = (st & 1) * 32 + (swz % 64) / 2; }
__device__ __forceinline__ int perm32(int rho) { const int n = rho >> 4, i = rho & 15; return 8 * (i >> 2) + 4 * n + (i & 3); }
__device__ __forceinline__ unsigned cvt_pk_bf16(float lo, float hi) { return pack2(lo, hi); }

struct Unit { const char* A; const char* B; int pm, pn, tag, x0, x1; };

__device__ __forceinline__ bool static_unit(int i, int G, int c, int nM, int nN, int& pm, int& pn) {
    const int nwg = nM * nN; const long L = (long)i * G + c; if (L >= nwg) return false;
    int wgid = (int)L; { const int q = nwg / NXCD, r = nwg % NXCD, xcd = wgid % NXCD, off = wgid / NXCD; wgid = (xcd < r ? xcd * (q + 1) : r * (q + 1) + (xcd - r) * q) + off; }
    const int nig = WGM * nN, gid = wgid / nig, fm = gid * WGM, gsz = (nM - fm) < WGM ? (nM - fm) : WGM;
    pm = fm + ((wgid % nig) % gsz); pn = (wgid % nig) / gsz; return true;
}

template <class Sched, class Epi>
__device__ __forceinline__ void gemm_stream(PG8_LAS unsigned char* lds, const int K, const Sched& S, const Epi& E) {
    const int tid = otid(), wid = __builtin_amdgcn_readfirstlane(tid >> 6), lane = tid & 63, wr = wid >> 2, wc = wid & 3, fr = lane & 15, fq = lane >> 4;
    const int nt = K / BK;
    int sR[2], sC[2];
    constexpr int NH = Sched::GATHER ? 2 : 1;
    unsigned voffA[NH][2], voffB[1][2], voffAn[NH][2];
#pragma unroll
    for (int i = 0; i < 2; ++i) { int R, C; stage_rc(tid * 16 + i * 8192, R, C); sR[i] = R; sC[i] = C; const int Rb = (R & ~31) + perm32(R & 31);
        voffB[0][i] = (unsigned)(Rb * K + C) * 2u;
#pragma unroll
        for (int h = 0; h < NH; ++h) { voffA[h][i] = (unsigned)((h * HALF + R) * K + C) * 2u; voffAn[h][i] = voffA[h][i]; } }
    const size_t kstep = (size_t)(BK * 2);
    const size_t hstepA = Sched::GATHER ? 0 : (size_t)HALF * K * 2, hstepB = (size_t)HALF * K * 2;
    const unsigned ldsw = (unsigned)wid * 1024u;
    const int aoff = lds_byte(wr * 64 + fr, fq * 8), boff = lds_byte(wc * 32 + fr, fq * 8);
#define PG8_SA(b, h) (((b) * 2 + (h)) * HTB)
#define PG8_SB(b, h) ((4 + (b) * 2 + (h)) * HTB)
#define PG8_STAGE(bufoff, gbase, voff) do { _Pragma("unroll") for (int _i = 0; _i < 2; ++_i) \
        __builtin_amdgcn_global_load_lds((const unsigned*)((const char*)(gbase) + (voff)[_i]), (PG8_LAS unsigned*)(lds + (bufoff) + ldsw + _i * 8192), 16, 0, 0); } while (0)
#define PG8_LDA(dst, b, h) do { _Pragma("unroll") for (int m = 0; m < 4; ++m) _Pragma("unroll") for (int k = 0; k < 2; ++k) dst[m][k] = *(const PG8_LAS bf16x8*)(lds + PG8_SA(b, h) + aoff + m * 2048 + k * 1024); } while (0)
#define PG8_LDB(dst, b, h) do { _Pragma("unroll") for (int n = 0; n < 2; ++n) _Pragma("unroll") for (int k = 0; k < 2; ++k) dst[n][k] = *(const PG8_LAS bf16x8*)(lds + PG8_SB(b, h) + boff + n * 2048 + k * 1024); } while (0)
#define PG8_MMA(ai, bj, At, Bt) do { __builtin_amdgcn_s_setprio(1); _Pragma("unroll") for (int m = 0; m < 4; ++m) _Pragma("unroll") for (int n = 0; n < 2; ++n) _Pragma("unroll") for (int k = 0; k < 2; ++k) \
        acc[ai][bj][m][n] = __builtin_amdgcn_mfma_f32_16x16x32_bf16(Bt[n][k], At[m][k], acc[ai][bj][m][n], 0, 0, 0); __builtin_amdgcn_s_setprio(0); } while (0)
#define PG8_WAIT_V(n) asm volatile("s_waitcnt vmcnt(" #n ")" ::: "memory")
#define PG8_WAIT_L(n) asm volatile("s_waitcnt lgkmcnt(" #n ")" ::: "memory")
#define PG8_BAR __builtin_amdgcn_s_barrier()
#define PG8_SCHED __builtin_amdgcn_sched_barrier(0)
#define PG8_GOFF(u, dst) do { if constexpr (Sched::GATHER) { _Pragma("unroll") for (int _h = 0; _h < 2; ++_h) _Pragma("unroll") for (int _i = 0; _i < 2; ++_i) \
        dst[_h][_i] = S.row_off(u, _h * HALF + sR[_i]) + (unsigned)sC[_i] * 2u; } } while (0)
    Unit cur, nxt; int ui = 0;
    if (!S.next(0, cur)) return;
    f32x4 acc[2][2][4][2];
#pragma unroll
    for (int a = 0; a < 2; ++a)
#pragma unroll
        for (int b = 0; b < 2; ++b)
#pragma unroll
            for (int m = 0; m < 4; ++m)
#pragma unroll
                for (int n = 0; n < 2; ++n) acc[a][b][m][n] = (f32x4){0.f, 0.f, 0.f, 0.f};
    bf16x8 At[4][2], B0[2][2], B1[2][2];
    const char* cA = cur.A; const char* cB = cur.B;
    PG8_GOFF(cur, voffA);
    PG8_STAGE(PG8_SB(0, 0), cB, voffB[0]); PG8_STAGE(PG8_SA(0, 0), cA, voffA[0]); PG8_STAGE(PG8_SB(0, 1), cB + hstepB, voffB[0]); PG8_STAGE(PG8_SA(0, 1), cA + hstepA, voffA[NH - 1]);
    if (wr == 1) PG8_BAR;
    PG8_WAIT_V(4); PG8_BAR;
    PG8_STAGE(PG8_SB(1, 0), cB + kstep, voffB[0]); PG8_STAGE(PG8_SA(1, 0), cA + kstep, voffA[0]); PG8_STAGE(PG8_SB(1, 1), cB + kstep + hstepB, voffB[0]);
    PG8_WAIT_V(6); PG8_BAR;
    for (;;) {
        const bool has_next = S.next(ui + 1, nxt);
        const char* nA = has_next ? nxt.A : cA; const char* nB = has_next ? nxt.B : cB;
        if constexpr (Sched::GATHER) { if (has_next) { PG8_GOFF(nxt, voffAn); } else {
#pragma unroll
            for (int _h = 0; _h < NH; ++_h)
#pragma unroll
                for (int _i = 0; _i < 2; ++_i) voffAn[_h][_i] = voffA[_h][_i]; } }
        for (int t = 0; t < nt; t += 2) {
            const bool last = (t == nt - 2);
            const char* a1 = cA + (size_t)(t + 1) * kstep;
            const char* a2 = last ? nA : cA + (size_t)(t + 2) * kstep; const char* b2 = last ? nB : cB + (size_t)(t + 2) * kstep;
            const char* a3 = a2 + kstep; const char* b3 = b2 + kstep;
            unsigned vA2[NH][2];
#pragma unroll
            for (int _h = 0; _h < NH; ++_h)
#pragma unroll
                for (int _i = 0; _i < 2; ++_i) vA2[_h][_i] = (Sched::GATHER && last) ? voffAn[_h][_i] : voffA[_h][_i];
            PG8_LDB(B0, 0, 0); PG8_SCHED; PG8_LDA(At, 0, 0); PG8_STAGE(PG8_SA(1, 1), a1 + hstepA, voffA[NH - 1]);
            PG8_WAIT_L(8); PG8_BAR; PG8_WAIT_L(0); PG8_MMA(0, 0, At, B0); PG8_BAR; PG8_SCHED;
            PG8_LDB(B1, 0, 1); PG8_STAGE(PG8_SB(0, 0), b2, voffB[0]);
            PG8_BAR; PG8_WAIT_L(0); PG8_MMA(0, 1, At, B1); PG8_BAR;
            PG8_LDA(At, 0, 1); PG8_STAGE(PG8_SA(0, 0), a2, vA2[0]);
            PG8_BAR; PG8_WAIT_L(0); PG8_MMA(1, 0, At, B0); PG8_BAR; PG8_SCHED;
            PG8_STAGE(PG8_SB(0, 1), b2 + hstepB, voffB[0]);
            PG8_WAIT_V(6); PG8_BAR; PG8_MMA(1, 1, At, B1); PG8_BAR;
            PG8_LDB(B0, 1, 0); PG8_SCHED; PG8_LDA(At, 1, 0); PG8_STAGE(PG8_SA(0, 1), a2 + hstepA, vA2[NH - 1]);
            PG8_WAIT_L(8); PG8_BAR; PG8_WAIT_L(0); PG8_MMA(0, 0, At, B0); PG8_BAR; PG8_SCHED;
            PG8_LDB(B1, 1, 1); PG8_STAGE(PG8_SB(1, 0), b3, voffB[0]);
            PG8_BAR; PG8_WAIT_L(0); PG8_MMA(0, 1, At, B1); PG8_BAR;
            PG8_LDA(At, 1, 1); PG8_STAGE(PG8_SA(1, 0), a3, vA2[0]);
            PG8_BAR; PG8_WAIT_L(0); PG8_MMA(1, 0, At, B0); PG8_BAR; PG8_SCHED;
            PG8_STAGE(PG8_SB(1, 1), b3 + hstepB, voffB[0]);
            PG8_WAIT_V(6); PG8_BAR; PG8_MMA(1, 1, At, B1); PG8_BAR;
        }
        E(acc, cur, wr, wc, fr, fq);
        if (!has_next) break;
#pragma unroll
        for (int a = 0; a < 2; ++a)
#pragma unroll
            for (int b = 0; b < 2; ++b)
#pragma unroll
                for (int m = 0; m < 4; ++m)
#pragma unroll
                    for (int n = 0; n < 2; ++n) acc[a][b][m][n] = (f32x4){0.f, 0.f, 0.f, 0.f};
        cur = nxt; cA = nA; cB = nB; ++ui;
        if constexpr (Sched::GATHER) {
#pragma unroll
            for (int _h = 0; _h < NH; ++_h)
#pragma unroll
                for (int _i = 0; _i < 2; ++_i) voffA[_h][_i] = voffAn[_h][_i]; }
    }
    PG8_WAIT_V(0);
    if (wr == 0) PG8_BAR;
    PG8_BAR;
#undef PG8_SA
#undef PG8_SB
#undef PG8_STAGE
#undef PG8_LDA
#undef PG8_LDB
#undef PG8_MMA
#undef PG8_WAIT_V
#undef PG8_WAIT_L
#undef PG8_BAR
#undef PG8_SCHED
#undef PG8_GOFF
}
}

struct InprojSched {
    static constexpr bool GATHER = false;
    const char* H; const char* W; int G, c;
    __device__ __forceinline__ bool next(int i, pg8::Unit& u) const {
        int pm, pn;
        if (!pg8::static_unit(i, G, c, TALL / 256, 26, pm, pn)) return false;
        u.pm = pm; u.pn = pn; u.tag = 0;
        const char* hp = H + (size_t)pm * 256 * 2048; const char* wp = W + (size_t)pn * 256 * 2048;
        if (pn < 19) { u.A = hp; u.B = wp; } else { u.A = wp; u.B = hp; }
        return true;
    }
};

struct InprojEpi {
    unsigned char* ws_; const float* gq_; const float* gk_; float* red_;
    typedef pg8::f32x4 f32x4;

    __device__ __forceinline__ static void st8(bf16* d, const float (&o)[8]) {
        pg8::u32x4 w; w.x = pg8::cvt_pk_bf16(o[0], o[1]); w.y = pg8::cvt_pk_bf16(o[2], o[3]); w.z = pg8::cvt_pk_bf16(o[4], o[5]); w.w = pg8::cvt_pk_bf16(o[6], o[7]);
        *(pg8::u32x4*)d = w;
    }
    template <bool NORM>
    __device__ __forceinline__ void rope128(unsigned char* ws, float* red, const f32x4 (&acc)[2][2][4][2], bf16* dst, int ld, int colbase, float scale, const float* gain,
                                            int pm, int wr, int wc, int fr, int fq) const {
        const bool isctx = pm >= 64;
        const int a = wc & 1, i0 = 8 * fq;
        const float* rp = (const float*)(ws + OFF_ROPE);
        bf16* d0 = dst + colbase + (wc >> 1) * 128 + 64 * a + i0;
        float g1[8], g2[8];
        if (NORM) {
#pragma unroll
            for (int j = 0; j < 8; ++j) { g1[j] = gain[64 * a + i0 + j] * scale; g2[j] = gain[64 * a + 32 + i0 + j] * scale; }
#pragma unroll
            for (int ai = 0; ai < 2; ++ai)
#pragma unroll
                for (int m = 0; m < 4; ++m) {
                    float ss = 0.f;
#pragma unroll
                    for (int bj = 0; bj < 2; ++bj)
#pragma unroll
                        for (int n = 0; n < 2; ++n)
#pragma unroll
                            for (int j = 0; j < 4; ++j) ss += acc[ai][bj][m][n][j] * acc[ai][bj][m][n][j];
                    { const int ln = fr + 16 * fq; ss += shx(ss, 16, ln); ss += shx(ss, 32, ln); }
                    if (fq == 0) red[(128 * ai + 64 * wr + 16 * m + fr) * 4 + wc] = ss;
                }
            asm volatile("s_waitcnt lgkmcnt(0)" ::: "memory");
            __builtin_amdgcn_s_barrier();
        }
        constexpr int RB = 1;
#pragma unroll
        for (int aim = 0; aim < 8 / RB; ++aim) {
            const int ai = aim / (4 / RB), mh = aim % (4 / RB);
            float4 tc[4][2], tsn[4][2];
            {
#pragma unroll
                for (int m = RB * mh; m < RB * mh + RB; ++m) {
                    const int t = (256 * pm + 128 * ai + 64 * wr + 16 * m + fr) & (SEQ - 1); const int pos = a ? (t & 63) : (t >> 6);
                    tc[m][0] = *(const float4*)(rp + pos * 32 + i0); tc[m][1] = *(const float4*)(rp + pos * 32 + i0 + 4);
                    tsn[m][0] = *(const float4*)(rp + 2048 + pos * 32 + i0); tsn[m][1] = *(const float4*)(rp + 2048 + pos * 32 + i0 + 4);
                }
            }
#pragma unroll
            for (int m = RB * mh; m < RB * mh + RB; ++m) {
                const int rl = 128 * ai + 64 * wr + 16 * m + fr;
                const int row = 256 * pm + rl;
                float x1[8], x2[8];
#pragma unroll
                for (int n = 0; n < 2; ++n)
#pragma unroll
                    for (int j = 0; j < 4; ++j) { x1[n * 4 + j] = acc[ai][0][m][n][j]; x2[n * 4 + j] = acc[ai][1][m][n][j]; }
                if (NORM) {
                    const float rstd = rsqrtf((red[rl * 4 + wc] + red[rl * 4 + (wc ^ 1)]) * (1.f / 128.f) + EPS);
#pragma unroll
                    for (int j = 0; j < 8; ++j) { x1[j] *= rstd * g1[j]; x2[j] *= rstd * g2[j]; }
                } else {
#pragma unroll
                    for (int j = 0; j < 8; ++j) { x1[j] *= scale; x2[j] *= scale; }
                }
                float o1[8], o2[8];
                if (!isctx) {
                    const float4 c0 = tc[m][0], c1 = tc[m][1], s0 = tsn[m][0], s1 = tsn[m][1];
                    const float cs[8] = {c0.x, c0.y, c0.z, c0.w, c1.x, c1.y, c1.z, c1.w}, sn[8] = {s0.x, s0.y, s0.z, s0.w, s1.x, s1.y, s1.z, s1.w};
#pragma unroll
                    for (int j = 0; j < 8; ++j) { o1[j] = x1[j] * cs[j] - x2[j] * sn[j]; o2[j] = x1[j] * sn[j] + x2[j] * cs[j]; }
                } else {
#pragma unroll
                    for (int j = 0; j < 8; ++j) { o1[j] = x1[j]; o2[j] = x2[j]; }
                }
                st8(d0 + (size_t)row * ld, o1); st8(d0 + (size_t)row * ld + 32, o2);
            }
            __builtin_amdgcn_sched_barrier(0);
        }
    }
    __device__ __forceinline__ void rope64(unsigned char* ws, const f32x4 (&acc)[2][2][4][2], bf16* dst, int ld, int colbase, float scale, int nheads,
                                           int pm, int wr, int wc, int fr, int fq) const {
        if (wc >= nheads) return;
        const bool isctx = pm >= 64;
        const int a = fq >> 1, i0 = 8 * (fq & 1);
        const float* rp = (const float*)(ws + OFF_ROPE) + 4096;
        bf16* d0 = dst + colbase + 64 * wc + 32 * a + i0;
#pragma unroll
        for (int aim = 0; aim < 4; ++aim) {
            const int ai = aim >> 1, mh = aim & 1;
            float4 tc[4][2], tsn[4][2];
            {
#pragma unroll
                for (int m = 2 * mh; m < 2 * mh + 2; ++m) {
                    const int t = (256 * pm + 128 * ai + 64 * wr + 16 * m + fr) & (SEQ - 1); const int pos = a ? (t & 63) : (t >> 6);
                    tc[m][0] = *(const float4*)(rp + pos * 16 + i0); tc[m][1] = *(const float4*)(rp + pos * 16 + i0 + 4);
                    tsn[m][0] = *(const float4*)(rp + 1024 + pos * 16 + i0); tsn[m][1] = *(const float4*)(rp + 1024 + pos * 16 + i0 + 4);
                }
            }
#pragma unroll
            for (int m = 2 * mh; m < 2 * mh + 2; ++m) {
                const int row = 256 * pm + 128 * ai + 64 * wr + 16 * m + fr;
                float x1[8], x2[8], o1[8], o2[8];
#pragma unroll
                for (int n = 0; n < 2; ++n)
#pragma unroll
                    for (int j = 0; j < 4; ++j) { x1[n * 4 + j] = acc[ai][0][m][n][j] * scale; x2[n * 4 + j] = acc[ai][1][m][n][j] * scale; }
                if (!isctx) {
                    const float4 c0 = tc[m][0], c1 = tc[m][1], s0 = tsn[m][0], s1 = tsn[m][1];
                    const float cs[8] = {c0.x, c0.y, c0.z, c0.w, c1.x, c1.y, c1.z, c1.w}, sn[8] = {s0.x, s0.y, s0.z, s0.w, s1.x, s1.y, s1.z, s1.w};
#pragma unroll
                    for (int j = 0; j < 8; ++j) { o1[j] = x1[j] * cs[j] - x2[j] * sn[j]; o2[j] = x1[j] * sn[j] + x2[j] * cs[j]; }
                } else {
#pragma unroll
                    for (int j = 0; j < 8; ++j) { o1[j] = x1[j]; o2[j] = x2[j]; }
                }
                st8(d0 + (size_t)row * ld, o1); st8(d0 + (size_t)row * ld + 16, o2);
            }
            __builtin_amdgcn_sched_barrier(0);
        }
    }
    __device__ __forceinline__ void plain(const f32x4 (&acc)[2][2][4][2], bf16* dst, int ld, int colbase, int pm, int wr, int wc, int fr, int fq) const {
#pragma unroll
        for (int ai = 0; ai < 2; ++ai)
#pragma unroll
            for (int m = 0; m < 4; ++m) {
                const int row = 256 * pm + 128 * ai + 64 * wr + 16 * m + fr;
#pragma unroll
                for (int bj = 0; bj < 2; ++bj) {
                    float o[8];
#pragma unroll
                    for (int n = 0; n < 2; ++n)
#pragma unroll
                        for (int j = 0; j < 4; ++j) o[n * 4 + j] = acc[ai][bj][m][n][j];
                    st8(dst + (size_t)row * ld + colbase + 128 * bj + 32 * wc + 8 * fq, o);
                }
            }
    }
    __device__ __forceinline__ void swapped(unsigned char* ws, const f32x4 (&acc)[2][2][4][2], int sidx, int l, int pm, int wr, int wc, int fr, int fq) const {
        const bool isctx = pm >= 64;
        const int b = isctx ? pm - 64 : pm >> 4;
        const int key0 = isctx ? 4096 : (pm & 15) * 256;
        const int tk0 = 32 * wc + 8 * fq;
        if (sidx < 4 || sidx == 6) {
            const int nai = sidx == 6 ? 1 : 2;
            bf16* base = sidx == 6 ? (bf16*)(ws + OFF_VS) + (size_t)(b * 2) * 64 * KEYS : (bf16*)(ws + OFF_VR) + (size_t)(b * 4 + sidx) * 256 * KEYS;
#pragma unroll
            for (int ai = 0; ai < 2; ++ai) {
                if (ai < nai) {
#pragma unroll
                    for (int m = 0; m < 4; ++m) {
                        const int e = 128 * ai + 64 * wr + 16 * m + fr;
#pragma unroll
                        for (int bj = 0; bj < 2; ++bj) {
                            float o[8];
#pragma unroll
                            for (int n = 0; n < 2; ++n)
#pragma unroll
                                for (int j = 0; j < 4; ++j) o[n * 4 + j] = acc[ai][bj][m][n][j];
                            st8(base + (size_t)e * KEYS + key0 + 128 * bj + tk0, o);
                        }
                    }
                }
            }
        } else {
            const int h = 2 * (sidx - 4) + wr;
            const float* rp = (const float*)(ws + OFF_ROPE);
            const float* dec = (const float*)(ws + OFF_DEC) + 64 + (size_t)((l * 4 + h) * 6) * 128;
            float df[8], db[8];
            { const float4 a0 = *(const float4*)(dec + tk0), a1 = *(const float4*)(dec + tk0 + 4), b0 = *(const float4*)(dec + 128 + tk0), b1 = *(const float4*)(dec + 128 + tk0 + 4);
              df[0] = a0.x; df[1] = a0.y; df[2] = a0.z; df[3] = a0.w; df[4] = a1.x; df[5] = a1.y; df[6] = a1.z; df[7] = a1.w;
              db[0] = b0.x; db[1] = b0.y; db[2] = b0.z; db[3] = b0.w; db[4] = b1.x; db[5] = b1.y; db[6] = b1.z; db[7] = b1.w; }
            bf16* kf = (bf16*)(ws + OFF_KFT) + (size_t)(b * 4 + h) * 128 * KEYS;
            bf16* kb = (bf16*)(ws + OFF_KBT) + (size_t)(b * 4 + h) * 128 * KEYS;
#pragma unroll
            for (int m = 0; m < 4; ++m) {
                const int a = m >> 1, i = 16 * (m & 1) + fr;
                const int d1 = 64 * a + i, d2 = d1 + 32;
#pragma unroll
                for (int bj = 0; bj < 2; ++bj) {
                    const int tok0 = key0 + 128 * bj + tk0;
                    float cs[8], sn[8];
                    if (!isctx) {
                        if (a == 0) {
                            const float c = rp[(tok0 >> 6) * 32 + i], sv = rp[2048 + (tok0 >> 6) * 32 + i];
#pragma unroll
                            for (int j = 0; j < 8; ++j) { cs[j] = c; sn[j] = sv; }
                        } else {
                            const float* ct = rp + 6144 + i * 64 + (tok0 & 63); const float* stt = rp + 8192 + i * 64 + (tok0 & 63);
                            const float4 c0 = *(const float4*)ct, c1 = *(const float4*)(ct + 4), s0 = *(const float4*)stt, s1 = *(const float4*)(stt + 4);
                            cs[0] = c0.x; cs[1] = c0.y; cs[2] = c0.z; cs[3] = c0.w; cs[4] = c1.x; cs[5] = c1.y; cs[6] = c1.z; cs[7] = c1.w;
                            sn[0] = s0.x; sn[1] = s0.y; sn[2] = s0.z; sn[3] = s0.w; sn[4] = s1.x; sn[5] = s1.y; sn[6] = s1.z; sn[7] = s1.w;
                        }
                    } else {
#pragma unroll
                        for (int j = 0; j < 8; ++j) { cs[j] = 1.f; sn[j] = 0.f; }
                    }
                    float o1[8], o2[8];
#pragma unroll
                    for (int n = 0; n < 2; ++n)
#pragma unroll
                        for (int j = 0; j < 4; ++j) {
                            const int jj = n * 4 + j;
                            const float x1 = acc[0][bj][m][n][j], x2 = acc[1][bj][m][n][j];
                            o1[jj] = x1 * cs[jj] - x2 * sn[jj]; o2[jj] = x1 * sn[jj] + x2 * cs[jj];
                        }
                    float v[8];
#pragma unroll
                    for (int j = 0; j < 8; ++j) v[j] = o1[j] * df[j];
                    st8(kf + (size_t)d1 * KEYS + tok0, v);
#pragma unroll
                    for (int j = 0; j < 8; ++j) v[j] = o2[j] * df[j];
                    st8(kf + (size_t)d2 * KEYS + tok0, v);
#pragma unroll
                    for (int j = 0; j < 8; ++j) v[j] = o1[j] * db[j];
                    st8(kb + (size_t)d1 * KEYS + tok0, v);
#pragma unroll
                    for (int j = 0; j < 8; ++j) v[j] = o2[j] * db[j];
                    st8(kb + (size_t)d2 * KEYS + tok0, v);
                    __builtin_amdgcn_sched_barrier(0);
                }
            }
        }
    }
    int l;
    __device__ __forceinline__ void operator()(const f32x4 (&acc)[2][2][4][2], const pg8::Unit& u, int wr, int wc, int fr0, int fq0) const {
        unsigned char* ws = ws_; float* red = red_; const float* gq = gq_; const float* gk = gk_;
        asm volatile("" : "+s"(ws), "+s"(gq), "+s"(gk));
        int fr = fr0, fq = fq0; asm volatile("" : "+v"(fr), "+v"(fq));
        const int pn = u.pn, pm = u.pm;
        if (pn < 2)        rope128<false>(ws, red, acc, (bf16*)(ws + OFF_QR), 512, 256 * pn, 1.f, nullptr, pm, wr, wc, fr, fq);
        else if (pn < 4)   rope128<false>(ws, red, acc, (bf16*)(ws + OFF_KR), 512, 256 * (pn - 2), 0.08838834764831845f, nullptr, pm, wr, wc, fr, fq);
        else if (pn < 8)   plain(acc, (bf16*)(ws + OFF_UR), 1024, 256 * (pn - 4), pm, wr, wc, fr, fq);
        else if (pn < 12)  rope64(ws, acc, (bf16*)(ws + OFF_QS), 1024, 256 * (pn - 8), 0.125f, 4, pm, wr, wc, fr, fq);
        else if (pn == 12) rope64(ws, acc, (bf16*)(ws + OFF_KS), 128, 0, 1.f, 2, pm, wr, wc, fr, fq);
        else if (pn < 17)  rope128<true>(ws, red, acc, (bf16*)(ws + OFF_QA), 1024, 256 * (pn - 13), 1.f, gq, pm, wr, wc, fr, fq);
        else if (pn == 17) rope128<true>(ws, red, acc, (bf16*)(ws + OFF_KA), 256, 0, 1.f, gk, pm, wr, wc, fr, fq);
        else if (pn == 18) plain(acc, (bf16*)(ws + OFF_VA), 256, 0, pm, wr, wc, fr, fq);
        else swapped(ws, acc, pn - 19, l, pm, wr, wc, fr, fq);
    }
};

__device__ __forceinline__ void phase_inproj(const Params& p, int l, char* smem) {
    InprojSched S; S.H = (const char*)(p.ws + OFF_H); S.W = (const char*)(p.ws + OFF_WT); S.G = gridDim.x; S.c = blockIdx.x;
    InprojEpi E; E.ws_ = p.ws; E.gq_ = p.gq + l * 128; E.gk_ = p.gk + l * 128; E.red_ = (float*)(smem + pg8::STAGE_BYTES); E.l = l;
    pg8::gemm_stream<InprojSched, InprojEpi>((PG8_LAS unsigned char*)smem, 1024, S, E);
    __syncthreads();
}


struct OutSched {
    static constexpr bool GATHER = false;
    const char* Y; const char* W; int G, c, nM;
    __device__ __forceinline__ bool next(int i, pg8::Unit& u) const {
        int pm, pn;
        if (!pg8::static_unit(i, G, c, nM, 4, pm, pn)) return false;
        u.pm = pm; u.pn = pn; u.tag = 0; u.A = Y + (size_t)pm * 256 * 2048; u.B = W + (size_t)pn * 256 * 2048;
        return true;
    }
};
struct OutEpi {
    unsigned char* ws_; const float* xin_; const float* cin_; float* out_; int l;
    typedef pg8::f32x4 f32x4;
    __device__ __forceinline__ void operator()(const f32x4 (&acc)[2][2][4][2], const pg8::Unit& u, int wr, int wc, int fr0, int fq0) const {
        unsigned char* ws = ws_; const float* xin = xin_; const float* cin = cin_; float* out = out_;
        asm volatile("" : "+s"(ws), "+s"(xin), "+s"(cin), "+s"(out));
        int fr = fr0, fq = fq0; asm volatile("" : "+v"(fr), "+v"(fq));
        const int pm = u.pm, pn = u.pn;
        const bool isctx = pm >= 64;
        const int v = isctx ? 4 : pm >> 4;
        const int col0 = 256 * pn + 32 * wc + 8 * fq;
        const float* gt = (const float*)(ws + OFF_MOD) + (size_t)(l * 5 + v) * 6144 + 2048 + col0;
        float4 g[2][2];
#pragma unroll
        for (int bj = 0; bj < 2; ++bj)
#pragma unroll
            for (int n = 0; n < 2; ++n) g[bj][n] = *(const float4*)(gt + 128 * bj + 4 * n);
        float* CX = (float*)(ws + OFF_CX);
        const int row0 = 256 * pm + 64 * wr + fr;
        const float* xi; float* xo;
        if (isctx) { xo = CX + (size_t)(row0 - TLAT) * D + col0; xi = (l == 0) ? cin + (size_t)(row0 - TLAT) * D + col0 : xo; }
        else { xo = out + (size_t)row0 * D + col0; xi = (l == 0) ? xin + (size_t)row0 * D + col0 : xo; }
#pragma unroll
        for (int ai = 0; ai < 2; ++ai) {
            float4 a[4][2][2];
#pragma unroll
            for (int m = 0; m < 4; ++m)
#pragma unroll
                for (int bj = 0; bj < 2; ++bj)
#pragma unroll
                    for (int n = 0; n < 2; ++n) a[m][bj][n] = *(const float4*)(xi + (size_t)(128 * ai + 16 * m) * D + 128 * bj + 4 * n);
#pragma unroll
            for (int m = 0; m < 4; ++m)
#pragma unroll
                for (int bj = 0; bj < 2; ++bj)
#pragma unroll
                    for (int n = 0; n < 2; ++n) {
                        float4 o; const float4 aa = a[m][bj][n], gg = g[bj][n];
                        o.x = aa.x + gg.x * acc[ai][bj][m][n][0]; o.y = aa.y + gg.y * acc[ai][bj][m][n][1];
                        o.z = aa.z + gg.z * acc[ai][bj][m][n][2]; o.w = aa.w + gg.w * acc[ai][bj][m][n][3];
                        *(float4*)(xo + (size_t)(128 * ai + 16 * m) * D + 128 * bj + 4 * n) = o;
                    }
            __builtin_amdgcn_sched_barrier(0);
        }
    }
};
__device__ __forceinline__ void phase_outproj(const Params& p, int l, char* smem) {
    OutSched S; S.Y = (const char*)(p.ws + OFF_Y); S.W = (const char*)(p.ws + OFF_WT) + (size_t)WR_OUT * 2048; S.G = gridDim.x; S.c = blockIdx.x; S.nM = (l == 0 ? TALL : TLAT) / 256;
    OutEpi E; E.ws_ = p.ws; E.xin_ = p.x; E.cin_ = p.ctx; E.out_ = p.out; E.l = l;
    pg8::gemm_stream<OutSched, OutEpi>((PG8_LAS unsigned char*)smem, 1024, S, E);
    __syncthreads();
    conv_run(p, l, 1, smem, (l == 0) ? 16 : 0);
}

__device__ __forceinline__ size_t gate_region(int br) { return br == 0 ? OFF_VR : (br == 1 ? OFF_KFT : OFF_F); }
struct GateSched {
    static constexpr bool GATHER = false;
    const char* ws; int G, c, nM, nctx;
    __device__ __forceinline__ bool next(int i, pg8::Unit& u) const {
        int pm, pn;
        if (pg8::static_unit(i, G, c, nM, 12, pm, pn)) {
            u.pm = pm; u.pn = pn; u.tag = 0;
            u.A = ws + OFF_H + (size_t)pm * 256 * 2048; u.B = ws + OFF_WT + (size_t)(WR_G + pn * 256) * 2048;
            return true;
        }
        const int q = i * G + c - nM * 12;
        if (q < 0 || q >= nctx) return false;
        const int t = q / 3, br = q - 3 * t, pmc = t >> 2, pn4 = t & 3;
        u.pm = pmc; u.pn = pn4; u.tag = 2 + br;
        u.A = ws + (br == 0 ? OFF_UR : br == 1 ? OFF_QS : OFF_QA) + (size_t)(64 + pmc) * 256 * 2048;
        u.B = ws + OFF_WT + (size_t)(WR_BR + br * 1024 + pn4 * 256) * 2048;
        return true;
    }
};
struct CtxGateSched {
    static constexpr bool GATHER = false;
    const char* ws; int q;
    __device__ __forceinline__ bool next(int i, pg8::Unit& u) const {
        if (i > 0) return false;
        const int pmc = q / 12, pn12 = q - 12 * pmc;
        u.pm = pmc; u.pn = pn12; u.tag = 1;
        u.A = ws + OFF_H + (size_t)(64 + pmc) * 256 * 2048; u.B = ws + OFF_WT + (size_t)(WR_G + pn12 * 256) * 2048;
        return true;
    }
};
struct GateEpi {
    unsigned char* ws_;
    typedef pg8::f32x4 f32x4;
    __device__ __forceinline__ void operator()(const f32x4 (&acc)[2][2][4][2], const pg8::Unit& u, int wr, int wc, int fr0, int fq0) const {
        unsigned char* ws = ws_;
        asm volatile("" : "+s"(ws));
        int fr = fr0, fq = fq0; asm volatile("" : "+v"(fr), "+v"(fq));
        if (u.tag < 2) {
            const int br = u.pn >> 2, pn4 = u.pn & 3;
            bf16* Gp = u.tag == 0 ? (bf16*)(ws + gate_region(br)) : (bf16*)(ws + OFF_GC) + (size_t)br * 1024 * 1024;
#pragma unroll
            for (int ai = 0; ai < 2; ++ai)
#pragma unroll
                for (int m = 0; m < 4; ++m) {
                    const int row = 256 * u.pm + 128 * ai + 64 * wr + 16 * m + fr;
#pragma unroll
                    for (int bj = 0; bj < 2; ++bj) {
                        float o[8];
#pragma unroll
                        for (int n = 0; n < 2; ++n)
#pragma unroll
                            for (int j = 0; j < 4; ++j) o[n * 4 + j] = __builtin_amdgcn_rcpf(1.f + fexp_(-acc[ai][bj][m][n][j]));
                        InprojEpi::st8(Gp + (size_t)row * 1024 + 256 * pn4 + 128 * bj + 32 * wc + 8 * fq, o);
                    }
                    __builtin_amdgcn_sched_barrier(0);
                }
        } else {
            const int br = u.tag - 2;
            const bf16* Gc = (const bf16*)(ws + OFF_GC) + (size_t)br * 1024 * 1024;
            bf16* Pc = (bf16*)(ws + OFF_PC) + (size_t)br * 1024 * 1024;
            const size_t off0 = (size_t)(256 * u.pm + 64 * wr + fr) * 1024 + 256 * u.pn + 32 * wc + 8 * fq;
#pragma unroll
            for (int ai = 0; ai < 2; ++ai) {
                uint4 g[4][2];
#pragma unroll
                for (int m = 0; m < 4; ++m)
#pragma unroll
                    for (int bj = 0; bj < 2; ++bj) g[m][bj] = *(const uint4*)(Gc + off0 + (size_t)(128 * ai + 16 * m) * 1024 + 128 * bj);
#pragma unroll
                for (int m = 0; m < 4; ++m)
#pragma unroll
                    for (int bj = 0; bj < 2; ++bj) {
                        float gf[8]; unpack8(g[m][bj], gf);
                        float o[8];
#pragma unroll
                        for (int n = 0; n < 2; ++n)
#pragma unroll
                            for (int j = 0; j < 4; ++j) o[n * 4 + j] = gf[n * 4 + j] * acc[ai][bj][m][n][j];
                        InprojEpi::st8(Pc + off0 + (size_t)(128 * ai + 16 * m) * 1024 + 128 * bj, o);
                    }
                __builtin_amdgcn_sched_barrier(0);
            }
        }
    }
};
__device__ __forceinline__ void ctx_gate_item(const Params& p, int q, char* smem) {
    CtxGateSched S; S.ws = (const char*)p.ws; S.q = q;
    GateEpi E; E.ws_ = p.ws;
    pg8::gemm_stream<CtxGateSched, GateEpi>((PG8_LAS unsigned char*)smem, 1024, S, E);
    __syncthreads();
}
__device__ __forceinline__ void phase_gates(const Params& p, int l, char* smem) {
    GateSched S; S.ws = (const char*)p.ws; S.G = gridDim.x; S.c = blockIdx.x; S.nM = TLAT / 256; S.nctx = (l == 0) ? 48 : 0;
    GateEpi E; E.ws_ = p.ws;
    pg8::gemm_stream<GateSched, GateEpi>((PG8_LAS unsigned char*)smem, 1024, S, E);
    __syncthreads();
}
struct MergeSched {
    static constexpr bool GATHER = false;
    const char* ws; int G, c, nM;
    __device__ __forceinline__ bool next(int i, pg8::Unit& u) const {
        const int j = i / 3, br = i - 3 * j;
        int pm, pn;
        if (!pg8::static_unit(j, G, c, nM, 4, pm, pn)) return false;
        u.pm = pm; u.pn = pn; u.tag = br;
        u.A = ws + (br == 0 ? OFF_UR : br == 1 ? OFF_QS : OFF_QA) + (size_t)pm * 256 * 2048;
        u.B = ws + OFF_WT + (size_t)(WR_BR + br * 1024 + pn * 256) * 2048;
        return true;
    }
};
struct MergeEpi {
    unsigned char* ws_;
    typedef pg8::f32x4 f32x4;
    __device__ __forceinline__ void operator()(const f32x4 (&acc)[2][2][4][2], const pg8::Unit& u, int wr, int wc, int fr0, int fq0) const {
        unsigned char* ws = ws_;
        asm volatile("" : "+s"(ws));
        int fr = fr0, fq = fq0; asm volatile("" : "+v"(fr), "+v"(fq));
        const int br = u.tag;
        const bf16* Gp = (const bf16*)(ws + gate_region(br));
        bf16* Y = (bf16*)(ws + OFF_Y);
        const size_t off0 = (size_t)(256 * u.pm + 64 * wr + fr) * 1024 + 256 * u.pn + 32 * wc + 8 * fq;
#pragma unroll
        for (int ai = 0; ai < 2; ++ai) {
            uint4 g[4][2], y[4][2];
#pragma unroll
            for (int m = 0; m < 4; ++m)
#pragma unroll
                for (int bj = 0; bj < 2; ++bj) {
                    const size_t off = off0 + (size_t)(128 * ai + 16 * m) * 1024 + 128 * bj;
                    g[m][bj] = *(const uint4*)(Gp + off);
                    if (br > 0) y[m][bj] = *(const uint4*)(Y + off);
                }
#pragma unroll
            for (int m = 0; m < 4; ++m)
#pragma unroll
                for (int bj = 0; bj < 2; ++bj) {
                    const size_t off = off0 + (size_t)(128 * ai + 16 * m) * 1024 + 128 * bj;
                    float gf[8]; unpack8(g[m][bj], gf);
                    float o[8];
#pragma unroll
                    for (int n = 0; n < 2; ++n)
#pragma unroll
                        for (int j = 0; j < 4; ++j) o[n * 4 + j] = gf[n * 4 + j] * acc[ai][bj][m][n][j];
                    if (br > 0) {
                        float yf[8]; unpack8(y[m][bj], yf);
#pragma unroll
                        for (int j = 0; j < 8; ++j) o[j] += yf[j];
                    }
                    InprojEpi::st8(Y + off, o);
                }
            __builtin_amdgcn_sched_barrier(0);
        }
    }
};
__device__ __forceinline__ void phase_merge(const Params& p, int l, char* smem) {
    MergeSched S; S.ws = (const char*)p.ws; S.G = gridDim.x; S.c = blockIdx.x; S.nM = TLAT / 256;
    MergeEpi E; E.ws_ = p.ws;
    pg8::gemm_stream<MergeSched, MergeEpi>((PG8_LAS unsigned char*)smem, 1024, S, E);
    __syncthreads();
    if (l == 0) {
        const uint4* P0 = (const uint4*)(p.ws + OFF_PC); uint4* Yc = (uint4*)(p.ws + OFF_Y + (size_t)TLAT * 2048);
        for (int i = blockIdx.x * NT + otid(); i < 1024 * 1024 / 8; i += gridDim.x * NT) {
            float a[8], b[8], c[8]; unpack8(P0[i], a); unpack8(P0[i + 131072], b); unpack8(P0[i + 262144], c);
            uint4 o; o.x = pack2(a[0] + b[0] + c[0], a[1] + b[1] + c[1]); o.y = pack2(a[2] + b[2] + c[2], a[3] + b[3] + c[3]);
            o.z = pack2(a[4] + b[4] + c[4], a[5] + b[5] + c[5]); o.w = pack2(a[6] + b[6] + c[6], a[7] + b[7] + c[7]);
            Yc[i] = o;
        }
    }
}

__device__ __forceinline__ bool moe_find(const int* cnt, int tile, int& e, int& mt, int& rowbase, int& ce) {
    const int lane = otid() & 63;
    const int c = lane < 16 ? cnt[lane] : 0;
    const int nt = (c + 255) >> 8;
    int pt = nt, pr = c;
#pragma unroll
    for (int o = 1; o < 16; o <<= 1) { const int a = shup(pt, o, lane), b = shup(pr, o, lane); if (lane >= o) { pt += a; pr += b; } }
    const bool mine = lane < 16 && tile >= pt - nt && tile < pt;
    const unsigned long long m = __ballot(mine);
    if (m == 0ull) return false;
    const int src = __ffsll((long long)m) - 1;
    e = src;
    mt = tile - (__builtin_amdgcn_readlane(pt, src) - __builtin_amdgcn_readlane(nt, src));
    rowbase = __builtin_amdgcn_readlane(pr, src) - __builtin_amdgcn_readlane(c, src);
    ce = __builtin_amdgcn_readlane(c, src);
    return true;
}
struct Moe1Sched {
    static constexpr bool GATHER = true;
    const char* ws; const int* cnt; const int* lts; int G, c;
    __device__ __forceinline__ bool next(int i, pg8::Unit& u) const {
        const int L = i * G + c; const int tile = L >> 2, pn = L & 3;
        int e, mt, rowbase, ce;
        if (!moe_find(cnt, tile, e, mt, rowbase, ce)) return false;
        u.pm = mt; u.pn = pn; u.tag = e; u.x0 = rowbase; u.x1 = ce;
        u.A = ws + OFF_H; u.B = ws + OFF_WGU + ((size_t)e * 1024 + pn * 256) * 2048;
        return true;
    }
    __device__ __forceinline__ unsigned row_off(const pg8::Unit& u, int r) const {
        int idx = u.pm * 256 + r; if (idx >= u.x1) idx = u.x1 - 1;
        return (unsigned)(lts[(size_t)u.tag * TALL + idx] >> 1) * 2048u;
    }
};
struct Moe1Epi {
    unsigned char* ws_; int l;
    typedef pg8::f32x4 f32x4;
    __device__ __forceinline__ void operator()(const f32x4 (&acc)[2][2][4][2], const pg8::Unit& u, int wr, int wc, int fr0, int fq0) const {
        unsigned char* ws = ws_;
        asm volatile("" : "+v"(ws));
        int fr = fr0, fq = fq0; asm volatile("" : "+v"(fr), "+v"(fq));
        const int mt = u.pm, rowbase = u.x0, ce = u.x1;
        bf16* HB = (bf16*)(ws + OFF_HB);
#pragma unroll
        for (int ai = 0; ai < 2; ++ai)
#pragma unroll
            for (int m = 0; m < 4; ++m) {
                const int idx = mt * 256 + 128 * ai + 64 * wr + 16 * m + fr;
                if (idx < ce) {
                    float o[8];
#pragma unroll
                    for (int n = 0; n < 2; ++n)
#pragma unroll
                        for (int j = 0; j < 4; ++j) { const float g = acc[ai][0][m][n][j], uu = acc[ai][1][m][n][j]; o[n * 4 + j] = fsilu_(g) * uu; }
                    InprojEpi::st8(HB + (size_t)(rowbase + idx) * 512 + 128 * u.pn + 32 * wc + 8 * fq, o);
                }
                __builtin_amdgcn_sched_barrier(0);
            }
    }
};
__device__ __forceinline__ void phase_moe1(const Params& p, int l, char* smem) {
    Moe1Sched S; S.ws = (const char*)p.ws; S.cnt = (const int*)(p.ws + OFF_CTL) + l * 16; S.lts = (const int*)(p.ws + OFF_LTS); S.G = gridDim.x; S.c = blockIdx.x;
    Moe1Epi E; E.ws_ = p.ws; E.l = l;
    pg8::gemm_stream<Moe1Sched, Moe1Epi>((PG8_LAS unsigned char*)smem, 1024, S, E);
    __syncthreads();
    if (l == 0) {
        const int* cnt = (const int*)(p.ws + OFF_CTL) + l * 16;
        int tiles = 0;
        for (int i = 0; i < 16; ++i) tiles += (__builtin_amdgcn_readfirstlane(cnt[i]) + 255) >> 8;
        const int rem = (tiles * 4) % (int)gridDim.x;
        conv_run(p, 1, 0, smem, (rem > 0 && rem < (int)gridDim.x - 32) ? rem : 0);
    }
}
struct Moe2Sched {
    static constexpr bool GATHER = false;
    const char* ws; const int* cnt; int G, c;
    __device__ __forceinline__ bool next(int i, pg8::Unit& u) const {
        const int L = i * G + c; const int tile = L >> 2, pn = L & 3;
        int e, mt, rowbase, ce;
        if (!moe_find(cnt, tile, e, mt, rowbase, ce)) return false;
        u.pm = mt; u.pn = pn; u.tag = e; u.x0 = rowbase; u.x1 = ce;
        u.A = ws + OFF_HB + (size_t)(rowbase + mt * 256) * 1024; u.B = ws + OFF_WD + ((size_t)e * 1024 + pn * 256) * 1024;
        return true;
    }
};
struct Moe2Epi {
    unsigned char* ws_; int l;
    typedef pg8::f32x4 f32x4;
    __device__ __forceinline__ void operator()(const f32x4 (&acc)[2][2][4][2], const pg8::Unit& u, int wr, int wc, int fr0, int fq0) const {
        unsigned char* ws = ws_;
        asm volatile("" : "+s"(ws));
        int fr = fr0, fq = fq0; asm volatile("" : "+v"(fr), "+v"(fq));
        const int e = u.tag, mt = u.pm, ce = u.x1;
        const int* lts = (const int*)(ws + OFF_LTS) + (size_t)e * TALL; const float* lw = (const float*)(ws + OFF_LW) + (size_t)e * TALL;
        bf16* YB = (bf16*)(ws + OFF_YB);
        int tsv[2][4]; float wv[2][4];
#pragma unroll
        for (int ai = 0; ai < 2; ++ai)
#pragma unroll
            for (int m = 0; m < 4; ++m) {
                int idx = mt * 256 + 128 * ai + 64 * wr + 16 * m + fr; if (idx >= ce) idx = ce - 1;
                tsv[ai][m] = lts[idx]; wv[ai][m] = lw[idx];
            }
#pragma unroll
        for (int ai = 0; ai < 2; ++ai)
#pragma unroll
            for (int m = 0; m < 4; ++m) {
                const int idx = mt * 256 + 128 * ai + 64 * wr + 16 * m + fr;
                if (idx < ce) {
                    const int ts = tsv[ai][m]; const float w = wv[ai][m];
#pragma unroll
                    for (int bj = 0; bj < 2; ++bj) {
                        float o[8];
#pragma unroll
                        for (int n = 0; n < 2; ++n)
#pragma unroll
                            for (int j = 0; j < 4; ++j) o[n * 4 + j] = w * acc[ai][bj][m][n][j];
                        InprojEpi::st8(YB + (size_t)ts * 1024 + 256 * u.pn + 128 * bj + 32 * wc + 8 * fq, o);
                    }
                }
            }
    }
};
__device__ __forceinline__ void phase_moe2(const Params& p, int l, char* smem) {
    Moe2Sched S; S.ws = (const char*)p.ws; S.cnt = (const int*)(p.ws + OFF_CTL) + l * 16; S.G = gridDim.x; S.c = blockIdx.x;
    Moe2Epi E; E.ws_ = p.ws; E.l = l;
    pg8::gemm_stream<Moe2Sched, Moe2Epi>((PG8_LAS unsigned char*)smem, 512, S, E);
    __syncthreads();
}

namespace ga {
using s16x4  = __attribute__((ext_vector_type(4))) short;
using u32x4  = __attribute__((ext_vector_type(4))) unsigned;
constexpr int QBLK = 32, KVBLK = 64;
constexpr float SCALE = 0.088388347648318440f;
constexpr float THR = 8.f;
constexpr int LDQ = 1024, LDK = 256, LDO = 1024;
constexpr int SHM_V = KVBLK * 128 * 2, SHM_K = KVBLK * 128 * 2;
constexpr int SHM_ATTN = 2 * SHM_V + 2 * SHM_K + 8 * 64 * 4;
#define KSWZ(row, colB) ((row) * 256 + ((colB) ^ (((row) & 7) << 4)))
#define SBAR() __builtin_amdgcn_sched_barrier(0)
__device__ __forceinline__ int crow(int r, int hi) { return (r & 3) + 8 * (r >> 2) + 4 * hi; }
__device__ __forceinline__ unsigned cvtpk(float lo, float hi) { return pack2(lo, hi); }
__device__ __forceinline__ void partialSM_fixed(f32x16& p0, f32x16& p1, float mnC) {
  constexpr float C = SCALE * 1.4426950408889634f;
#pragma unroll
  for (int r = 0; r < 16; ++r) p0[r] = __builtin_amdgcn_exp2f(fmaf(p0[r], C, mnC));
#pragma unroll
  for (int r = 0; r < 16; ++r) p1[r] = fmaf(p1[r], C, mnC);
}
__device__ __forceinline__ void partialSM(f32x16& p0, f32x16& p1, float& m_reg, float& mn, float& alpha) {
  constexpr float C = SCALE * 1.4426950408889634f;
  float pmax = p0[0];
#pragma unroll
  for (int r = 1; r < 16; ++r) pmax = fmaxf(pmax, p0[r]);
#pragma unroll
  for (int r = 0; r < 16; ++r) pmax = fmaxf(pmax, p1[r]);
  { auto rr = __builtin_amdgcn_permlane32_swap(__float_as_uint(pmax), __float_as_uint(pmax), false, false);
    pmax = fmaxf(__uint_as_float(rr[0]), __uint_as_float(rr[1])); }
  if (__builtin_expect(__all(pmax - m_reg <= THR / SCALE), 1)) { mn = m_reg; alpha = 1.f; }
  else { mn = fmaxf(m_reg, pmax); alpha = __builtin_amdgcn_exp2f((m_reg - mn) * C); m_reg = mn; }
  float mnC = -mn * C;
#pragma unroll
  for (int r = 0; r < 16; ++r) p0[r] = fmaf(p0[r], C, mnC);
#pragma unroll
  for (int r = 0; r < 16; ++r) p1[r] = fmaf(p1[r], C, mnC);
#pragma unroll
  for (int r = 0; r < 16; ++r) p0[r] = __builtin_amdgcn_exp2f(p0[r]);
}
__device__ __forceinline__ void finishSM(f32x16& p0, f32x16& p1, float alpha, float& l_reg, bf16x8& pa0, bf16x8& pa1, bf16x8& pa2, bf16x8& pa3) {
#pragma unroll
  for (int r = 0; r < 16; ++r) p1[r] = __builtin_amdgcn_exp2f(p1[r]);
  float ps = 0;
#pragma unroll
  for (int r = 0; r < 16; ++r) ps += p0[r];
#pragma unroll
  for (int r = 0; r < 16; ++r) ps += p1[r];
  { auto rr = __builtin_amdgcn_permlane32_swap(__float_as_uint(ps), __float_as_uint(ps), false, false);
    ps = __uint_as_float(rr[0]) + __uint_as_float(rr[1]); }
  l_reg = l_reg * alpha + ps;
#define PK4(P, BASE, OUT) do { unsigned a0 = cvtpk(P[BASE + 0], P[BASE + 1]), a1 = cvtpk(P[BASE + 2], P[BASE + 3]);   \
    unsigned b0 = cvtpk(P[BASE + 4], P[BASE + 5]), b1 = cvtpk(P[BASE + 6], P[BASE + 7]);                              \
    auto r0 = __builtin_amdgcn_permlane32_swap(a0, b0, false, false); auto r1 = __builtin_amdgcn_permlane32_swap(a1, b1, false, false); \
    u32x4 w = {r0[0], r1[0], r0[1], r1[1]}; OUT = *reinterpret_cast<bf16x8*>(&w); } while (0)
  PK4(p0, 0, pa0); PK4(p0, 8, pa1); PK4(p1, 0, pa2); PK4(p1, 8, pa3);
#undef PK4
}
__device__ __forceinline__ void qkt(f32x16& p0, f32x16& p1, const char* Ks, const bf16x8* qr, int r32, int hi) {
  p0 = f32x16{}; p1 = f32x16{};
#pragma unroll
  for (int d0 = 0; d0 < 8; ++d0) { int cb = (d0 * 16 + hi * 8) * 2;
    bf16x8 b0 = *reinterpret_cast<const bf16x8*>(Ks + KSWZ(r32, cb));
    bf16x8 b1 = *reinterpret_cast<const bf16x8*>(Ks + KSWZ(32 + r32, cb));
    p0 = __builtin_amdgcn_mfma_f32_32x32x16_bf16(b0, qr[d0], p0, 0, 0, 0);
    p1 = __builtin_amdgcn_mfma_f32_32x32x16_bf16(b1, qr[d0], p1, 0, 0, 0); }
}
__device__ __forceinline__ int v_st(int k, int c) { const int kk = (k & ~0xC) | ((k & 4) << 1) | ((k & 8) >> 1); return ((kk >> 3) * 4 + (c >> 5)) * 512 + ((kk & 7) * 32 + (c & 31)) * 2; }
__device__ __forceinline__ int v_rd_base(int lane) { return ((lane & 3) << 3) | (((lane >> 2) & 3) << 6) | (((lane >> 4) & 1) << 5) | (((lane >> 5) & 1) << 8); }
constexpr int v_rd_off(int d0, int ks, int half) { return d0 * 512 + ks * 4096 + half * 2048; }
template <int OFF> __device__ __forceinline__ s16x4 tr_read(int vb) {
  s16x4 r; asm volatile("ds_read_b64_tr_b16 %0, %1 offset:%2" : "=&v"(r) : "v"(vb), "i"(OFF) : "memory"); return r;
}
template <int D0> __device__ __forceinline__ void pv_one(f32x16& od, int vb, bf16x8 pa0, bf16x8 pa1, bf16x8 pa2, bf16x8 pa3) {
  const s16x4 l0 = tr_read<v_rd_off(D0, 0, 0)>(vb), h0 = tr_read<v_rd_off(D0, 0, 1)>(vb), l1 = tr_read<v_rd_off(D0, 1, 0)>(vb), h1 = tr_read<v_rd_off(D0, 1, 1)>(vb);
  const s16x4 l2 = tr_read<v_rd_off(D0, 2, 0)>(vb), h2 = tr_read<v_rd_off(D0, 2, 1)>(vb), l3 = tr_read<v_rd_off(D0, 3, 0)>(vb), h3 = tr_read<v_rd_off(D0, 3, 1)>(vb);
  asm volatile("s_waitcnt lgkmcnt(0)" ::: "memory"); SBAR();
#define PK(L, H) (bf16x8){L[0], L[1], L[2], L[3], H[0], H[1], H[2], H[3]}
  od = __builtin_amdgcn_mfma_f32_32x32x16_bf16(pa0, PK(l0, h0), od, 0, 0, 0);
  od = __builtin_amdgcn_mfma_f32_32x32x16_bf16(pa1, PK(l1, h1), od, 0, 0, 0);
  od = __builtin_amdgcn_mfma_f32_32x32x16_bf16(pa2, PK(l2, h2), od, 0, 0, 0);
  od = __builtin_amdgcn_mfma_f32_32x32x16_bf16(pa3, PK(l3, h3), od, 0, 0, 0);
#undef PK
}
__device__ __forceinline__ void pv_d0(f32x16* o, int vb, bf16x8 pa0, bf16x8 pa1, bf16x8 pa2, bf16x8 pa3) {
  pv_one<0>(o[0], vb, pa0, pa1, pa2, pa3); pv_one<1>(o[1], vb, pa0, pa1, pa2, pa3); pv_one<2>(o[2], vb, pa0, pa1, pa2, pa3); pv_one<3>(o[3], vb, pa0, pa1, pa2, pa3);
}

__device__ __forceinline__ void attn_dense_body(bf16* Qb, const bf16* Klat, const bf16* Vlat, const bf16* Kctx, const bf16* Vctx,
                                                int nlat, int seq, char* lds, float mfix) {
  const int tid = otid(), wid = tid >> 6, lane = tid & 63, r32 = lane & 31, hi = lane >> 5;
  char* V_lds = lds; char* K_lds = lds + 2 * SHM_V;
  float* wsl = (float*)(lds + 2 * SHM_V + 2 * SHM_K) + wid * 64; float* li_l = wsl; float* al_l = wsl + 32;
  float l_reg = 0; f32x16 o[4] = {}; bf16x8 qr[8];
  const bf16* Qw = Qb + (long)(wid * QBLK + r32) * LDQ + hi * 8;
#pragma unroll
  for (int d0 = 0; d0 < 8; ++d0) qr[d0] = *reinterpret_cast<const bf16x8*>(Qw + d0 * 16);
  const int sr = tid >> 4, sc = (tid & 15) * 8, vst0 = v_st(sr, sc), vst1 = v_st(32 + sr, sc);
  const int vb0 = (int)(uintptr_t)V_lds + v_rd_base(lane);
  struct { bf16x8 vs0, vs1, ks0, ks1; } sr_[2];
#define KVROW(k0) ((k0) < nlat ? (long)(k0) * LDK : (long)((k0) - nlat) * LDK)
#define SLOAD(i, k0) do { const bf16* kb_ = ((k0) < nlat ? Klat : Kctx) + KVROW(k0); const bf16* vb_ = ((k0) < nlat ? Vlat : Vctx) + KVROW(k0); \
    sr_[i].vs0 = *reinterpret_cast<const bf16x8*>(vb_ + (long)sr * LDK + sc); sr_[i].vs1 = *reinterpret_cast<const bf16x8*>(vb_ + (long)(32 + sr) * LDK + sc); \
    sr_[i].ks0 = *reinterpret_cast<const bf16x8*>(kb_ + (long)sr * LDK + sc); sr_[i].ks1 = *reinterpret_cast<const bf16x8*>(kb_ + (long)(32 + sr) * LDK + sc); } while (0)
#define SWRITE(b, i) do { *(bf16x8*)(V_lds + (b) * SHM_V + vst0) = sr_[i].vs0;          \
    *(bf16x8*)(V_lds + (b) * SHM_V + vst1) = sr_[i].vs1; int kc = sc * 2;               \
    *(bf16x8*)(K_lds + (b) * SHM_K + KSWZ(sr, kc)) = sr_[i].ks0;                       \
    *(bf16x8*)(K_lds + (b) * SHM_K + KSWZ(32 + sr, kc)) = sr_[i].ks1; } while (0)
#define SWAIT() asm volatile("s_waitcnt vmcnt(4)" ::: "memory")
#define RESC(a) do { if (__any((a) < 1.f)) { if (hi == 0) al_l[r32] = (a); asm volatile("s_waitcnt lgkmcnt(0)" ::: "memory"); \
    _Pragma("unroll") for (int d = 0; d < 4; ++d) _Pragma("unroll") for (int r = 0; r < 16; ++r) o[d][r] *= al_l[crow(r, hi)]; } } while (0)
  f32x16 pA0, pA1, pB0, pB1; bf16x8 pa0, pa1, pa2, pa3; const int NTL = seq / KVBLK;
  const float mnC = -mfix * (SCALE * 1.4426950408889634f);
  constexpr int SE = 0, SO = 1;
  SLOAD(SE, 0); asm volatile("s_waitcnt vmcnt(0)" ::: "memory"); SWRITE(0, SE); __syncthreads();
  qkt(pA0, pA1, K_lds, qr, r32, hi); partialSM_fixed(pA0, pA1, mnC);
  SLOAD(SO, KVBLK); if (2 < NTL) SLOAD(SE, 2 * KVBLK);
  SWAIT(); SWRITE(1, SO); __syncthreads();
  for (int j = 1; j + 1 < NTL; j += 2) {
    SBAR(); qkt(pB0, pB1, K_lds + SHM_K, qr, r32, hi);
    finishSM(pA0, pA1, 1.f, l_reg, pa0, pa1, pa2, pa3); SBAR();
    SLOAD(SO, (j + 2) * KVBLK); SBAR();
    pv_d0(o, vb0, pa0, pa1, pa2, pa3); partialSM_fixed(pB0, pB1, mnC);
    __syncthreads(); SWAIT(); SWRITE(0, SE);
    __syncthreads();
    SBAR(); qkt(pA0, pA1, K_lds, qr, r32, hi);
    finishSM(pB0, pB1, 1.f, l_reg, pa0, pa1, pa2, pa3); SBAR();
    if (j + 3 < NTL) SLOAD(SE, (j + 3) * KVBLK); SBAR();
    pv_d0(o, vb0 + (int)SHM_V, pa0, pa1, pa2, pa3); partialSM_fixed(pA0, pA1, mnC);
    __syncthreads(); SWAIT(); SWRITE(1, SO);
    __syncthreads();
  }
  SBAR(); qkt(pB0, pB1, K_lds + SHM_K, qr, r32, hi);
  finishSM(pA0, pA1, 1.f, l_reg, pa0, pa1, pa2, pa3); SBAR();
  pv_d0(o, vb0, pa0, pa1, pa2, pa3); partialSM_fixed(pB0, pB1, mnC);
  __syncthreads();
  finishSM(pB0, pB1, 1.f, l_reg, pa0, pa1, pa2, pa3); SBAR();
  pv_d0(o, vb0 + (int)SHM_V, pa0, pa1, pa2, pa3);
  if (hi == 0) li_l[r32] = l_reg; asm volatile("s_waitcnt lgkmcnt(0)" ::: "memory");
  float rli[16];
#pragma unroll
  for (int r = 0; r < 16; ++r) rli[r] = __builtin_amdgcn_rcpf(li_l[crow(r, hi)]);
  bf16* Ow = Qb + (long)(wid * QBLK) * LDO;
#pragma unroll
  for (int r = 0; r < 16; ++r) { int orow = crow(r, hi);
#pragma unroll
    for (int d0 = 0; d0 < 4; ++d0) Ow[(long)orow * LDO + d0 * 32 + r32] = f2bf(o[d0][r] * rli[r]); }
  __syncthreads();
#undef KVROW
#undef SLOAD
#undef SWRITE
#undef SWAIT
#undef RESC
}
#undef KSWZ
}

__device__ __forceinline__ void ga_item(const Params& p, int l, int it, char* smem) {
    const float mfix = ((const float*)(p.ws + OFF_DEC))[16 + l];
    bf16* QA = (bf16*)(p.ws + OFF_QA); const bf16* KA = (const bf16*)(p.ws + OFF_KA); const bf16* VA = (const bf16*)(p.ws + OFF_VA);
    if (it < 512) {
        const int pair = it & 7, j = it >> 3, hg = j >> 4, qb = j & 15, b = pair >> 1, kvh = pair & 1, head = kvh * 4 + hg;
        ga::attn_dense_body(QA + (size_t)(b * SEQ + qb * 256) * 1024 + head * 128,
                            KA + (size_t)(b * SEQ) * 256 + kvh * 128, VA + (size_t)(b * SEQ) * 256 + kvh * 128,
                            KA + (size_t)(TLAT + b * CTXL) * 256 + kvh * 128, VA + (size_t)(TLAT + b * CTXL) * 256 + kvh * 128,
                            4096, 4352, smem, mfix);
    } else {
        const int j = it - 512, b = j >> 3, head = j & 7, kvh = head >> 2;
        const bf16* kc = KA + (size_t)(TLAT + b * CTXL) * 256 + kvh * 128; const bf16* vc = VA + (size_t)(TLAT + b * CTXL) * 256 + kvh * 128;
        ga::attn_dense_body(QA + (size_t)(TLAT + b * CTXL) * 1024 + head * 128, kc, vc, kc, vc, 0, 256, smem, mfix);
    }
}
__device__ __forceinline__ int chunk_key0(int c) { return c < 32 ? c * 128 : 4096 + (c - 32) * 128; }
__device__ __forceinline__ void ret1_item(const Params& p, int l, int it, char* smem) {
    const int tid = otid(), lr = tid >> 3;
    const bf16* VT = (const bf16*)(p.ws + OFF_VR);
    bf16* F = (bf16*)(p.ws + OFF_F);
    {
        const int dir = it & 1, j = it >> 1, c = j % 34, bh = j / 34;
        const int key0 = chunk_key0(c);
        const bf16* KT = (const bf16*)(p.ws + (dir ? OFF_KBT : OFF_KFT));
        const bf16* a = VT + ((size_t)bh * 256 + lr) * KEYS + key0;
        const bf16* b = KT + ((size_t)bh * 128 + lr) * KEYS + key0;
        f32x16 acc[2][2]; zero_acc<2>(acc);
        gemm_mainloop<2>(acc, a, a + 64 * KEYS, a + 128 * KEYS, a + 192 * KEYS, b, b + 64 * KEYS, 128, smem);
        bf16* dst = F + ((size_t)(dir * 16 + bh) * 34 + c) * 32768;
        for (int h = 0; h < 2; ++h) {
            stage_half(acc, h, smem);
            __syncthreads();
            epi_plain_bf16((const float*)smem, dst, 128, h * 128, 0);
            __syncthreads();
        }
    }
}

__device__ __forceinline__ void phase_ret_scan(const Params& p, int l) {
    const int tid = otid();
    unsigned* F = (unsigned*)(p.ws + OFF_F);
    for (int g = blockIdx.x * NT + tid; g < 2 * 16 * 16384; g += gridDim.x * NT) {
        const int e2 = g & 16383, bh = (g >> 14) & 15, dir = g >> 18, h = bh & 3;
        const float lg = ((const float*)(p.ws + OFF_DEC))[l * 8 + dir * 4 + h];
        const float g128 = fexp_(128.f * lg);
        unsigned* base = F + (size_t)(dir * 16 + bh) * 34 * 16384 + e2;
        unsigned u[34];
#pragma unroll
        for (int c = 0; c < 34; ++c) u[c] = base[(size_t)c * 16384];
        float s0 = 0.f, s1 = 0.f;
        if (dir == 0) {
#pragma unroll
            for (int k = 0; k < 34; ++k) {
                const int c = k == 0 ? 32 : (k == 1 ? 33 : k - 2);
                const unsigned v = u[c];
                base[(size_t)c * 16384] = pack2(s0, s1);
                s0 = g128 * s0 + lo2f(v); s1 = g128 * s1 + hi2f(v);
            }
        } else {
#pragma unroll
            for (int k = 0; k < 34; ++k) {
                const int c = k == 0 ? 33 : (k == 1 ? 32 : 33 - k);
                const unsigned v = u[c];
                base[(size_t)c * 16384] = pack2(s0, s1);
                s0 = g128 * s0 + lo2f(v); s1 = g128 * s1 + hi2f(v);
            }
        }
    }
}

namespace r3 {
constexpr int KROWB = 272, VROWB = 264;
constexpr int KS_BYTES = 128 * KROWB, VT_BYTES = 256 * VROWB;
__device__ __forceinline__ int crow(int r, int hi) { return (r & 3) + 8 * (r >> 2) + 4 * hi; }
__device__ __forceinline__ bf16x8 scaleq(bf16x8 q, float sc) {
    ga::u32x4 w = *reinterpret_cast<ga::u32x4*>(&q);
    ga::u32x4 o = {pack2(lo2f(w[0]) * sc, hi2f(w[0]) * sc), pack2(lo2f(w[1]) * sc, hi2f(w[1]) * sc), pack2(lo2f(w[2]) * sc, hi2f(w[2]) * sc), pack2(lo2f(w[3]) * sc, hi2f(w[3]) * sc)};
    return *reinterpret_cast<bf16x8*>(&o);
}
__device__ __forceinline__ void body(const Params& p, int l, int b, int h, int c, char* lds) {
    const int tid = otid(), wid = tid >> 6, lane = tid & 63, r32 = lane & 31, hi = lane >> 5, wq = wid & 3, wv = wid >> 2;
    const bf16* QR = (const bf16*)(p.ws + OFF_QR); const bf16* KR = (const bf16*)(p.ws + OFF_KR);
    const bf16* VT = (const bf16*)(p.ws + OFF_VR); bf16* UR = (bf16*)(p.ws + OFF_UR);
    const bf16* F = (const bf16*)(p.ws + OFF_F);
    const int bh = b * 4 + h, key0 = chunk_key0(c);
    const int row0 = c < 32 ? b * SEQ + c * 128 : TLAT + b * CTXL + (c - 32) * 128;
    const float* dec = (const float*)(p.ws + OFF_DEC) + 64 + (size_t)((l * 4 + h) * 6) * 128;
    char* Ks = lds; char* Vt = lds + KS_BYTES; float* red = (float*)(lds + KS_BYTES + VT_BYTES);
    {
        uint4 kv[4], vv[8];
#pragma unroll
        for (int i = 0; i < 4; ++i) { const int idx = tid + NT * i; kv[i] = *(const uint4*)(KR + (size_t)(row0 + (idx >> 4)) * 512 + h * 128 + (idx & 15) * 8); }
#pragma unroll
        for (int i = 0; i < 8; ++i) { const int idx = tid + NT * i; vv[i] = *(const uint4*)(VT + ((size_t)bh * 256 + (idx >> 4)) * KEYS + key0 + (idx & 15) * 8); }
#pragma unroll
        for (int i = 0; i < 4; ++i) { const int idx = tid + NT * i; *(uint4*)(Ks + (idx >> 4) * KROWB + (idx & 15) * 16) = kv[i]; }
#pragma unroll
        for (int i = 0; i < 8; ++i) { const int idx = tid + NT * i; char* d = Vt + (idx >> 4) * VROWB + (idx & 15) * 16;
            *(uint2*)d = make_uint2(vv[i].x, vv[i].y); *(uint2*)(d + 8) = make_uint2(vv[i].z, vv[i].w); }
    }
    const int iq = 32 * wq + r32;
    bf16x8 qr[8];
    {
        const bf16* Qw = QR + (size_t)(row0 + iq) * 512 + h * 128 + hi * 8;
#pragma unroll
        for (int d0 = 0; d0 < 8; ++d0) qr[d0] = *reinterpret_cast<const bf16x8*>(Qw + d0 * 16);
    }
    __syncthreads();
    f32x16 o[4] = {};
    const bf16* St0 = F + ((size_t)(0 * 16 + bh) * 34 + c) * 32768; const bf16* St1 = F + ((size_t)(1 * 16 + bh) * 34 + c) * 32768;
#define R3_LD(P, i) (*(const uint4*)((P) + (size_t)(tid + NT * (i)) * 8))
    uint4 sv0 = R3_LD(St0, 0), sv1 = R3_LD(St0, 1), sv2 = R3_LD(St0, 2), sv3 = R3_LD(St0, 3), sv4 = R3_LD(St0, 4), sv5 = R3_LD(St0, 5), sv6 = R3_LD(St0, 6), sv7 = R3_LD(St0, 7);
#pragma unroll 1
    for (int kb = 0; kb < 4; ++kb) {
        f32x16 pz = {};
#pragma unroll
        for (int d0 = 0; d0 < 8; ++d0) {
            const bf16x8 kf = *reinterpret_cast<const bf16x8*>(Ks + (32 * kb + r32) * KROWB + (d0 * 16 + hi * 8) * 2);
            pz = __builtin_amdgcn_mfma_f32_32x32x16_bf16(kf, qr[d0], pz, 0, 0, 0);
        }
#pragma unroll
        for (int r = 0; r < 16; ++r) {
            const int dd = iq - (32 * kb + crow(r, hi));
            pz[r] *= (dd >= 0) ? dec[512 + dd] : dec[640 - dd];
        }
#pragma unroll
        for (int s2 = 0; s2 < 2; ++s2) {
            ga::u32x4 pw = {pack2(pz[8 * s2 + 0], pz[8 * s2 + 1]), pack2(pz[8 * s2 + 2], pz[8 * s2 + 3]), pack2(pz[8 * s2 + 4], pz[8 * s2 + 5]), pack2(pz[8 * s2 + 6], pz[8 * s2 + 7])};
            const bf16x8 pa = *reinterpret_cast<bf16x8*>(&pw);
#pragma unroll
            for (int db = 0; db < 4; ++db) {
                const char* vp = Vt + (128 * wv + 32 * db + r32) * VROWB + (32 * kb + 16 * s2 + 4 * hi) * 2;
                const uint2 lo = *(const uint2*)vp, hi2 = *(const uint2*)(vp + 16);
                ga::u32x4 bw = {lo.x, lo.y, hi2.x, hi2.y};
                o[db] = __builtin_amdgcn_mfma_f32_32x32x16_bf16(pa, *reinterpret_cast<bf16x8*>(&bw), o[db], 0, 0, 0);
            }
        }
    }
    char* Ss = lds;
#define R3_ST(i, v) do { const int idx = tid + NT * (i); *(uint4*)(Ss + (idx >> 4) * KROWB + (idx & 15) * 16) = (v); } while (0)
#define R3_STATE_WRITE() do { R3_ST(0, sv0); R3_ST(1, sv1); R3_ST(2, sv2); R3_ST(3, sv3); R3_ST(4, sv4); R3_ST(5, sv5); R3_ST(6, sv6); R3_ST(7, sv7); } while (0)
#define R3_STATE_MMA(SC) do { const float sc_ = (SC); _Pragma("unroll") for (int s = 0; s < 8; ++s) { const bf16x8 qa = scaleq(qr[s], sc_); \
        _Pragma("unroll") for (int db = 0; db < 4; ++db) { \
            const bf16x8 bfr = *reinterpret_cast<const bf16x8*>(Ss + (128 * wv + 32 * db + r32) * KROWB + (16 * s + 8 * hi) * 2); \
            o[db] = __builtin_amdgcn_mfma_f32_32x32x16_bf16(qa, bfr, o[db], 0, 0, 0); } } } while (0)
    __syncthreads();
    R3_STATE_WRITE();
    sv0 = R3_LD(St1, 0); sv1 = R3_LD(St1, 1); sv2 = R3_LD(St1, 2); sv3 = R3_LD(St1, 3); sv4 = R3_LD(St1, 4); sv5 = R3_LD(St1, 5); sv6 = R3_LD(St1, 6); sv7 = R3_LD(St1, 7);
    __syncthreads();
    R3_STATE_MMA(dec[256 + iq]);
    __syncthreads();
    R3_STATE_WRITE();
    __syncthreads();
    R3_STATE_MMA(dec[384 + iq]);
#undef R3_STATE_WRITE
#undef R3_STATE_MMA
#undef R3_ST
#undef R3_LD
    float ssq[16];
#pragma unroll
    for (int r = 0; r < 16; ++r) { ssq[r] = o[0][r] * o[0][r] + o[1][r] * o[1][r] + o[2][r] * o[2][r] + o[3][r] * o[3][r]; }
#pragma unroll
    for (int r = 0; r < 16; ++r) {
        float v = ssq[r];
        v += shx(v, 1, lane); v += shx(v, 2, lane); v += shx(v, 4, lane); v += shx(v, 8, lane); v += shx(v, 16, lane);
        ssq[r] = v;
    }
    if (r32 == 0) {
#pragma unroll
        for (int r = 0; r < 16; ++r) red[wv * 128 + 32 * wq + crow(r, hi)] = ssq[r];
    }
    __syncthreads();
    char* Os = lds;
#pragma unroll
    for (int r = 0; r < 16; ++r) {
        const int il = crow(r, hi);
        const float rs = rsqrtf((red[32 * wq + il] + red[128 + 32 * wq + il]) * (1.f / 256.f) + EPS);
#pragma unroll
        for (int db = 0; db < 4; ++db) *(bf16*)(Os + (32 * wq + il) * 528 + (128 * wv + 32 * db + r32) * 2) = f2bf(o[db][r] * rs);
    }
    __syncthreads();
    {
        uint4 uv[8];
#pragma unroll
        for (int k = 0; k < 8; ++k) { const int cidx = tid + NT * k; uv[k] = *(const uint4*)(UR + (size_t)(row0 + (cidx >> 5)) * 1024 + h * 256 + (cidx & 31) * 8); }
#pragma unroll
        for (int k = 0; k < 8; ++k) {
            const int cidx = tid + NT * k;
            const uint4 ov = *(const uint4*)(Os + (cidx >> 5) * 528 + (cidx & 31) * 16);
            float uf[8], of[8]; unpack8(uv[k], uf); unpack8(ov, of);
            uint4 w; w.x = pack2(of[0] * fsilu_(uf[0]), of[1] * fsilu_(uf[1])); w.y = pack2(of[2] * fsilu_(uf[2]), of[3] * fsilu_(uf[3]));
            w.z = pack2(of[4] * fsilu_(uf[4]), of[5] * fsilu_(uf[5])); w.w = pack2(of[6] * fsilu_(uf[6]), of[7] * fsilu_(uf[7]));
            *(uint4*)(UR + (size_t)(row0 + (cidx >> 5)) * 1024 + h * 256 + (cidx & 31) * 8) = w;
        }
    }
    __syncthreads();
}
}

__device__ __forceinline__ void ret3_item(const Params& p, int l, int it, char* smem) {
    int b, h, c;
    if (it < 512) { c = it & 31; h = (it >> 5) & 3; b = it >> 7; }
    else { int j = it - 512; c = 32 + (j & 1); h = (j >> 1) & 3; b = j >> 3; }
    r3::body(p, l, b, h, c, smem);
}

namespace swa {
constexpr int KROWB = 144, VROWB = 136;
constexpr int KT_BYTES = 64 * KROWB, VT_BYTES = 64 * VROWB, BUF_BYTES = KT_BYTES + VT_BYTES;
constexpr float LOG2E = 1.4426950408889634f;
constexpr float THR = 8.f;
__device__ __forceinline__ int crow(int r, int hi) { return (r & 3) + 8 * (r >> 2) + 4 * hi; }

__device__ __forceinline__ void body(const Params& p, int l, int b, int kvh, int qrow0, int q0pos, char* lds) {
    const int tid = otid(), wid = tid >> 6, lane = tid & 63, r32 = lane & 31, hi = lane >> 5;
    bf16* QS = (bf16*)(p.ws + OFF_QS); const bf16* KS = (const bf16*)(p.ws + OFF_KS); const bf16* VT = (const bf16*)(p.ws + OFF_VS);
    float* wsl = (float*)(lds + 2 * BUF_BYTES) + wid * 64; float* li_l = wsl; float* al_l = wsl + 32;
    const int head = kvh * 8 + wid;
    const float sinkv = p.sink[l * 16 + head];
    float m_reg = sinkv, l_reg = 1.f;
    f32x16 o[2] = {};
    bf16x8 qr[4];
    bf16* Qw = QS + (size_t)(qrow0 + r32) * 1024 + head * 64 + hi * 8;
#pragma unroll
    for (int d0 = 0; d0 < 4; ++d0) qr[d0] = *reinterpret_cast<const bf16x8*>(Qw + d0 * 16);
    int t0 = 0, nloc = 0;
    if (q0pos >= 0) {
        const int lo = q0pos - 128 < 0 ? 0 : q0pos - 128, hiq = q0pos + 160 > SEQ ? SEQ : q0pos + 160;
        t0 = lo >> 6; nloc = ((hiq - 1) >> 6) - t0 + 1;
    }
    const int ntiles = nloc + 4;
    const int sk = tid >> 3, sch = tid & 7;
    const bf16* vtb = VT + ((size_t)(b * 2 + kvh) * 64 + sk) * KEYS + sch * 8;
    uint4 rkA, rvA, rkB, rvB;
#define TLOAD(t, RK, RV) do { const int t_ = (t); const bool loc_ = t_ < nloc; const int key0_ = loc_ ? (t0 + t_) * 64 : 4096 + (t_ - nloc) * 64; \
        const int krow_ = loc_ ? b * SEQ + key0_ : TLAT + b * CTXL + (t_ - nloc) * 64; \
        RK = *(const uint4*)(KS + (size_t)(krow_ + sk) * 128 + kvh * 64 + sch * 8); RV = *(const uint4*)(vtb + key0_); } while (0)
#define TWRITE(buf, RK, RV) do { char* kb_ = lds + (buf) * BUF_BYTES; *(uint4*)(kb_ + sk * KROWB + sch * 16) = RK; \
        char* vb_ = kb_ + KT_BYTES + sk * VROWB + sch * 16; *(uint2*)vb_ = make_uint2(RV.x, RV.y); *(uint2*)(vb_ + 8) = make_uint2(RV.z, RV.w); } while (0)
#define TILE_COMPUTE(t) do { \
        const char* Kb = lds + ((t) & 1) * BUF_BYTES; const char* Vb = Kb + KT_BYTES; \
        f32x16 p0 = {}, p1 = {}; \
        _Pragma("unroll") for (int d0 = 0; d0 < 4; ++d0) { \
            bf16x8 k0 = *reinterpret_cast<const bf16x8*>(Kb + r32 * KROWB + (d0 * 16 + hi * 8) * 2); \
            bf16x8 k1 = *reinterpret_cast<const bf16x8*>(Kb + (32 + r32) * KROWB + (d0 * 16 + hi * 8) * 2); \
            p0 = __builtin_amdgcn_mfma_f32_32x32x16_bf16(k0, qr[d0], p0, 0, 0, 0); \
            p1 = __builtin_amdgcn_mfma_f32_32x32x16_bf16(k1, qr[d0], p1, 0, 0, 0); } \
        if ((t) < nloc && !((t0 + (t)) * 64 >= q0pos - 97 && (t0 + (t)) * 64 + 63 <= q0pos + 128)) { const int kbase = (t0 + (t)) * 64 - (q0pos + r32); \
            _Pragma("unroll") for (int r = 0; r < 16; ++r) { int d0_ = kbase + crow(r, hi); int d1_ = d0_ + 32; \
                if (d0_ < -128 || d0_ > 128) p0[r] = -1e30f; if (d1_ < -128 || d1_ > 128) p1[r] = -1e30f; } } \
        float pmax = p0[0]; \
        _Pragma("unroll") for (int r = 1; r < 16; ++r) pmax = fmaxf(pmax, p0[r]); \
        _Pragma("unroll") for (int r = 0; r < 16; ++r) pmax = fmaxf(pmax, p1[r]); \
        { auto rr = __builtin_amdgcn_permlane32_swap(__float_as_uint(pmax), __float_as_uint(pmax), false, false); \
          pmax = fmaxf(__uint_as_float(rr[0]), __uint_as_float(rr[1])); } \
        float alpha = 1.f; \
        if (!__all(pmax - m_reg <= THR)) { const float mn = fmaxf(m_reg, pmax); \
            alpha = __builtin_amdgcn_exp2f((m_reg - mn) * LOG2E); m_reg = mn; \
            if (hi == 0) al_l[r32] = alpha; \
            asm volatile("s_waitcnt lgkmcnt(0)" ::: "memory"); \
            _Pragma("unroll") for (int d = 0; d < 2; ++d) _Pragma("unroll") for (int r = 0; r < 16; ++r) o[d][r] *= al_l[crow(r, hi)]; } \
        const float mC = -m_reg * LOG2E; float ps = 0.f; \
        _Pragma("unroll") for (int r = 0; r < 16; ++r) { p0[r] = __builtin_amdgcn_exp2f(fmaf(p0[r], LOG2E, mC)); ps += p0[r]; } \
        _Pragma("unroll") for (int r = 0; r < 16; ++r) { p1[r] = __builtin_amdgcn_exp2f(fmaf(p1[r], LOG2E, mC)); ps += p1[r]; } \
        { auto rr = __builtin_amdgcn_permlane32_swap(__float_as_uint(ps), __float_as_uint(ps), false, false); \
          ps = __uint_as_float(rr[0]) + __uint_as_float(rr[1]); } \
        l_reg = l_reg * alpha + ps; \
        _Pragma("unroll") for (int s4 = 0; s4 < 4; ++s4) { unsigned w0, w1, w2, w3; \
            if (s4 < 2) { w0 = pack2(p0[8 * s4 + 0], p0[8 * s4 + 1]); w1 = pack2(p0[8 * s4 + 2], p0[8 * s4 + 3]); w2 = pack2(p0[8 * s4 + 4], p0[8 * s4 + 5]); w3 = pack2(p0[8 * s4 + 6], p0[8 * s4 + 7]); } \
            else { const int s2 = s4 - 2; w0 = pack2(p1[8 * s2 + 0], p1[8 * s2 + 1]); w1 = pack2(p1[8 * s2 + 2], p1[8 * s2 + 3]); w2 = pack2(p1[8 * s2 + 4], p1[8 * s2 + 5]); w3 = pack2(p1[8 * s2 + 6], p1[8 * s2 + 7]); } \
            ga::u32x4 pw = {w0, w1, w2, w3}; bf16x8 pa = *reinterpret_cast<bf16x8*>(&pw); \
            _Pragma("unroll") for (int db = 0; db < 2; ++db) { \
                const char* vp = Vb + (db * 32 + r32) * VROWB + (16 * s4 + 4 * hi) * 2; \
                uint2 lo = *(const uint2*)vp, hi2 = *(const uint2*)(vp + 16); \
                ga::u32x4 bw = {lo.x, lo.y, hi2.x, hi2.y}; bf16x8 vb = *reinterpret_cast<bf16x8*>(&bw); \
                o[db] = __builtin_amdgcn_mfma_f32_32x32x16_bf16(pa, vb, o[db], 0, 0, 0); } } \
    } while (0)
    TLOAD(0, rkA, rvA); TLOAD(1, rkB, rvB);
    TWRITE(0, rkA, rvA); __syncthreads();
    int t = 0;
    for (; t + 1 < ntiles; t += 2) {
        if (t + 2 < ntiles) TLOAD(t + 2, rkA, rvA);
        TILE_COMPUTE(t);
        TWRITE(1, rkB, rvB);
        __syncthreads();
        if (t + 3 < ntiles) TLOAD(t + 3, rkB, rvB);
        TILE_COMPUTE(t + 1);
        if (t + 2 < ntiles) TWRITE(0, rkA, rvA);
        __syncthreads();
    }
    if (t < ntiles) { TILE_COMPUTE(t); __syncthreads(); }
#undef TILE_COMPUTE
    if (hi == 0) li_l[r32] = l_reg;
    asm volatile("s_waitcnt lgkmcnt(0)" ::: "memory");
    bf16* Ow = QS + (size_t)qrow0 * 1024 + head * 64;
#pragma unroll
    for (int r = 0; r < 16; ++r) {
        const int orow = crow(r, hi); const float rl = 1.f / li_l[orow];
#pragma unroll
        for (int db = 0; db < 2; ++db) Ow[(size_t)orow * 1024 + db * 32 + r32] = f2bf(o[db][r] * rl);
    }
    __syncthreads();
#undef TLOAD
#undef TWRITE
}
}

__device__ __forceinline__ void swa_item(const Params& p, int l, int it, char* smem) {
    if (it < 1024) {
        const int pair = it & 7, j = it >> 3, b = pair >> 1, kvh = pair & 1;
        swa::body(p, l, b, kvh, b * SEQ + j * 32, j * 32, smem);
    } else {
        const int j = it - 1024, pair = j & 7, qb = j >> 3, b = pair >> 1, kvh = pair & 1;
        swa::body(p, l, b, kvh, TLAT + b * CTXL + qb * 32, -1, smem);
    }
}
__device__ __forceinline__ void phase_mixA(const Params& p, int l, char* smem) {
    const int ncg = (l == 0) ? 48 : 0;
    const int total = 256 + ncg + 16 * 34 * 2;
    for (int it = blockIdx.x; it < total; it += gridDim.x) {
        if (it < 256) ga_item(p, l, it, smem);
        else if (it < 256 + ncg) ctx_gate_item(p, it - 256, smem);
        else ret1_item(p, l, it - 256 - ncg, smem);
    }
}
__device__ __forceinline__ void phase_mixB(const Params& p, int l, char* smem) {
    const int n_r3 = 512 + (l == 0 ? 32 : 0), n_sw = 1024 + (l == 0 ? 64 : 0), n_gc = (l == 0 ? 32 : 0);
    const int total = 256 + n_r3 + n_sw + n_gc;
    for (int it = blockIdx.x; it < total; it += gridDim.x) {
        if (it < 256) ga_item(p, l, 256 + it, smem);
        else if (it < 256 + n_r3) ret3_item(p, l, it - 256, smem);
        else if (it < 256 + n_r3 + n_sw) swa_item(p, l, it - 256 - n_r3, smem);
        else ga_item(p, l, 512 + (it - 256 - n_r3 - n_sw), smem);
    }
}

#define XB_TMO      128
#define XB_XCNT(j)  (256  + 64 * (j))
#define XB_XSUB(j)  (1280 + 64 * (j))
#define XB_XGEN(j)  (2304 + 64 * (j))
#define XB_TOP      3328
#define XB_TOPGEN   3392
#define XCD_BAR_WORDS 3456
#define XB_SPIN_CAP (1u << 22)
#define LAS __attribute__((address_space(3)))
__device__ __forceinline__ unsigned xb_ld(unsigned* p)              { return __hip_atomic_load(p, __ATOMIC_RELAXED, __HIP_MEMORY_SCOPE_AGENT); }
__device__ __forceinline__ unsigned xb_add(unsigned* p, unsigned v) { return __hip_atomic_fetch_add(p, v, __ATOMIC_RELAXED, __HIP_MEMORY_SCOPE_AGENT); }
__device__ __forceinline__ unsigned xb_xcc_id() { return (unsigned)__builtin_amdgcn_s_getreg((3 << 11) | 20) & 0xFu; }
#define XB_SPIN(cond, bar) do { unsigned _sp = 0; while (cond) { __builtin_amdgcn_s_sleep(1); \
    if ((++_sp & 255u) == 0u) { if (xb_ld(&(bar)[XB_TMO])) break; if (_sp > XB_SPIN_CAP) { atomicAdd(&(bar)[XB_TMO], 1u); break; } } } } while (0)
struct XcdBarrier { unsigned* bar; unsigned x; volatile LAS unsigned* st; };
__device__ __forceinline__ XcdBarrier xcd_barrier_post(unsigned* bar, volatile LAS unsigned* st) {
    XcdBarrier b; b.bar = bar; b.x = xb_xcc_id(); b.st = st;
    if (threadIdx.x == 0) (void)xb_add(&bar[XB_XCNT(b.x)], 1u);
    return b;
}
__device__ __forceinline__ void xcd_barrier_complete(unsigned* bar, unsigned x, unsigned& nloc, unsigned& nx) {
    const unsigned G = gridDim.x * gridDim.y * gridDim.z;
    unsigned sum, cnt, mine, sp = 0u;
    for (;;) {
        sum = 0u; cnt = 0u; mine = 0u;
#pragma unroll
        for (unsigned j = 0; j < 16; ++j) { const unsigned c = xb_ld(&bar[XB_XCNT(j)]); sum += c; cnt += (c > 0u) ? 1u : 0u; mine = (j == x) ? c : mine; }
        if (sum == G) break;
        __builtin_amdgcn_s_sleep(1);
        if ((++sp & 255u) == 0u) { if (xb_ld(&bar[XB_TMO])) break; if (sp > XB_SPIN_CAP) { atomicAdd(&bar[XB_TMO], 1u); break; } }
    }
    nloc = mine > 0u ? mine : 1u; nx = cnt > 0u ? cnt : 1u;
}
__device__ __forceinline__ void xcd_barrier(const XcdBarrier& b) {
    asm volatile("s_waitcnt vmcnt(0)" ::: "memory");
    __syncthreads();
    if (threadIdx.x == 0) {
        unsigned* bar = b.bar;
        __builtin_amdgcn_s_waitcnt(0);
        unsigned nloc = b.st[0], nx = b.st[1];
        if (nloc == 0u) { xcd_barrier_complete(bar, b.x, nloc, nx); b.st[0] = nloc; b.st[1] = nx; }
        const unsigned old = xb_add(&bar[XB_XSUB(b.x)], 1u);
        const unsigned gen = old / nloc;
        if (old + 1u == (gen + 1u) * nloc) {
            __builtin_amdgcn_fence(__ATOMIC_RELEASE, "agent");
            asm volatile("s_waitcnt vmcnt(0)" ::: "memory");
            const unsigned og = xb_add(&bar[XB_TOP], 1u);
            const unsigned tg = og / nx;
            if (og + 1u == (tg + 1u) * nx) xb_add(&bar[XB_TOPGEN], 1u);
            else XB_SPIN(xb_ld(&bar[XB_TOPGEN]) == tg, bar);
            __builtin_amdgcn_fence(__ATOMIC_ACQUIRE, "agent");
            xb_add(&bar[XB_XGEN(b.x)], 1u);
            asm volatile("s_waitcnt vmcnt(0)" ::: "memory");
        } else {
            XB_SPIN(xb_ld(&bar[XB_XGEN(b.x)]) == gen, bar);
            __builtin_amdgcn_fence(__ATOMIC_ACQUIRE, "agent");
            asm volatile("s_waitcnt vmcnt(0)" ::: "memory");
        }
    }
    __syncthreads();
}

constexpr int PH_PER_LAYER = 11;
constexpr int NPHASE = 2 + 2 * PH_PER_LAYER;
constexpr int LDS_BYTES = pg8::STAGE_BYTES + 4096;

__device__ __forceinline__ void run_phase(const Params& p, int ph, char* smem) {
#ifndef PHASE_MASK
    if (ph == 0) { phase0(p, smem); return; }
    if (ph == NPHASE - 1) { phase_final(p); return; }
#else
    if (ph == 0 || ph == NPHASE - 1) return;
#endif
    const int l = (ph - 1) / PH_PER_LAYER, s = (ph - 1) % PH_PER_LAYER;
#ifdef PHASE_MASK
    if (!((PHASE_MASK >> s) & 1)) return;
#endif
    switch (s) {
        case 0: phase_norm1(p, l); break;
        case 1: phase_inproj(p, l, smem); break;
        case 2: phase_mixA(p, l, smem); break;
        case 3: phase_ret_scan(p, l); break;
        case 4: phase_mixB(p, l, smem); break;
        case 5: phase_gates(p, l, smem); break;
        case 6: phase_merge(p, l, smem); break;
        case 7: phase_outproj(p, l, smem); break;
        case 8: {
            phase_norm2(p, l, smem);
        } break;
        case 9: phase_moe1(p, l, smem); break;
        case 10: phase_moe2(p, l, smem); break;
    }
}

__global__ void __launch_bounds__(NT, 2) mega(Params p) {
    extern __shared__ __attribute__((aligned(16))) char smem[];
    cg::grid_group grid = cg::this_grid();
    volatile LAS unsigned* st = (volatile LAS unsigned*)(smem + LDS_BYTES);
    if (threadIdx.x < 4) st[threadIdx.x] = 0u;
    __syncthreads();
    XcdBarrier bar = xcd_barrier_post((unsigned*)(p.ws + OFF_BAR), st);
#ifdef PROBE_PH
    const unsigned long long t0_ = __builtin_amdgcn_s_memrealtime(); unsigned long long tk_ = 0;
#endif
    for (int ph = p.ph_lo; ph < p.ph_hi; ++ph) {
        run_phase(p, ph, smem);
        if (ph + 1 < p.ph_hi) {
            if (ph == p.ph_lo) grid.sync();
            else xcd_barrier(bar);
        }
#ifdef PROBE_PH
        if (ph == PROBE_PH) tk_ = __builtin_amdgcn_s_memrealtime() - t0_;
#endif
    }
#ifdef PROBE_A
    if (blockIdx.x == PROBE_BLK && threadIdx.x == 0) {
        const unsigned long long te = __builtin_amdgcn_s_memrealtime(); const unsigned long long w = g_probe_tk * 4;
        while (__builtin_amdgcn_s_memrealtime() - te < w) __builtin_amdgcn_s_sleep(8);
    }
#endif
#ifdef PROBE_PH
    if (blockIdx.x == 0 && threadIdx.x == 0) {
        const unsigned long long te = __builtin_amdgcn_s_memrealtime();
        while (__builtin_amdgcn_s_memrealtime() - te < tk_) __builtin_amdgcn_s_sleep(8);
    }
#endif
}

extern "C" void kernel_launch(void* const* d_in, const int* in_sizes, int n_in, void* d_out, int out_size, void* d_ws, size_t ws_size,
                              hipStream_t stream) {
    static int grid_blocks = 0;
    if (!grid_blocks) {
        int dev = 0, cus = 0, per_cu = 0;
        hipGetDevice(&dev);
        hipDeviceGetAttribute(&cus, hipDeviceAttributeMultiprocessorCount, dev);
        hipFuncSetAttribute((const void*)mega, hipFuncAttributeMaxDynamicSharedMemorySize, LDS_BYTES + 16);
        hipOccupancyMaxActiveBlocksPerMultiprocessor(&per_cu, (const void*)mega, NT, LDS_BYTES + 16);
        if (per_cu < 1) { fprintf(stderr, "occupancy query returned %d\n", per_cu); per_cu = 1; }
        if (per_cu > 1) per_cu = 1;
        grid_blocks = cus * per_cu; if (grid_blocks > MAXBLK) grid_blocks = MAXBLK;
        if (ws_size < WS_END) fprintf(stderr, "workspace too small: %zu < %zu\n", ws_size, (size_t)WS_END);
    }
    Params p{};
    const float** f = (const float**)&p;
    for (int i = 0; i < 23; ++i) f[i] = (const float*)d_in[i];
    p.out = (float*)d_out; p.ws = (unsigned char*)d_ws;
#if MULTI_LAUNCH
    for (int ph = 0; ph < NPHASE; ++ph) {
        p.ph_lo = ph; p.ph_hi = ph + 1;
        hipMemsetAsync((char*)d_ws + OFF_BAR, 0, 16384, stream);
        hipLaunchKernelGGL(mega, dim3(grid_blocks), dim3(NT), LDS_BYTES + 16, stream, p);
    }
#else
    p.ph_lo = 0; p.ph_hi = NPHASE;
    void* args[] = {&p};
    hipMemsetAsync((char*)d_ws + OFF_BAR, 0, 16384, stream);
    hipError_t e = hipLaunchCooperativeKernel((const void*)mega, dim3(grid_blocks), dim3(NT), args, LDS_BYTES + 16, stream);
    if (e != hipSuccess) fprintf(stderr, "cooperative launch failed: %s (grid %d)\n", hipGetErrorString(e), grid_blocks);
#endif
}
```

```cpp
#include <hip/hip_runtime.h>
#include <hip/hip_cooperative_groups.h>
#include <cstdio>
#include <cstdint>
namespace cg = cooperative_groups;

#ifndef MULTI_LAUNCH
#define MULTI_LAUNCH 0
#endif

typedef unsigned short bf16;
typedef __attribute__((ext_vector_type(8))) short bf16x8;
typedef __attribute__((ext_vector_type(16))) float f32x16;

constexpr int NT = 512;
constexpr int D = 1024, NB = 4, SEQ = 4096, CTXL = 256;
constexpr int TLAT = NB * SEQ, TCTX = NB * CTXL, TALL = TLAT + TCTX;
constexpr int DIN = 8960, DQKV = 5888;
constexpr int NEXP = 16, DEXP = 512;
constexpr float EPS = 1e-6f;

constexpr size_t OFF_CTL  = 0;
constexpr size_t OFF_BAR  = 4096;
constexpr size_t OFF_LTS  = 4096 + 16384;
constexpr size_t OFF_LW   = OFF_LTS + (size_t)16 * TALL * 4;
constexpr size_t OFF_MOD  = OFF_LW + (size_t)16 * TALL * 4;
constexpr size_t OFF_ROPE = OFF_MOD + (size_t)2 * 5 * 6144 * 4;
constexpr size_t OFF_DEC  = OFF_ROPE + 65536;
constexpr size_t OFF_CX   = OFF_DEC + 32768;
constexpr size_t OFF_H    = OFF_CX + (size_t)TCTX * D * 4;
constexpr size_t OFF_QR   = OFF_H + (size_t)TALL * 1024 * 2;
constexpr size_t OFF_KR   = OFF_QR + (size_t)TALL * 512 * 2;
constexpr size_t OFF_VR   = OFF_KR + (size_t)TALL * 512 * 2;
constexpr size_t OFF_UR   = OFF_VR + (size_t)TALL * 1024 * 2;
constexpr size_t OFF_QS   = OFF_UR + (size_t)TALL * 1024 * 2;
constexpr size_t OFF_KS   = OFF_QS + (size_t)TALL * 1024 * 2;
constexpr size_t OFF_VS   = OFF_KS + (size_t)TALL * 128 * 2;
constexpr size_t OFF_QA   = OFF_VS + (size_t)TALL * 128 * 2;
constexpr size_t OFF_KA   = OFF_QA + (size_t)TALL * 1024 * 2;
constexpr size_t OFF_VA   = OFF_KA + (size_t)TALL * 256 * 2;
constexpr size_t OFF_F    = OFF_VA + (size_t)TALL * 256 * 2;
constexpr size_t F_BYTES  = (size_t)71303168;
constexpr size_t OFF_WT   = OFF_F + F_BYTES;
constexpr int WR_G = 6656, WR_BR = 9728, WR_OUT = 12800, WT_ROWS = 13824;
constexpr size_t WT_LAYER = (size_t)WT_ROWS * 1024 * 2;
constexpr size_t OFF_KFT  = OFF_WT + WT_LAYER;
constexpr size_t OFF_KBT  = OFF_KFT + (size_t)16 * 128 * 4352 * 2;
constexpr size_t OFF_SM   = OFF_KBT + (size_t)16 * 128 * 4352 * 2;
constexpr int MAXBLK = 320;
constexpr size_t OFF_GC   = OFF_SM + (size_t)MAXBLK * 128 * 128 * 2;
constexpr size_t OFF_PC   = OFF_GC + (size_t)3 * 1024 * 1024 * 2;
constexpr size_t WS_END   = OFF_PC + (size_t)3 * 1024 * 1024 * 2;
constexpr int KEYS = 4352;
constexpr size_t OFF_Y    = OFF_QR;
constexpr size_t OFF_HB   = OFF_VR;
constexpr size_t OFF_YB   = OFF_QS;
constexpr size_t OFF_WGU  = OFF_F;
constexpr size_t OFF_WD   = OFF_F + (size_t)16 * 1024 * 1024 * 2;

struct Params {
    const float *x, *c, *ctx, *c_ctx, *w_mod, *b_mod, *g1, *g2, *w_in, *ret_logit, *sink, *gq, *gk,
                *w_br_ret, *w_br_swa, *w_br_ga, *w_out, *w_router, *b_router, *w_gate, *w_up, *w_down, *g_final;
    float* out;
    unsigned char* ws;
    int ph_lo, ph_hi;
};

__device__ __forceinline__ int otid() { int t = threadIdx.x; asm volatile("" : "+v"(t)); return t; }
__device__ __forceinline__ bf16 f2bf(float f) { unsigned u = __float_as_uint(f); u += 0x7fffu + ((u >> 16) & 1u); return (bf16)(u >> 16); }
__device__ __forceinline__ float bf2f(bf16 h) { return __uint_as_float(((unsigned)h) << 16); }
typedef float f32x2_t __attribute__((ext_vector_type(2)));
typedef __bf16 bf16x2_t __attribute__((ext_vector_type(2)));
__device__ __forceinline__ unsigned pack2(float a, float b) { f32x2_t v = {a, b}; bf16x2_t r = __builtin_convertvector(v, bf16x2_t); return __builtin_bit_cast(unsigned, r); }
__device__ __forceinline__ float lo2f(unsigned u) { return __uint_as_float(u << 16); }
__device__ __forceinline__ float hi2f(unsigned u) { return __uint_as_float(u & 0xffff0000u); }
__device__ __forceinline__ void unpack8(uint4 u, float (&f)[8]) {
    f[0] = lo2f(u.x); f[1] = hi2f(u.x); f[2] = lo2f(u.y); f[3] = hi2f(u.y); f[4] = lo2f(u.z); f[5] = hi2f(u.z); f[6] = lo2f(u.w); f[7] = hi2f(u.w);
}
__device__ __forceinline__ float shx(float v, int o, int lane) { return __int_as_float(__builtin_amdgcn_ds_bpermute((lane ^ o) << 2, __float_as_int(v))); }
__device__ __forceinline__ int shup(int v, int o, int lane) { return __builtin_amdgcn_ds_bpermute(((lane - o) & 63) << 2, v); }
__device__ __forceinline__ float wsum(float v, int lane) {
#pragma unroll
    for (int o = 32; o > 0; o >>= 1) v += shx(v, o, lane);
    return v;
}
__device__ __forceinline__ float wmax(float v, int lane) {
#pragma unroll
    for (int o = 32; o > 0; o >>= 1) v = fmaxf(v, shx(v, o, lane));
    return v;
}
__device__ __forceinline__ float fexp_(float x) { return __builtin_amdgcn_exp2f(x * 1.4426950408889634f); }
__device__ __forceinline__ float flogsig_(float x) { return -0.6931471805599453f * __builtin_amdgcn_logf(1.f + fexp_(-x)); }
__device__ __forceinline__ float sigmoidf_(float x) { return 1.f / (1.f + expf(-x)); }
__device__ __forceinline__ float siluf_(float x) { return x / (1.f + expf(-x)); }
__device__ __forceinline__ float fsilu_(float x) { return x * __builtin_amdgcn_rcpf(1.f + __builtin_amdgcn_exp2f(-1.4426950408889634f * x)); }

__device__ __forceinline__ void mod_item(const Params& p, int item, char* smem) {
    float* sc = (float*)smem;
    float* red = sc + 5 * 1024;
    const int tid = otid();
    for (int i = tid; i < 5 * 1024; i += NT) {
        int v = i >> 10, k = i & 1023;
        float xv = v < 4 ? p.c[v * 1024 + k] : p.c_ctx[k];
        sc[i] = siluf_(xv);
    }
    __syncthreads();
    const int l = item / 96, cgp = item % 96, cq = tid & 15, ks = tid >> 4;
    const float* w = p.w_mod + (size_t)l * 1024 * 6144 + cgp * 64 + cq * 4;
    float4 a0 = {0, 0, 0, 0}, a1 = a0, a2 = a0, a3 = a0, a4 = a0;
#pragma unroll 8
    for (int kk = 0; kk < 32; ++kk) {
        const int k = ks * 32 + kk;
        const float4 wv = *(const float4*)(w + (size_t)k * 6144);
        const float s0 = sc[k], s1 = sc[1024 + k], s2 = sc[2048 + k], s3 = sc[3072 + k], s4 = sc[4096 + k];
        a0.x += s0 * wv.x; a0.y += s0 * wv.y; a0.z += s0 * wv.z; a0.w += s0 * wv.w;
        a1.x += s1 * wv.x; a1.y += s1 * wv.y; a1.z += s1 * wv.z; a1.w += s1 * wv.w;
        a2.x += s2 * wv.x; a2.y += s2 * wv.y; a2.z += s2 * wv.z; a2.w += s2 * wv.w;
        a3.x += s3 * wv.x; a3.y += s3 * wv.y; a3.z += s3 * wv.z; a3.w += s3 * wv.w;
        a4.x += s4 * wv.x; a4.y += s4 * wv.y; a4.z += s4 * wv.z; a4.w += s4 * wv.w;
    }
    *(float4*)(red + (ks * 5 + 0) * 64 + cq * 4) = a0; *(float4*)(red + (ks * 5 + 1) * 64 + cq * 4) = a1; *(float4*)(red + (ks * 5 + 2) * 64 + cq * 4) = a2;
    *(float4*)(red + (ks * 5 + 3) * 64 + cq * 4) = a3; *(float4*)(red + (ks * 5 + 4) * 64 + cq * 4) = a4;
    __syncthreads();
    if (tid < 320) {
        int v = tid >> 6, c2 = tid & 63; float sum = 0;
        for (int k2 = 0; k2 < 32; ++k2) sum += red[(k2 * 5 + v) * 64 + c2];
        float* mod = (float*)(p.ws + OFF_MOD);
        mod[(size_t)(l * 5 + v) * 6144 + cgp * 64 + c2] = sum + p.b_mod[l * 6144 + cgp * 64 + c2];
    }
    __syncthreads();
}

__device__ __forceinline__ int inproj_col_normal(int unit, int p) {
    const int bj = p >> 7, w = p & 127;
    const int r128 = 128 * (w >> 6) + 64 * ((w >> 5) & 1) + 32 * bj + (w & 31);
    if (unit < 2) return 0 + 256 * unit + r128;
    if (unit < 4) return 512 + 256 * (unit - 2) + r128;
    if (unit < 8) return 2048 + 256 * (unit - 4) + p;
    if (unit < 12) return 3072 + 256 * (unit - 8) + 64 * (w >> 5) + 32 * ((w >> 4) & 1) + 16 * bj + (w & 15);
    if (unit == 12) return 4096 + 64 * ((w >> 5) & 1) + 32 * ((w >> 4) & 1) + 16 * bj + (w & 15);
    if (unit < 17) return 4352 + 256 * (unit - 13) + r128;
    if (unit == 17) return 5376 + r128;
    return 5632 + p;
}
__device__ __forceinline__ int inproj_col_swapped(int sidx, int r) {
    const int ai = r >> 7, w = r & 127;
    if (sidx < 4) return 1024 + 256 * sidx + r;
    if (sidx < 6) return 512 + 128 * (2 * (sidx - 4) + (w >> 6)) + 64 * ((w >> 5) & 1) + 32 * ai + (w & 31);
    return 4224 + (r & 127);
}

constexpr int CONV_NONMOE = 16 * (WT_ROWS / 256);
constexpr int CONV_MOE = 1024 + 512;
struct ConvTile { const float* s[4]; int ld; bf16* dst; int dld; };
__device__ __forceinline__ ConvTile conv_tile_nonmoe(const Params& p, int l, int it) {
    ConvTile t; const int lane64 = otid() & 63;
    const int kt = it & 15, rg = it >> 4;
    t.dst = (bf16*)(p.ws + OFF_WT) + (size_t)rg * 256 * 1024 + kt * 64; t.dld = 1024;
#pragma unroll
    for (int j = 0; j < 4; ++j) {
        const int R = rg * 256 + lane64 + 64 * j;
        const float* src; int ld, col;
        if (R < WR_G) { src = p.w_in + (size_t)l * 1024 * DIN; ld = DIN;
            if (R < 4864) col = inproj_col_normal(R >> 8, R & 255); else col = inproj_col_swapped((R - 4864) >> 8, (R - 4864) & 255); }
        else if (R < WR_BR) { src = p.w_in + (size_t)l * 1024 * DIN; ld = DIN; col = 5888 + (R - WR_G); }
        else if (R < WR_OUT) { const int br = (R - WR_BR) >> 10; src = (br == 0 ? p.w_br_ret : br == 1 ? p.w_br_swa : p.w_br_ga) + (size_t)l * 1024 * 1024; ld = 1024; col = (R - WR_BR) & 1023; }
        else { src = p.w_out + (size_t)l * 1024 * 1024; ld = 1024; col = R - WR_OUT; }
        t.s[j] = src + (size_t)kt * 64 * ld + col; t.ld = ld;
    }
    return t;
}
__device__ __forceinline__ ConvTile conv_tile_moe(const Params& p, int l, int it) {
    ConvTile t; const int lane64 = otid() & 63;
    if (it < 1024) {
        const int kt = it & 15, u = (it >> 4) & 3, e = it >> 6;
        t.dst = (bf16*)(p.ws + OFF_WGU) + ((size_t)e * 1024 + u * 256) * 1024 + kt * 64; t.dld = 1024; t.ld = 512;
#pragma unroll
        for (int j = 0; j < 4; ++j) {
            const float* src = (j < 2 ? p.w_gate : p.w_up) + ((size_t)(l * 16 + e) * 1024 + (size_t)kt * 64) * 512;
            t.s[j] = src + 128 * u + lane64 + 64 * (j & 1);
        }
    } else {
        const int i2 = it - 1024; const int kt = i2 & 7, g = (i2 >> 3) & 3, e = i2 >> 5;
        t.dst = (bf16*)(p.ws + OFF_WD) + ((size_t)e * 1024 + g * 256) * 512 + kt * 64; t.dld = 512; t.ld = 1024;
#pragma unroll
        for (int j = 0; j < 4; ++j) t.s[j] = p.w_down + ((size_t)(l * 16 + e) * 512 + (size_t)kt * 64) * 1024 + 256 * g + lane64 + 64 * j;
    }
    return t;
}
__device__ __forceinline__ void conv_run(const Params& p, int l, int which, char* smem, int b0 = 0) {
    const int tid = otid(), wave = tid >> 6, lane = tid & 63;
    const int ntiles = which ? CONV_MOE : CONV_NONMOE;
    unsigned* T = (unsigned*)smem;
    float va[4][8], vb[4][8];
    if ((int)blockIdx.x < b0) return;
    const int cstride = gridDim.x - b0;
    int it = blockIdx.x - b0;
    if (it >= ntiles) return;
    ConvTile ct = which ? conv_tile_moe(p, l, it) : conv_tile_nonmoe(p, l, it);
#define CONV_LOAD(dstv, tile) do { _Pragma("unroll") for (int j = 0; j < 4; ++j) _Pragma("unroll") for (int r = 0; r < 8; ++r) dstv[j][r] = (tile).s[j][(size_t)(wave * 8 + r) * (tile).ld]; } while (0)
    CONV_LOAD(va, ct);
    for (;;) {
        const int nit = it + cstride; const bool more = nit < ntiles;
        ConvTile nt = ct;
        if (more) { nt = which ? conv_tile_moe(p, l, nit) : conv_tile_nonmoe(p, l, nit); CONV_LOAD(vb, nt); }
#pragma unroll
        for (int j = 0; j < 4; ++j)
#pragma unroll
            for (int r = 0; r < 8; r += 2) T[(lane + 64 * j) * 33 + wave * 4 + (r >> 1)] = pack2(va[j][r], va[j][r + 1]);
        __syncthreads();
        {
            const int n = tid >> 1, half = tid & 1;
            const unsigned* row = T + n * 33 + half * 16;
            uint4 o0, o1, o2, o3;
            o0.x = row[0]; o0.y = row[1]; o0.z = row[2]; o0.w = row[3]; o1.x = row[4]; o1.y = row[5]; o1.z = row[6]; o1.w = row[7];
            o2.x = row[8]; o2.y = row[9]; o2.z = row[10]; o2.w = row[11]; o3.x = row[12]; o3.y = row[13]; o3.z = row[14]; o3.w = row[15];
            uint4* d = (uint4*)(ct.dst + (size_t)n * ct.dld + half * 32);
            d[0] = o0; d[1] = o1; d[2] = o2; d[3] = o3;
        }
        __syncthreads();
        if (!more) break;
        it = nit; ct = nt;
#pragma unroll
        for (int j = 0; j < 4; ++j)
#pragma unroll
            for (int r = 0; r < 8; ++r) va[j][r] = vb[j][r];
    }
#undef CONV_LOAD
}

__device__ __forceinline__ void phase0(const Params& p, char* smem) {
    const int tid = otid();
    if (blockIdx.x == 0) { int* ctl = (int*)(p.ws + OFF_CTL); if (tid < 64) ctl[tid] = 0; }
    {
        const int tb = gridDim.x > 192 ? 192 : 0;
        const int nb = (int)gridDim.x - tb, b0 = (int)blockIdx.x - tb;
        if (b0 >= 0) {
            const int g0 = b0 * NT + otid(); const int gs = nb * NT;
            float* rp = (float*)(p.ws + OFF_ROPE);
            for (int i = g0; i < 64 * 32; i += gs) {
                int pos = i >> 5, j = i & 31;
                float fr = exp2f(-(float)j * (13.287712379549449f / 32.f)); float a = (float)pos * fr;
                rp[i] = cosf(a); rp[2048 + i] = sinf(a);
            }
            for (int i = g0; i < 64 * 16; i += gs) {
                int pos = i >> 4, j = i & 15;
                float fr = exp2f(-(float)j * (13.287712379549449f / 16.f)); float a = (float)pos * fr;
                rp[4096 + i] = cosf(a); rp[4096 + 1024 + i] = sinf(a);
            }
            for (int i = g0; i < 64 * 32; i += gs) {
                int j = i >> 6, pos = i & 63;
                float fr = exp2f(-(float)j * (13.287712379549449f / 32.f)); float a = (float)pos * fr;
                rp[6144 + i] = cosf(a); rp[8192 + i] = sinf(a);
            }
            float* dec = (float*)(p.ws + OFF_DEC);
            if (g0 < 16) { const float x = p.ret_logit[g0]; dec[g0] = flogsig_(x); }
            if (b0 == 0 && tid < 64) {
#pragma unroll
                for (int l2 = 0; l2 < 2; ++l2) {
                    float mq = fmaxf(fabsf(p.gq[l2 * 128 + tid]), fabsf(p.gq[l2 * 128 + 64 + tid])), mk = fmaxf(fabsf(p.gk[l2 * 128 + tid]), fabsf(p.gk[l2 * 128 + 64 + tid]));
                    mq = wmax(mq, tid); mk = wmax(mk, tid);
                    if (tid == 0) dec[16 + l2] = 128.f * mq * mk;
                }
            }
            for (int i = g0; i < 2 * 4 * 128; i += gs) {
                const int j = i & 127, h = (i >> 7) & 3, l = i >> 9;
                const float lgf = flogsig_(p.ret_logit[l * 8 + h]), lgb = flogsig_(p.ret_logit[l * 8 + 4 + h]);
                float* d = dec + 64 + (size_t)((l * 4 + h) * 6) * 128;
                const float ks = 0.08838834764831845f;
                d[j] = ks * fexp_((float)(127 - j) * lgf); d[128 + j] = ks * fexp_((float)j * lgb);
                d[256 + j] = fexp_((float)(j + 1) * lgf); d[384 + j] = fexp_((float)(128 - j) * lgb);
                d[512 + j] = fexp_((float)j * lgf); d[640 + j] = fexp_((float)j * lgb);
            }
        }
    }
    for (int it = blockIdx.x; it < 192; it += gridDim.x) mod_item(p, it, smem);
    conv_run(p, 0, 0, smem);
}

struct RowIn { float4 x[4]; uint2 y0[4], y1[4]; };
__device__ __forceinline__ void norm1_load(const Params& p, int l, int r, int lane, RowIn& d) {
    const bool isctx = r >= TLAT;
    if (l == 0) {
        const float* xin = isctx ? p.ctx + (size_t)(r - TLAT) * D : p.x + (size_t)r * D;
#pragma unroll
        for (int j = 0; j < 4; ++j) d.x[j] = *(const float4*)(xin + j * 256 + lane * 4);
    } else {
        const float* xr = isctx ? (const float*)(p.ws + OFF_CX) + (size_t)(r - TLAT) * D : p.out + (size_t)r * D;
        const bf16* YB = (const bf16*)(p.ws + OFF_YB);
#pragma unroll
        for (int j = 0; j < 4; ++j) {
            const int col = j * 256 + lane * 4;
            d.x[j] = *(const float4*)(xr + col);
            d.y0[j] = *(const uint2*)(YB + (size_t)(r * 2) * D + col); d.y1[j] = *(const uint2*)(YB + (size_t)(r * 2 + 1) * D + col);
        }
    }
}
__device__ __forceinline__ void phase_norm1(const Params& p, int l) {
    const int tid = otid(), wave = tid >> 6, lane = tid & 63;
    const float* mod = (const float*)(p.ws + OFF_MOD);
    float* CX = (float*)(p.ws + OFF_CX);
    bf16* H = (bf16*)(p.ws + OFF_H);
    const int stride = gridDim.x * 8;
    int r = blockIdx.x * 8 + wave;
    RowIn cur, nxt;
    if (r < TALL) norm1_load(p, l, r, lane, cur);
    while (r < TALL) {
        const int rn = r + stride;
        if (rn < TALL) norm1_load(p, l, rn, lane, nxt);
        const bool isctx = r >= TLAT; const int v = isctx ? 4 : r / SEQ;
        float4 xv[4];
        if (l == 0) {
#pragma unroll
            for (int j = 0; j < 4; ++j) xv[j] = cur.x[j];
        } else {
            float* xr = isctx ? CX + (size_t)(r - TLAT) * D : p.out + (size_t)r * D;
            const float* gt2 = mod + (size_t)((l - 1) * 5 + v) * 6144 + 5 * 1024;
#pragma unroll
            for (int j = 0; j < 4; ++j) {
                const int col = j * 256 + lane * 4;
                float4 a = cur.x[j]; const float4 g = *(const float4*)(gt2 + col);
                const uint2 y0 = cur.y0[j], y1 = cur.y1[j];
                a.x += g.x * (lo2f(y0.x) + lo2f(y1.x)); a.y += g.y * (hi2f(y0.x) + hi2f(y1.x));
                a.z += g.z * (lo2f(y0.y) + lo2f(y1.y)); a.w += g.w * (hi2f(y0.y) + hi2f(y1.y));
                *(float4*)(xr + col) = a; xv[j] = a;
            }
        }
        float ss = 0;
#pragma unroll
        for (int j = 0; j < 4; ++j) ss += xv[j].x * xv[j].x + xv[j].y * xv[j].y + xv[j].z * xv[j].z + xv[j].w * xv[j].w;
        ss = wsum(ss, lane);
        const float rstd = rsqrtf(ss * (1.f / 1024.f) + EPS);
        const float* md = mod + (size_t)(l * 5 + v) * 6144;
#pragma unroll
        for (int j = 0; j < 4; ++j) {
            const int col = j * 256 + lane * 4;
            const float4 g = *(const float4*)(p.g1 + l * 1024 + col), sh = *(const float4*)(md + col), sc = *(const float4*)(md + 1024 + col);
            const float h0 = xv[j].x * rstd * g.x * (1.f + sc.x) + sh.x, h1 = xv[j].y * rstd * g.y * (1.f + sc.y) + sh.y;
            const float h2 = xv[j].z * rstd * g.z * (1.f + sc.z) + sh.z, h3 = xv[j].w * rstd * g.w * (1.f + sc.w) + sh.w;
            uint2 o; o.x = pack2(h0, h1); o.y = pack2(h2, h3);
            *(uint2*)(H + (size_t)r * D + col) = o;
        }
        cur = nxt; r = rn;
    }
}

__device__ __forceinline__ int kiter_max(int nrows, int g) { return (nrows + g * 8 - 1) / (g * 8); }
__device__ __forceinline__ void phase_norm2(const Params& p, int l, char* smem) {
    const int tid = otid(), wave = tid >> 6, lane = tid & 63;
    const float* mod = (const float*)(p.ws + OFF_MOD);
    const float* CX = (const float*)(p.ws + OFF_CX);
    bf16* H = (bf16*)(p.ws + OFF_H);
    int* cnt = (int*)(p.ws + OFF_CTL) + l * 16;
    int* lts = (int*)(p.ws + OFF_LTS);
    float* lw = (float*)(p.ws + OFF_LW);
    const int nrows = (l == 0) ? TALL : TLAT;
    int* lcnt = (int*)smem;
    int* rinfo = lcnt + 32;
    float* wrT = (float*)(smem + 4096);
    if (tid < 32) lcnt[tid] = 0;
    for (int i = tid; i < 16 * 1024; i += NT) { const int col = i >> 4, e = i & 15; wrT[e * 1024 + col] = p.w_router[i]; }
    __syncthreads();
    int kiter = 0;
    for (int r = blockIdx.x * 8 + wave; r < nrows; r += gridDim.x * 8, ++kiter) {
        const bool isctx = r >= TLAT; const int v = isctx ? 4 : r / SEQ;
        const float* xr = isctx ? CX + (size_t)(r - TLAT) * D : p.out + (size_t)r * D;
        float4 xv[4];
#pragma unroll
        for (int j = 0; j < 4; ++j) xv[j] = *(const float4*)(xr + j * 256 + lane * 4);
        float ss = 0;
#pragma unroll
        for (int j = 0; j < 4; ++j) ss += xv[j].x * xv[j].x + xv[j].y * xv[j].y + xv[j].z * xv[j].z + xv[j].w * xv[j].w;
        ss = wsum(ss, lane);
        const float rstd = rsqrtf(ss * (1.f / 1024.f) + EPS);
        const float* md = mod + (size_t)(l * 5 + v) * 6144;
        float part[16];
#pragma unroll
        for (int e = 0; e < 16; ++e) part[e] = 0.f;
#pragma unroll
        for (int j = 0; j < 4; ++j) {
            int col = j * 256 + lane * 4;
            float4 g = *(const float4*)(p.g2 + l * 1024 + col), sh = *(const float4*)(md + 3072 + col), sc = *(const float4*)(md + 4096 + col);
            float hv[4];
            hv[0] = xv[j].x * rstd * g.x * (1.f + sc.x) + sh.x; hv[1] = xv[j].y * rstd * g.y * (1.f + sc.y) + sh.y;
            hv[2] = xv[j].z * rstd * g.z * (1.f + sc.z) + sh.z; hv[3] = xv[j].w * rstd * g.w * (1.f + sc.w) + sh.w;
            uint2 o; o.x = pack2(hv[0], hv[1]); o.y = pack2(hv[2], hv[3]);
            *(uint2*)(H + (size_t)r * D + col) = o;
#pragma unroll
            for (int e = 0; e < 16; ++e) {
                const float4 w4 = *(const float4*)(wrT + e * 1024 + col);
                part[e] += hv[0] * w4.x + hv[1] * w4.y + hv[2] * w4.z + hv[3] * w4.w;
            }
        }
#pragma unroll
        for (int e = 0; e < 16; ++e) part[e] = wsum(part[e], lane);
        if (lane == 0) {
            float s[16], bb[16];
#pragma unroll
            for (int e = 0; e < 16; ++e) { s[e] = sigmoidf_(part[e]); bb[e] = s[e] + p.b_router[e]; }
            float bestscore = -1e30f; int be0 = 0, be1 = 1; float bs0 = 0.f, bs1 = 0.f;
#pragma unroll
            for (int g = 0; g < 4; ++g) {
                int i1 = 0; float m1 = bb[g * 4]; float s1 = s[g * 4];
#pragma unroll
                for (int i = 1; i < 4; ++i) if (bb[g * 4 + i] > m1) { m1 = bb[g * 4 + i]; i1 = i; s1 = s[g * 4 + i]; }
                int i2 = -1; float m2 = -1e30f; float s2 = 0.f;
#pragma unroll
                for (int i = 0; i < 4; ++i) if (i != i1 && bb[g * 4 + i] > m2) { m2 = bb[g * 4 + i]; i2 = i; s2 = s[g * 4 + i]; }
                float gs = m1 + m2;
                if (gs > bestscore) { bestscore = gs; be0 = g * 4 + i1; be1 = g * 4 + i2; bs0 = s1; bs1 = s2; }
            }
            float inv = 1.f / (bs0 + bs1);
            const int p0 = atomicAdd(&lcnt[be0], 1), p1 = atomicAdd(&lcnt[be1], 1);
            int* ri = rinfo + (kiter * 8 + wave) * 4;
            ri[0] = be0 | (be1 << 8); ri[1] = p0 | (p1 << 16); ri[2] = __float_as_int(bs0 * inv); ri[3] = __float_as_int(bs1 * inv);
        }
    }
    __syncthreads();
    if (tid < 16) lcnt[16 + tid] = atomicAdd(&cnt[tid], lcnt[tid]);
    __syncthreads();
    {
        const int nent = kiter_max(nrows, gridDim.x) * 16;
        for (int en = tid; en < nent; en += NT) {
            const int s2 = en & 1, w = (en >> 1) & 7, k = en >> 4;
            const int r = blockIdx.x * 8 + w + k * gridDim.x * 8;
            if (r < nrows) {
                const int* ri = rinfo + (k * 8 + w) * 4;
                const int e = (ri[0] >> (8 * s2)) & 255, pos = (ri[1] >> (16 * s2)) & 65535;
                const int gp = lcnt[16 + e] + pos;
                lts[(size_t)e * TALL + gp] = r * 2 + s2; lw[(size_t)e * TALL + gp] = __int_as_float(ri[2 + s2]);
            }
        }
    }
    __syncthreads();
}

__device__ __forceinline__ void phase_final(const Params& p) {
    const int tid = otid(), wave = tid >> 6, lane = tid & 63;
    const float* mod = (const float*)(p.ws + OFF_MOD);
    const int stride = gridDim.x * 8;
    int r = blockIdx.x * 8 + wave;
    RowIn cur, nxt;
    if (r < TLAT) norm1_load(p, 2, r, lane, cur);
    while (r < TLAT) {
        const int rn = r + stride;
        if (rn < TLAT) norm1_load(p, 2, rn, lane, nxt);
        const int v = r / SEQ;
        float* xr = p.out + (size_t)r * D;
        const float* gt2 = mod + (size_t)(1 * 5 + v) * 6144 + 5 * 1024;
        float4 xv[4];
#pragma unroll
        for (int j = 0; j < 4; ++j) {
            const int col = j * 256 + lane * 4;
            float4 a = cur.x[j]; const float4 g = *(const float4*)(gt2 + col);
            const uint2 y0 = cur.y0[j], y1 = cur.y1[j];
            a.x += g.x * (lo2f(y0.x) + lo2f(y1.x)); a.y += g.y * (hi2f(y0.x) + hi2f(y1.x));
            a.z += g.z * (lo2f(y0.y) + lo2f(y1.y)); a.w += g.w * (hi2f(y0.y) + hi2f(y1.y));
            xv[j] = a;
        }
        float ss = 0;
#pragma unroll
        for (int j = 0; j < 4; ++j) ss += xv[j].x * xv[j].x + xv[j].y * xv[j].y + xv[j].z * xv[j].z + xv[j].w * xv[j].w;
        ss = wsum(ss, lane);
        const float rstd = rsqrtf(ss * (1.f / 1024.f) + EPS);
#pragma unroll
        for (int j = 0; j < 4; ++j) {
            const int col = j * 256 + lane * 4;
            const float4 g = *(const float4*)(p.g_final + col);
            float4 o; o.x = xv[j].x * rstd * g.x; o.y = xv[j].y * rstd * g.y; o.z = xv[j].z * rstd * g.z; o.w = xv[j].w * rstd * g.w;
            *(float4*)(xr + col) = o;
        }
        cur = nxt; r = rn;
    }
}

constexpr int LDS_ROW = 144;
constexpr int A_STAGE = 256 * LDS_ROW;
constexpr int B_STAGE = 128 * LDS_ROW;
constexpr int STAGE = A_STAGE + B_STAGE;
constexpr int GEMM_LDS = 2 * STAGE;
constexpr int CT_LD = 132;

template <int MI>
__device__ __forceinline__ void zero_acc(f32x16 (&acc)[MI][2]) {
#pragma unroll
    for (int a = 0; a < MI; ++a)
#pragma unroll
        for (int b = 0; b < 2; ++b)
#pragma unroll
            for (int r = 0; r < 16; ++r) acc[a][b][r] = 0.f;
}

__device__ __forceinline__ uint4 scale8(uint4 u, float sc) {
    uint4 o;
    o.x = pack2(lo2f(u.x) * sc, hi2f(u.x) * sc); o.y = pack2(lo2f(u.y) * sc, hi2f(u.y) * sc);
    o.z = pack2(lo2f(u.z) * sc, hi2f(u.z) * sc); o.w = pack2(lo2f(u.w) * sc, hi2f(u.w) * sc);
    return o;
}
template <int MI, bool BS = false>
__device__ __forceinline__ void gemm_mainloop(f32x16 (&acc)[MI][2], const bf16* ap0, const bf16* ap1, const bf16* ap2, const bf16* ap3,
                                              const bf16* bp0, const bf16* bp1, int K, char* smem, float bs0 = 1.f, float bs1 = 1.f) {
    const int tid = otid(), lane = tid & 63, wave = tid >> 6, wm = wave >> 1, wn = wave & 1;
    const int kc = tid & 7, lr = tid >> 3;
    uint4 ra0, ra1, ra2, ra3, rb0, rb1;
    ra0 = *(const uint4*)(ap0 + kc * 8); ra1 = *(const uint4*)(ap1 + kc * 8);
    if (MI == 2) { ra2 = *(const uint4*)(ap2 + kc * 8); ra3 = *(const uint4*)(ap3 + kc * 8); }
    rb0 = *(const uint4*)(bp0 + kc * 8); rb1 = *(const uint4*)(bp1 + kc * 8);
    if (BS) { rb0 = scale8(rb0, bs0); rb1 = scale8(rb1, bs1); }
    {
        char* st = smem;
        *(uint4*)(st + (lr) * LDS_ROW + kc * 16) = ra0; *(uint4*)(st + (lr + 64) * LDS_ROW + kc * 16) = ra1;
        if (MI == 2) { *(uint4*)(st + (lr + 128) * LDS_ROW + kc * 16) = ra2; *(uint4*)(st + (lr + 192) * LDS_ROW + kc * 16) = ra3; }
        *(uint4*)(st + A_STAGE + (lr) * LDS_ROW + kc * 16) = rb0; *(uint4*)(st + A_STAGE + (lr + 64) * LDS_ROW + kc * 16) = rb1;
    }
    __syncthreads();
    const int nk = K >> 6;
    const int aoff = (wm * (32 * MI) + (lane & 31)) * LDS_ROW + (lane >> 5) * 16;
    const int boff = A_STAGE + (wn * 64 + (lane & 31)) * LDS_ROW + (lane >> 5) * 16;
    for (int kt = 0; kt < nk; ++kt) {
        char* cur = smem + (kt & 1) * STAGE;
        const bool more = (kt + 1 < nk);
        if (more) {
            const int ko = (kt + 1) * 64 + kc * 8;
            ra0 = *(const uint4*)(ap0 + ko); ra1 = *(const uint4*)(ap1 + ko);
            if (MI == 2) { ra2 = *(const uint4*)(ap2 + ko); ra3 = *(const uint4*)(ap3 + ko); }
            rb0 = *(const uint4*)(bp0 + ko); rb1 = *(const uint4*)(bp1 + ko);
        }
#pragma unroll
        for (int ks = 0; ks < 4; ++ks) {
            bf16x8 b0 = *(const bf16x8*)(cur + boff + ks * 32);
            bf16x8 b1 = *(const bf16x8*)(cur + boff + 32 * LDS_ROW + ks * 32);
#pragma unroll
            for (int mi = 0; mi < MI; ++mi) {
                bf16x8 a0 = *(const bf16x8*)(cur + aoff + mi * 32 * LDS_ROW + ks * 32);
                acc[mi][0] = __builtin_amdgcn_mfma_f32_32x32x16_bf16(a0, b0, acc[mi][0], 0, 0, 0);
                acc[mi][1] = __builtin_amdgcn_mfma_f32_32x32x16_bf16(a0, b1, acc[mi][1], 0, 0, 0);
            }
        }
        if (more) {
            if (BS) { rb0 = scale8(rb0, bs0); rb1 = scale8(rb1, bs1); }
            char* st = smem + ((kt + 1) & 1) * STAGE;
            *(uint4*)(st + (lr) * LDS_ROW + kc * 16) = ra0; *(uint4*)(st + (lr + 64) * LDS_ROW + kc * 16) = ra1;
            if (MI == 2) { *(uint4*)(st + (lr + 128) * LDS_ROW + kc * 16) = ra2; *(uint4*)(st + (lr + 192) * LDS_ROW + kc * 16) = ra3; }
            *(uint4*)(st + A_STAGE + (lr) * LDS_ROW + kc * 16) = rb0; *(uint4*)(st + A_STAGE + (lr + 64) * LDS_ROW + kc * 16) = rb1;
        }
        __syncthreads();
    }
}

__device__ __forceinline__ void stage_full(const f32x16 (&acc)[1][2], char* smem) {
    const int tid = otid(), lane = tid & 63, wave = tid >> 6, wm = wave >> 1, wn = wave & 1;
    float* Ct = (float*)smem;
#pragma unroll
    for (int ni = 0; ni < 2; ++ni)
#pragma unroll
        for (int r = 0; r < 16; ++r) {
            int row = wm * 32 + (r & 3) + 8 * (r >> 2) + 4 * (lane >> 5);
            int col = wn * 64 + ni * 32 + (lane & 31);
            Ct[row * CT_LD + col] = acc[0][ni][r];
        }
}

__device__ __forceinline__ void stage_half(const f32x16 (&acc)[2][2], int h, char* smem) {
    const int tid = otid(), lane = tid & 63, wave = tid >> 6, wm = wave >> 1, wn = wave & 1;
    float* Ct = (float*)smem;
    if ((wm >> 1) == h) {
#pragma unroll
        for (int mi = 0; mi < 2; ++mi)
#pragma unroll
            for (int ni = 0; ni < 2; ++ni)
#pragma unroll
                for (int r = 0; r < 16; ++r) {
                    int row = (wm & 1) * 64 + mi * 32 + (r & 3) + 8 * (r >> 2) + 4 * (lane >> 5);
                    int col = wn * 64 + ni * 32 + (lane & 31);
                    Ct[row * CT_LD + col] = acc[mi][ni][r];
                }
    }
}

__device__ __forceinline__ void store32_bf16(bf16* dst, const float (&v)[32]) {
#pragma unroll
    for (int i = 0; i < 4; ++i) {
        uint4 o; o.x = pack2(v[i * 8 + 0], v[i * 8 + 1]); o.y = pack2(v[i * 8 + 2], v[i * 8 + 3]);
        o.z = pack2(v[i * 8 + 4], v[i * 8 + 5]); o.w = pack2(v[i * 8 + 6], v[i * 8 + 7]);
        *(uint4*)(dst + i * 8) = o;
    }
}

__device__ __forceinline__ void epi_plain_bf16(const float* Ct, bf16* dst, int ld, int mrow0, int n0) {
    const int tid = otid(), r = tid >> 2, q = tid & 3;
    float v[32];
    const float* src = Ct + r * CT_LD + 32 * q;
#pragma unroll
    for (int j = 0; j < 32; ++j) v[j] = src[j];
    store32_bf16(dst + (size_t)(mrow0 + r) * ld + n0 + 32 * q, v);
}

__device__ __forceinline__ void epi_outproj(const Params& p, int l, const float* Ct, int mrow0, int n0) {
    const int tid = otid(), r = tid >> 2, q = tid & 3;
    const int row = mrow0 + r;
    const bool isctx = row >= TLAT; const int v = isctx ? 4 : row / SEQ;
    const float* gt = (const float*)(p.ws + OFF_MOD) + (size_t)(l * 5 + v) * 6144 + 2048 + n0 + 32 * q;
    float* CX = (float*)(p.ws + OFF_CX);
    const float* xin; float* xo;
    if (isctx) { xo = CX + (size_t)(row - TLAT) * D + n0 + 32 * q; xin = (l == 0) ? p.ctx + (size_t)(row - TLAT) * D + n0 + 32 * q : xo; }
    else { xo = p.out + (size_t)row * D + n0 + 32 * q; xin = (l == 0) ? p.x + (size_t)row * D + n0 + 32 * q : xo; }
    const float* src = Ct + r * CT_LD + 32 * q;
#pragma unroll
    for (int i = 0; i < 8; ++i) {
        float4 a = *(const float4*)(xin + i * 4); float4 g = *(const float4*)(gt + i * 4);
        a.x += g.x * src[i * 4 + 0]; a.y += g.y * src[i * 4 + 1]; a.z += g.z * src[i * 4 + 2]; a.w += g.w * src[i * 4 + 3];
        *(float4*)(xo + i * 4) = a;
    }
}

__device__ __forceinline__ float log_sigmoid_(float x) { return -log1pf(expf(-x)); }

namespace pg8 {
#define PG8_LAS __attribute__((address_space(3)))
typedef float f32x4 __attribute__((ext_vector_type(4)));
typedef unsigned u32x4 __attribute__((ext_vector_type(4)));
constexpr int BM = 256, BK = 64, HALF = 128, HTB = HALF * BK * 2, STAGE_BYTES = 8 * HTB, NXCD = 8, WGM = 8;
__device__ __forceinline__ int lds_byte(int r, int c) { const int st = (r >> 4) * 2 + (c >> 5), rr = r & 15, cc = c & 31, ob = rr * 64 + cc * 2; return st * 1024 + (ob ^ (((ob >> 9) & 1) << 5)); }
__device__ __forceinline__ void stage_rc(int b, int& R, int& C) { const int st = b / 1024, sb = b % 1024, swz = sb ^ (((sb >> 9) & 1) << 5); R = (st >> 1) * 16 + swz / 64; C = (st & 1) * 32 + (swz % 64) / 2; }
__device__ __forceinline__ int perm32(int rho) { const int n = rho >> 4, i = rho & 15; return 8 * (i >> 2) + 4 * n + (i & 3); }
__device__ __forceinline__ unsigned cvt_pk_bf16(float lo, float hi) { return pack2(lo, hi); }

struct Unit { const char* A; const char* B; int pm, pn, tag, x0, x1; };

__device__ __forceinline__ bool static_unit(int i, int G, int c, int nM, int nN, int& pm, int& pn) {
    const int nwg = nM * nN; const long L = (long)i * G + c; if (L >= nwg) return false;
    int wgid = (int)L; { const int q = nwg / NXCD, r = nwg % NXCD, xcd = wgid % NXCD, off = wgid / NXCD; wgid = (xcd < r ? xcd * (q + 1) : r * (q + 1) + (xcd - r) * q) + off; }
    const int nig = WGM * nN, gid = wgid / nig, fm = gid * WGM, gsz = (nM - fm) < WGM ? (nM - fm) : WGM;
    pm = fm + ((wgid % nig) % gsz); pn = (wgid % nig) / gsz; return true;
}

template <class Sched, class Epi>
__device__ __forceinline__ void gemm_stream(PG8_LAS unsigned char* lds, const int K, const Sched& S, const Epi& E) {
    const int tid = otid(), wid = __builtin_amdgcn_readfirstlane(tid >> 6), lane = tid & 63, wr = wid >> 2, wc = wid & 3, fr = lane & 15, fq = lane >> 4;
    const int nt = K / BK;
    int sR[2], sC[2];
    constexpr int NH = Sched::GATHER ? 2 : 1;
    unsigned voffA[NH][2], voffB[1][2], voffAn[NH][2];
#pragma unroll
    for (int i = 0; i < 2; ++i) { int R, C; stage_rc(tid * 16 + i * 8192, R, C); sR[i] = R; sC[i] = C; const int Rb = (R & ~31) + perm32(R & 31);
        voffB[0][i] = (unsigned)(Rb * K + C) * 2u;
#pragma unroll
        for (int h = 0; h < NH; ++h) { voffA[h][i] = (unsigned)((h * HALF + R) * K + C) * 2u; voffAn[h][i] = voffA[h][i]; } }
    const size_t kstep = (size_t)(BK * 2);
    const size_t hstepA = Sched::GATHER ? 0 : (size_t)HALF * K * 2, hstepB = (size_t)HALF * K * 2;
    const unsigned ldsw = (unsigned)wid * 1024u;
    const int aoff = lds_byte(wr * 64 + fr, fq * 8), boff = lds_byte(wc * 32 + fr, fq * 8);
#define PG8_SA(b, h) (((b) * 2 + (h)) * HTB)
#define PG8_SB(b, h) ((4 + (b) * 2 + (h)) * HTB)
#define PG8_STAGE(bufoff, gbase, voff) do { _Pragma("unroll") for (int _i = 0; _i < 2; ++_i) \
        __builtin_amdgcn_global_load_lds((const unsigned*)((const char*)(gbase) + (voff)[_i]), (PG8_LAS unsigned*)(lds + (bufoff) + ldsw + _i * 8192), 16, 0, 0); } while (0)
#define PG8_LDA(dst, b, h) do { _Pragma("unroll") for (int m = 0; m < 4; ++m) _Pragma("unroll") for (int k = 0; k < 2; ++k) dst[m][k] = *(const PG8_LAS bf16x8*)(lds + PG8_SA(b, h) + aoff + m * 2048 + k * 1024); } while (0)
#define PG8_LDB(dst, b, h) do { _Pragma("unroll") for (int n = 0; n < 2; ++n) _Pragma("unroll") for (int k = 0; k < 2; ++k) dst[n][k] = *(const PG8_LAS bf16x8*)(lds + PG8_SB(b, h) + boff + n * 2048 + k * 1024); } while (0)
#define PG8_MMA(ai, bj, At, Bt) do { __builtin_amdgcn_s_setprio(1); _Pragma("unroll") for (int m = 0; m < 4; ++m) _Pragma("unroll") for (int n = 0; n < 2; ++n) _Pragma("unroll") for (int k = 0; k < 2; ++k) \
        acc[ai][bj][m][n] = __builtin_amdgcn_mfma_f32_16x16x32_bf16(Bt[n][k], At[m][k], acc[ai][bj][m][n], 0, 0, 0); __builtin_amdgcn_s_setprio(0); } while (0)
#define PG8_WAIT_V(n) asm volatile("s_waitcnt vmcnt(" #n ")" ::: "memory")
#define PG8_WAIT_L(n) asm volatile("s_waitcnt lgkmcnt(" #n ")" ::: "memory")
#define PG8_BAR __builtin_amdgcn_s_barrier()
#define PG8_SCHED __builtin_amdgcn_sched_barrier(0)
#define PG8_GOFF(u, dst) do { if constexpr (Sched::GATHER) { _Pragma("unroll") for (int _h = 0; _h < 2; ++_h) _Pragma("unroll") for (int _i = 0; _i < 2; ++_i) \
        dst[_h][_i] = S.row_off(u, _h * HALF + sR[_i]) + (unsigned)sC[_i] * 2u; } } while (0)
    Unit cur, nxt; int ui = 0;
    if (!S.next(0, cur)) return;
    f32x4 acc[2][2][4][2];
#pragma unroll
    for (int a = 0; a < 2; ++a)
#pragma unroll
        for (int b = 0; b < 2; ++b)
#pragma unroll
            for (int m = 0; m < 4; ++m)
#pragma unroll
                for (int n = 0; n < 2; ++n) acc[a][b][m][n] = (f32x4){0.f, 0.f, 0.f, 0.f};
    bf16x8 At[4][2], B0[2][2], B1[2][2];
    const char* cA = cur.A; const char* cB = cur.B;
    PG8_GOFF(cur, voffA);
    PG8_STAGE(PG8_SB(0, 0), cB, voffB[0]); PG8_STAGE(PG8_SA(0, 0), cA, voffA[0]); PG8_STAGE(PG8_SB(0, 1), cB + hstepB, voffB[0]); PG8_STAGE(PG8_SA(0, 1), cA + hstepA, voffA[NH - 1]);
    if (wr == 1) PG8_BAR;
    PG8_WAIT_V(4); PG8_BAR;
    PG8_STAGE(PG8_SB(1, 0), cB + kstep, voffB[0]); PG8_STAGE(PG8_SA(1, 0), cA + kstep, voffA[0]); PG8_STAGE(PG8_SB(1, 1), cB + kstep + hstepB, voffB[0]);
    PG8_WAIT_V(6); PG8_BAR;
    for (;;) {
        const bool has_next = S.next(ui + 1, nxt);
        const char* nA = has_next ? nxt.A : cA; const char* nB = has_next ? nxt.B : cB;
        if constexpr (Sched::GATHER) { if (has_next) { PG8_GOFF(nxt, voffAn); } else {
#pragma unroll
            for (int _h = 0; _h < NH; ++_h)
#pragma unroll
                for (int _i = 0; _i < 2; ++_i) voffAn[_h][_i] = voffA[_h][_i]; } }
        for (int t = 0; t < nt; t += 2) {
            const bool last = (t == nt - 2);
            const char* a1 = cA + (size_t)(t + 1) * kstep;
            const char* a2 = last ? nA : cA + (size_t)(t + 2) * kstep; const char* b2 = last ? nB : cB + (size_t)(t + 2) * kstep;
            const char* a3 = a2 + kstep; const char* b3 = b2 + kstep;
            unsigned vA2[NH][2];
#pragma unroll
            for (int _h = 0; _h < NH; ++_h)
#pragma unroll
                for (int _i = 0; _i < 2; ++_i) vA2[_h][_i] = (Sched::GATHER && last) ? voffAn[_h][_i] : voffA[_h][_i];
            PG8_LDB(B0, 0, 0); PG8_SCHED; PG8_LDA(At, 0, 0); PG8_STAGE(PG8_SA(1, 1), a1 + hstepA, voffA[NH - 1]);
            PG8_WAIT_L(8); PG8_BAR; PG8_WAIT_L(0); PG8_MMA(0, 0, At, B0); PG8_BAR; PG8_SCHED;
            PG8_LDB(B1, 0, 1); PG8_STAGE(PG8_SB(0, 0), b2, voffB[0]);
            PG8_BAR; PG8_WAIT_L(0); PG8_MMA(0, 1, At, B1); PG8_BAR;
            PG8_LDA(At, 0, 1); PG8_STAGE(PG8_SA(0, 0), a2, vA2[0]);
            PG8_BAR; PG8_WAIT_L(0); PG8_MMA(1, 0, At, B0); PG8_BAR; PG8_SCHED;
            PG8_STAGE(PG8_SB(0, 1), b2 + hstepB, voffB[0]);
            PG8_WAIT_V(6); PG8_BAR; PG8_MMA(1, 1, At, B1); PG8_BAR;
            PG8_LDB(B0, 1, 0); PG8_SCHED; PG8_LDA(At, 1, 0); PG8_STAGE(PG8_SA(0, 1), a2 + hstepA, vA2[NH - 1]);
            PG8_WAIT_L(8); PG8_BAR; PG8_WAIT_L(0); PG8_MMA(0, 0, At, B0); PG8_BAR; PG8_SCHED;
            PG8_LDB(B1, 1, 1); PG8_STAGE(PG8_SB(1, 0), b3, voffB[0]);
            PG8_BAR; PG8_WAIT_L(0); PG8_MMA(0, 1, At, B1); PG8_BAR;
            PG8_LDA(At, 1, 1); PG8_STAGE(PG8_SA(1, 0), a3, vA2[0]);
            PG8_BAR; PG8_WAIT_L(0); PG8_MMA(1, 0, At, B0); PG8_BAR; PG8_SCHED;
            PG8_STAGE(PG8_SB(1, 1), b3 + hstepB, voffB[0]);
            PG8_WAIT_V(6); PG8_BAR; PG8_MMA(1, 1, At, B1); PG8_BAR;
        }
        E(acc, cur, wr, wc, fr, fq);
        if (!has_next) break;
#pragma unroll
        for (int a = 0; a < 2; ++a)
#pragma unroll
            for (int b = 0; b < 2; ++b)
#pragma unroll
                for (int m = 0; m < 4; ++m)
#pragma unroll
                    for (int n = 0; n < 2; ++n) acc[a][b][m][n] = (f32x4){0.f, 0.f, 0.f, 0.f};
        cur = nxt; cA = nA; cB = nB; ++ui;
        if constexpr (Sched::GATHER) {
#pragma unroll
            for (int _h = 0; _h < NH; ++_h)
#pragma unroll
                for (int _i = 0; _i < 2; ++_i) voffA[_h][_i] = voffAn[_h][_i]; }
    }
    PG8_WAIT_V(0);
    if (wr == 0) PG8_BAR;
    PG8_BAR;
#undef PG8_SA
#undef PG8_SB
#undef PG8_STAGE
#undef PG8_LDA
#undef PG8_LDB
#undef PG8_MMA
#undef PG8_WAIT_V
#undef PG8_WAIT_L
#undef PG8_BAR
#undef PG8_SCHED
#undef PG8_GOFF
}
}

struct InprojSched {
    static constexpr bool GATHER = false;
    const char* H; const char* W; int G, c;
    __device__ __forceinline__ bool next(int i, pg8::Unit& u) const {
        int pm, pn;
        if (!pg8::static_unit(i, G, c, TALL / 256, 26, pm, pn)) return false;
        u.pm = pm; u.pn = pn; u.tag = 0;
        const char* hp = H + (size_t)pm * 256 * 2048; const char* wp = W + (size_t)pn * 256 * 2048;
        if (pn < 19) { u.A = hp; u.B = wp; } else { u.A = wp; u.B = hp; }
        return true;
    }
};

struct InprojEpi {
    unsigned char* ws_; const float* gq_; const float* gk_; float* red_;
    typedef pg8::f32x4 f32x4;

    __device__ __forceinline__ static void st8(bf16* d, const float (&o)[8]) {
        pg8::u32x4 w; w.x = pg8::cvt_pk_bf16(o[0], o[1]); w.y = pg8::cvt_pk_bf16(o[2], o[3]); w.z = pg8::cvt_pk_bf16(o[4], o[5]); w.w = pg8::cvt_pk_bf16(o[6], o[7]);
        *(pg8::u32x4*)d = w;
    }
    template <bool NORM>
    __device__ __forceinline__ void rope128(unsigned char* ws, float* red, const f32x4 (&acc)[2][2][4][2], bf16* dst, int ld, int colbase, float scale, const float* gain,
                                            int pm, int wr, int wc, int fr, int fq) const {
        const bool isctx = pm >= 64;
        const int a = wc & 1, i0 = 8 * fq;
        const float* rp = (const float*)(ws + OFF_ROPE);
        bf16* d0 = dst + colbase + (wc >> 1) * 128 + 64 * a + i0;
        float g1[8], g2[8];
        if (NORM) {
#pragma unroll
            for (int j = 0; j < 8; ++j) { g1[j] = gain[64 * a + i0 + j] * scale; g2[j] = gain[64 * a + 32 + i0 + j] * scale; }
#pragma unroll
            for (int ai = 0; ai < 2; ++ai)
#pragma unroll
                for (int m = 0; m < 4; ++m) {
                    float ss = 0.f;
#pragma unroll
                    for (int bj = 0; bj < 2; ++bj)
#pragma unroll
                        for (int n = 0; n < 2; ++n)
#pragma unroll
                            for (int j = 0; j < 4; ++j) ss += acc[ai][bj][m][n][j] * acc[ai][bj][m][n][j];
                    { const int ln = fr + 16 * fq; ss += shx(ss, 16, ln); ss += shx(ss, 32, ln); }
                    if (fq == 0) red[(128 * ai + 64 * wr + 16 * m + fr) * 4 + wc] = ss;
                }
            asm volatile("s_waitcnt lgkmcnt(0)" ::: "memory");
            __builtin_amdgcn_s_barrier();
        }
        constexpr int RB = 1;
#pragma unroll
        for (int aim = 0; aim < 8 / RB; ++aim) {
            const int ai = aim / (4 / RB), mh = aim % (4 / RB);
            float4 tc[4][2], tsn[4][2];
            {
#pragma unroll
                for (int m = RB * mh; m < RB * mh + RB; ++m) {
                    const int t = (256 * pm + 128 * ai + 64 * wr + 16 * m + fr) & (SEQ - 1); const int pos = a ? (t & 63) : (t >> 6);
                    tc[m][0] = *(const float4*)(rp + pos * 32 + i0); tc[m][1] = *(const float4*)(rp + pos * 32 + i0 + 4);
                    tsn[m][0] = *(const float4*)(rp + 2048 + pos * 32 + i0); tsn[m][1] = *(const float4*)(rp + 2048 + pos * 32 + i0 + 4);
                }
            }
#pragma unroll
            for (int m = RB * mh; m < RB * mh + RB; ++m) {
                const int rl = 128 * ai + 64 * wr + 16 * m + fr;
                const int row = 256 * pm + rl;
                float x1[8], x2[8];
#pragma unroll
                for (int n = 0; n < 2; ++n)
#pragma unroll
                    for (int j = 0; j < 4; ++j) { x1[n * 4 + j] = acc[ai][0][m][n][j]; x2[n * 4 + j] = acc[ai][1][m][n][j]; }
                if (NORM) {
                    const float rstd = rsqrtf((red[rl * 4 + wc] + red[rl * 4 + (wc ^ 1)]) * (1.f / 128.f) + EPS);
#pragma unroll
                    for (int j = 0; j < 8; ++j) { x1[j] *= rstd * g1[j]; x2[j] *= rstd * g2[j]; }
                } else {
#pragma unroll
                    for (int j = 0; j < 8; ++j) { x1[j] *= scale; x2[j] *= scale; }
                }
                float o1[8], o2[8];
                if (!isctx) {
                    const float4 c0 = tc[m][0], c1 = tc[m][1], s0 = tsn[m][0], s1 = tsn[m][1];
                    const float cs[8] = {c0.x, c0.y, c0.z, c0.w, c1.x, c1.y, c1.z, c1.w}, sn[8] = {s0.x, s0.y, s0.z, s0.w, s1.x, s1.y, s1.z, s1.w};
#pragma unroll
                    for (int j = 0; j < 8; ++j) { o1[j] = x1[j] * cs[j] - x2[j] * sn[j]; o2[j] = x1[j] * sn[j] + x2[j] * cs[j]; }
                } else {
#pragma unroll
                    for (int j = 0; j < 8; ++j) { o1[j] = x1[j]; o2[j] = x2[j]; }
                }
                st8(d0 + (size_t)row * ld, o1); st8(d0 + (size_t)row * ld + 32, o2);
            }
            __builtin_amdgcn_sched_barrier(0);
        }
    }
    __device__ __forceinline__ void rope64(unsigned char* ws, const f32x4 (&acc)[2][2][4][2], bf16* dst, int ld, int colbase, float scale, int nheads,
                                           int pm, int wr, int wc, int fr, int fq) const {
        if (wc >= nheads) return;
        const bool isctx = pm >= 64;
        const int a = fq >> 1, i0 = 8 * (fq & 1);
        const float* rp = (const float*)(ws + OFF_ROPE) + 4096;
        bf16* d0 = dst + colbase + 64 * wc + 32 * a + i0;
#pragma unroll
        for (int aim = 0; aim < 4; ++aim) {
            const int ai = aim >> 1, mh = aim & 1;
            float4 tc[4][2], tsn[4][2];
            {
#pragma unroll
                for (int m = 2 * mh; m < 2 * mh + 2; ++m) {
                    const int t = (256 * pm + 128 * ai + 64 * wr + 16 * m + fr) & (SEQ - 1); const int pos = a ? (t & 63) : (t >> 6);
                    tc[m][0] = *(const float4*)(rp + pos * 16 + i0); tc[m][1] = *(const float4*)(rp + pos * 16 + i0 + 4);
                    tsn[m][0] = *(const float4*)(rp + 1024 + pos * 16 + i0); tsn[m][1] = *(const float4*)(rp + 1024 + pos * 16 + i0 + 4);
                }
            }
#pragma unroll
            for (int m = 2 * mh; m < 2 * mh + 2; ++m) {
                const int row = 256 * pm + 128 * ai + 64 * wr + 16 * m + fr;
                float x1[8], x2[8], o1[8], o2[8];
#pragma unroll
                for (int n = 0; n < 2; ++n)
#pragma unroll
                    for (int j = 0; j < 4; ++j) { x1[n * 4 + j] = acc[ai][0][m][n][j] * scale; x2[n * 4 + j] = acc[ai][1][m][n][j] * scale; }
                if (!isctx) {
                    const float4 c0 = tc[m][0], c1 = tc[m][1], s0 = tsn[m][0], s1 = tsn[m][1];
                    const float cs[8] = {c0.x, c0.y, c0.z, c0.w, c1.x, c1.y, c1.z, c1.w}, sn[8] = {s0.x, s0.y, s0.z, s0.w, s1.x, s1.y, s1.z, s1.w};
#pragma unroll
                    for (int j = 0; j < 8; ++j) { o1[j] = x1[j] * cs[j] - x2[j] * sn[j]; o2[j] = x1[j] * sn[j] + x2[j] * cs[j]; }
                } else {
#pragma unroll
                    for (int j = 0; j < 8; ++j) { o1[j] = x1[j]; o2[j] = x2[j]; }
                }
                st8(d0 + (size_t)row * ld, o1); st8(d0 + (size_t)row * ld + 16, o2);
            }
            __builtin_amdgcn_sched_barrier(0);
        }
    }
    __device__ __forceinline__ void plain(const f32x4 (&acc)[2][2][4][2], bf16* dst, int ld, int colbase, int pm, int wr, int wc, int fr, int fq) const {
#pragma unroll
        for (int ai = 0; ai < 2; ++ai)
#pragma unroll
            for (int m = 0; m < 4; ++m) {
                const int row = 256 * pm + 128 * ai + 64 * wr + 16 * m + fr;
#pragma unroll
                for (int bj = 0; bj < 2; ++bj) {
                    float o[8];
#pragma unroll
                    for (int n = 0; n < 2; ++n)
#pragma unroll
                        for (int j = 0; j < 4; ++j) o[n * 4 + j] = acc[ai][bj][m][n][j];
                    st8(dst + (size_t)row * ld + colbase + 128 * bj + 32 * wc + 8 * fq, o);
                }
            }
    }
    __device__ __forceinline__ void swapped(unsigned char* ws, const f32x4 (&acc)[2][2][4][2], int sidx, int l, int pm, int wr, int wc, int fr, int fq) const {
        const bool isctx = pm >= 64;
        const int b = isctx ? pm - 64 : pm >> 4;
        const int key0 = isctx ? 4096 : (pm & 15) * 256;
        const int tk0 = 32 * wc + 8 * fq;
        if (sidx < 4 || sidx == 6) {
            const int nai = sidx == 6 ? 1 : 2;
            bf16* base = sidx == 6 ? (bf16*)(ws + OFF_VS) + (size_t)(b * 2) * 64 * KEYS : (bf16*)(ws + OFF_VR) + (size_t)(b * 4 + sidx) * 256 * KEYS;
#pragma unroll
            for (int ai = 0; ai < 2; ++ai) {
                if (ai < nai) {
#pragma unroll
                    for (int m = 0; m < 4; ++m) {
                        const int e = 128 * ai + 64 * wr + 16 * m + fr;
#pragma unroll
                        for (int bj = 0; bj < 2; ++bj) {
                            float o[8];
#pragma unroll
                            for (int n = 0; n < 2; ++n)
#pragma unroll
                                for (int j = 0; j < 4; ++j) o[n * 4 + j] = acc[ai][bj][m][n][j];
                            st8(base + (size_t)e * KEYS + key0 + 128 * bj + tk0, o);
                        }
                    }
                }
            }
        } else {
            const int h = 2 * (sidx - 4) + wr;
            const float* rp = (const float*)(ws + OFF_ROPE);
            const float* dec = (const float*)(ws + OFF_DEC) + 64 + (size_t)((l * 4 + h) * 6) * 128;
            float df[8], db[8];
            { const float4 a0 = *(const float4*)(dec + tk0), a1 = *(const float4*)(dec + tk0 + 4), b0 = *(const float4*)(dec + 128 + tk0), b1 = *(const float4*)(dec + 128 + tk0 + 4);
              df[0] = a0.x; df[1] = a0.y; df[2] = a0.z; df[3] = a0.w; df[4] = a1.x; df[5] = a1.y; df[6] = a1.z; df[7] = a1.w;
              db[0] = b0.x; db[1] = b0.y; db[2] = b0.z; db[3] = b0.w; db[4] = b1.x; db[5] = b1.y; db[6] = b1.z; db[7] = b1.w; }
            bf16* kf = (bf16*)(ws + OFF_KFT) + (size_t)(b * 4 + h) * 128 * KEYS;
            bf16* kb = (bf16*)(ws + OFF_KBT) + (size_t)(b * 4 + h) * 128 * KEYS;
#pragma unroll
            for (int m = 0; m < 4; ++m) {
                const int a = m >> 1, i = 16 * (m & 1) + fr;
                const int d1 = 64 * a + i, d2 = d1 + 32;
#pragma unroll
                for (int bj = 0; bj < 2; ++bj) {
                    const int tok0 = key0 + 128 * bj + tk0;
                    float cs[8], sn[8];
                    if (!isctx) {
                        if (a == 0) {
                            const float c = rp[(tok0 >> 6) * 32 + i], sv = rp[2048 + (tok0 >> 6) * 32 + i];
#pragma unroll
                            for (int j = 0; j < 8; ++j) { cs[j] = c; sn[j] = sv; }
                        } else {
                            const float* ct = rp + 6144 + i * 64 + (tok0 & 63); const float* stt = rp + 8192 + i * 64 + (tok0 & 63);
                            const float4 c0 = *(const float4*)ct, c1 = *(const float4*)(ct + 4), s0 = *(const float4*)stt, s1 = *(const float4*)(stt + 4);
                            cs[0] = c0.x; cs[1] = c0.y; cs[2] = c0.z; cs[3] = c0.w; cs[4] = c1.x; cs[5] = c1.y; cs[6] = c1.z; cs[7] = c1.w;
                            sn[0] = s0.x; sn[1] = s0.y; sn[2] = s0.z; sn[3] = s0.w; sn[4] = s1.x; sn[5] = s1.y; sn[6] = s1.z; sn[7] = s1.w;
                        }
                    } else {
#pragma unroll
                        for (int j = 0; j < 8; ++j) { cs[j] = 1.f; sn[j] = 0.f; }
                    }
                    float o1[8], o2[8];
#pragma unroll
                    for (int n = 0; n < 2; ++n)
#pragma unroll
                        for (int j = 0; j < 4; ++j) {
                            const int jj = n * 4 + j;
                            const float x1 = acc[0][bj][m][n][j], x2 = acc[1][bj][m][n][j];
                            o1[jj] = x1 * cs[jj] - x2 * sn[jj]; o2[jj] = x1 * sn[jj] + x2 * cs[jj];
                        }
                    float v[8];
#pragma unroll
                    for (int j = 0; j < 8; ++j) v[j] = o1[j] * df[j];
                    st8(kf + (size_t)d1 * KEYS + tok0, v);
#pragma unroll
                    for (int j = 0; j < 8; ++j) v[j] = o2[j] * df[j];
                    st8(kf + (size_t)d2 * KEYS + tok0, v);
#pragma unroll
                    for (int j = 0; j < 8; ++j) v[j] = o1[j] * db[j];
                    st8(kb + (size_t)d1 * KEYS + tok0, v);
#pragma unroll
                    for (int j = 0; j < 8; ++j) v[j] = o2[j] * db[j];
                    st8(kb + (size_t)d2 * KEYS + tok0, v);
                    __builtin_amdgcn_sched_barrier(0);
                }
            }
        }
    }
    int l;
    __device__ __forceinline__ void operator()(const f32x4 (&acc)[2][2][4][2], const pg8::Unit& u, int wr, int wc, int fr0, int fq0) const {
        unsigned char* ws = ws_; float* red = red_; const float* gq = gq_; const float* gk = gk_;
        asm volatile("" : "+s"(ws), "+s"(gq), "+s"(gk));
        int fr = fr0, fq = fq0; asm volatile("" : "+v"(fr), "+v"(fq));
        const int pn = u.pn, pm = u.pm;
        if (pn < 2)        rope128<false>(ws, red, acc, (bf16*)(ws + OFF_QR), 512, 256 * pn, 1.f, nullptr, pm, wr, wc, fr, fq);
        else if (pn < 4)   rope128<false>(ws, red, acc, (bf16*)(ws + OFF_KR), 512, 256 * (pn - 2), 0.08838834764831845f, nullptr, pm, wr, wc, fr, fq);
        else if (pn < 8)   plain(acc, (bf16*)(ws + OFF_UR), 1024, 256 * (pn - 4), pm, wr, wc, fr, fq);
        else if (pn < 12)  rope64(ws, acc, (bf16*)(ws + OFF_QS), 1024, 256 * (pn - 8), 0.125f, 4, pm, wr, wc, fr, fq);
        else if (pn == 12) rope64(ws, acc, (bf16*)(ws + OFF_KS), 128, 0, 1.f, 2, pm, wr, wc, fr, fq);
        else if (pn < 17)  rope128<true>(ws, red, acc, (bf16*)(ws + OFF_QA), 1024, 256 * (pn - 13), 1.f, gq, pm, wr, wc, fr, fq);
        else if (pn == 17) rope128<true>(ws, red, acc, (bf16*)(ws + OFF_KA), 256, 0, 1.f, gk, pm, wr, wc, fr, fq);
        else if (pn == 18) plain(acc, (bf16*)(ws + OFF_VA), 256, 0, pm, wr, wc, fr, fq);
        else swapped(ws, acc, pn - 19, l, pm, wr, wc, fr, fq);
    }
};

__device__ __forceinline__ void phase_inproj(const Params& p, int l, char* smem) {
    InprojSched S; S.H = (const char*)(p.ws + OFF_H); S.W = (const char*)(p.ws + OFF_WT); S.G = gridDim.x; S.c = blockIdx.x;
    InprojEpi E; E.ws_ = p.ws; E.gq_ = p.gq + l * 128; E.gk_ = p.gk + l * 128; E.red_ = (float*)(smem + pg8::STAGE_BYTES); E.l = l;
    pg8::gemm_stream<InprojSched, InprojEpi>((PG8_LAS unsigned char*)smem, 1024, S, E);
    __syncthreads();
}


struct OutSched {
    static constexpr bool GATHER = false;
    const char* Y; const char* W; int G, c, nM;
    __device__ __forceinline__ bool next(int i, pg8::Unit& u) const {
        int pm, pn;
        if (!pg8::static_unit(i, G, c, nM, 4, pm, pn)) return false;
        u.pm = pm; u.pn = pn; u.tag = 0; u.A = Y + (size_t)pm * 256 * 2048; u.B = W + (size_t)pn * 256 * 2048;
        return true;
    }
};
struct OutEpi {
    unsigned char* ws_; const float* xin_; const float* cin_; float* out_; int l;
    typedef pg8::f32x4 f32x4;
    __device__ __forceinline__ void operator()(const f32x4 (&acc)[2][2][4][2], const pg8::Unit& u, int wr, int wc, int fr0, int fq0) const {
        unsigned char* ws = ws_; const float* xin = xin_; const float* cin = cin_; float* out = out_;
        asm volatile("" : "+s"(ws), "+s"(xin), "+s"(cin), "+s"(out));
        int fr = fr0, fq = fq0; asm volatile("" : "+v"(fr), "+v"(fq));
        const int pm = u.pm, pn = u.pn;
        const bool isctx = pm >= 64;
        const int v = isctx ? 4 : pm >> 4;
        const int col0 = 256 * pn + 32 * wc + 8 * fq;
        const float* gt = (const float*)(ws + OFF_MOD) + (size_t)(l * 5 + v) * 6144 + 2048 + col0;
        float4 g[2][2];
#pragma unroll
        for (int bj = 0; bj < 2; ++bj)
#pragma unroll
            for (int n = 0; n < 2; ++n) g[bj][n] = *(const float4*)(gt + 128 * bj + 4 * n);
        float* CX = (float*)(ws + OFF_CX);
        const int row0 = 256 * pm + 64 * wr + fr;
        const float* xi; float* xo;
        if (isctx) { xo = CX + (size_t)(row0 - TLAT) * D + col0; xi = (l == 0) ? cin + (size_t)(row0 - TLAT) * D + col0 : xo; }
        else { xo = out + (size_t)row0 * D + col0; xi = (l == 0) ? xin + (size_t)row0 * D + col0 : xo; }
#pragma unroll
        for (int ai = 0; ai < 2; ++ai) {
            float4 a[4][2][2];
#pragma unroll
            for (int m = 0; m < 4; ++m)
#pragma unroll
                for (int bj = 0; bj < 2; ++bj)
#pragma unroll
                    for (int n = 0; n < 2; ++n) a[m][bj][n] = *(const float4*)(xi + (size_t)(128 * ai + 16 * m) * D + 128 * bj + 4 * n);
#pragma unroll
            for (int m = 0; m < 4; ++m)
#pragma unroll
                for (int bj = 0; bj < 2; ++bj)
#pragma unroll
                    for (int n = 0; n < 2; ++n) {
                        float4 o; const float4 aa = a[m][bj][n], gg = g[bj][n];
                        o.x = aa.x + gg.x * acc[ai][bj][m][n][0]; o.y = aa.y + gg.y * acc[ai][bj][m][n][1];
                        o.z = aa.z + gg.z * acc[ai][bj][m][n][2]; o.w = aa.w + gg.w * acc[ai][bj][m][n][3];
                        *(float4*)(xo + (size_t)(128 * ai + 16 * m) * D + 128 * bj + 4 * n) = o;
                    }
            __builtin_amdgcn_sched_barrier(0);
        }
    }
};
__device__ __forceinline__ void phase_outproj(const Params& p, int l, char* smem) {
    OutSched S; S.Y = (const char*)(p.ws + OFF_Y); S.W = (const char*)(p.ws + OFF_WT) + (size_t)WR_OUT * 2048; S.G = gridDim.x; S.c = blockIdx.x; S.nM = (l == 0 ? TALL : TLAT) / 256;
    OutEpi E; E.ws_ = p.ws; E.xin_ = p.x; E.cin_ = p.ctx; E.out_ = p.out; E.l = l;
    pg8::gemm_stream<OutSched, OutEpi>((PG8_LAS unsigned char*)smem, 1024, S, E);
    __syncthreads();
    conv_run(p, l, 1, smem, (l == 0) ? 16 : 0);
}

__device__ __forceinline__ size_t gate_region(int br) { return br == 0 ? OFF_VR : (br == 1 ? OFF_KFT : OFF_F); }
struct GateSched {
    static constexpr bool GATHER = false;
    const char* ws; int G, c, nM, nctx;
    __device__ __forceinline__ bool next(int i, pg8::Unit& u) const {
        int pm, pn;
        if (pg8::static_unit(i, G, c, nM, 12, pm, pn)) {
            u.pm = pm; u.pn = pn; u.tag = 0;
            u.A = ws + OFF_H + (size_t)pm * 256 * 2048; u.B = ws + OFF_WT + (size_t)(WR_G + pn * 256) * 2048;
            return true;
        }
        const int q = i * G + c - nM * 12;
        if (q < 0 || q >= nctx) return false;
        const int t = q / 3, br = q - 3 * t, pmc = t >> 2, pn4 = t & 3;
        u.pm = pmc; u.pn = pn4; u.tag = 2 + br;
        u.A = ws + (br == 0 ? OFF_UR : br == 1 ? OFF_QS : OFF_QA) + (size_t)(64 + pmc) * 256 * 2048;
        u.B = ws + OFF_WT + (size_t)(WR_BR + br * 1024 + pn4 * 256) * 2048;
        return true;
    }
};
struct CtxGateSched {
    static constexpr bool GATHER = false;
    const char* ws; int q;
    __device__ __forceinline__ bool next(int i, pg8::Unit& u) const {
        if (i > 0) return false;
        const int pmc = q / 12, pn12 = q - 12 * pmc;
        u.pm = pmc; u.pn = pn12; u.tag = 1;
        u.A = ws + OFF_H + (size_t)(64 + pmc) * 256 * 2048; u.B = ws + OFF_WT + (size_t)(WR_G + pn12 * 256) * 2048;
        return true;
    }
};
struct GateEpi {
    unsigned char* ws_;
    typedef pg8::f32x4 f32x4;
    __device__ __forceinline__ void operator()(const f32x4 (&acc)[2][2][4][2], const pg8::Unit& u, int wr, int wc, int fr0, int fq0) const {
        unsigned char* ws = ws_;
        asm volatile("" : "+s"(ws));
        int fr = fr0, fq = fq0; asm volatile("" : "+v"(fr), "+v"(fq));
        if (u.tag < 2) {
            const int br = u.pn >> 2, pn4 = u.pn & 3;
            bf16* Gp = u.tag == 0 ? (bf16*)(ws + gate_region(br)) : (bf16*)(ws + OFF_GC) + (size_t)br * 1024 * 1024;
#pragma unroll
            for (int ai = 0; ai < 2; ++ai)
#pragma unroll
                for (int m = 0; m < 4; ++m) {
                    const int row = 256 * u.pm + 128 * ai + 64 * wr + 16 * m + fr;
#pragma unroll
                    for (int bj = 0; bj < 2; ++bj) {
                        float o[8];
#pragma unroll
                        for (int n = 0; n < 2; ++n)
#pragma unroll
                            for (int j = 0; j < 4; ++j) o[n * 4 + j] = __builtin_amdgcn_rcpf(1.f + fexp_(-acc[ai][bj][m][n][j]));
                        InprojEpi::st8(Gp + (size_t)row * 1024 + 256 * pn4 + 128 * bj + 32 * wc + 8 * fq, o);
                    }
                    __builtin_amdgcn_sched_barrier(0);
                }
        } else {
            const int br = u.tag - 2;
            const bf16* Gc = (const bf16*)(ws + OFF_GC) + (size_t)br * 1024 * 1024;
            bf16* Pc = (bf16*)(ws + OFF_PC) + (size_t)br * 1024 * 1024;
            const size_t off0 = (size_t)(256 * u.pm + 64 * wr + fr) * 1024 + 256 * u.pn + 32 * wc + 8 * fq;
#pragma unroll
            for (int ai = 0; ai < 2; ++ai) {
                uint4 g[4][2];
#pragma unroll
                for (int m = 0; m < 4; ++m)
#pragma unroll
                    for (int bj = 0; bj < 2; ++bj) g[m][bj] = *(const uint4*)(Gc + off0 + (size_t)(128 * ai + 16 * m) * 1024 + 128 * bj);
#pragma unroll
                for (int m = 0; m < 4; ++m)
#pragma unroll
                    for (int bj = 0; bj < 2; ++bj) {
                        float gf[8]; unpack8(g[m][bj], gf);
                        float o[8];
#pragma unroll
                        for (int n = 0; n < 2; ++n)
#pragma unroll
                            for (int j = 0; j < 4; ++j) o[n * 4 + j] = gf[n * 4 + j] * acc[ai][bj][m][n][j];
                        InprojEpi::st8(Pc + off0 + (size_t)(128 * ai + 16 * m) * 1024 + 128 * bj, o);
                    }
                __builtin_amdgcn_sched_barrier(0);
            }
        }
    }
};
__device__ __forceinline__ void ctx_gate_item(const Params& p, int q, char* smem) {
    CtxGateSched S; S.ws = (const char*)p.ws; S.q = q;
    GateEpi E; E.ws_ = p.ws;
    pg8::gemm_stream<CtxGateSched, GateEpi>((PG8_LAS unsigned char*)smem, 1024, S, E);
    __syncthreads();
}
__device__ __forceinline__ void phase_gates(const Params& p, int l, char* smem) {
    GateSched S; S.ws = (const char*)p.ws; S.G = gridDim.x; S.c = blockIdx.x; S.nM = TLAT / 256; S.nctx = (l == 0) ? 48 : 0;
    GateEpi E; E.ws_ = p.ws;
    pg8::gemm_stream<GateSched, GateEpi>((PG8_LAS unsigned char*)smem, 1024, S, E);
    __syncthreads();
}
struct MergeSched {
    static constexpr bool GATHER = false;
    const char* ws; int G, c, nM;
    __device__ __forceinline__ bool next(int i, pg8::Unit& u) const {
        const int j = i / 3, br = i - 3 * j;
        int pm, pn;
        if (!pg8::static_unit(j, G, c, nM, 4, pm, pn)) return false;
        u.pm = pm; u.pn = pn; u.tag = br;
        u.A = ws + (br == 0 ? OFF_UR : br == 1 ? OFF_QS : OFF_QA) + (size_t)pm * 256 * 2048;
        u.B = ws + OFF_WT + (size_t)(WR_BR + br * 1024 + pn * 256) * 2048;
        return true;
    }
};
struct MergeEpi {
    unsigned char* ws_;
    typedef pg8::f32x4 f32x4;
    __device__ __forceinline__ void operator()(const f32x4 (&acc)[2][2][4][2], const pg8::Unit& u, int wr, int wc, int fr0, int fq0) const {
        unsigned char* ws = ws_;
        asm volatile("" : "+s"(ws));
        int fr = fr0, fq = fq0; asm volatile("" : "+v"(fr), "+v"(fq));
        const int br = u.tag;
        const bf16* Gp = (const bf16*)(ws + gate_region(br));
        bf16* Y = (bf16*)(ws + OFF_Y);
        const size_t off0 = (size_t)(256 * u.pm + 64 * wr + fr) * 1024 + 256 * u.pn + 32 * wc + 8 * fq;
#pragma unroll
        for (int ai = 0; ai < 2; ++ai) {
            uint4 g[4][2], y[4][2];
#pragma unroll
            for (int m = 0; m < 4; ++m)
#pragma unroll
                for (int bj = 0; bj < 2; ++bj) {
                    const size_t off = off0 + (size_t)(128 * ai + 16 * m) * 1024 + 128 * bj;
                    g[m][bj] = *(const uint4*)(Gp + off);
                    if (br > 0) y[m][bj] = *(const uint4*)(Y + off);
                }
#pragma unroll
            for (int m = 0; m < 4; ++m)
#pragma unroll
                for (int bj = 0; bj < 2; ++bj) {
                    const size_t off = off0 + (size_t)(128 * ai + 16 * m) * 1024 + 128 * bj;
                    float gf[8]; unpack8(g[m][bj], gf);
                    float o[8];
#pragma unroll
                    for (int n = 0; n < 2; ++n)
#pragma unroll
                        for (int j = 0; j < 4; ++j) o[n * 4 + j] = gf[n * 4 + j] * acc[ai][bj][m][n][j];
                    if (br > 0) {
                        float yf[8]; unpack8(y[m][bj], yf);
#pragma unroll
                        for (int j = 0; j < 8; ++j) o[j] += yf[j];
                    }
                    InprojEpi::st8(Y + off, o);
                }
            __builtin_amdgcn_sched_barrier(0);
        }
    }
};
__device__ __forceinline__ void phase_merge(const Params& p, int l, char* smem) {
    MergeSched S; S.ws = (const char*)p.ws; S.G = gridDim.x; S.c = blockIdx.x; S.nM = TLAT / 256;
    MergeEpi E; E.ws_ = p.ws;
    pg8::gemm_stream<MergeSched, MergeEpi>((PG8_LAS unsigned char*)smem, 1024, S, E);
    __syncthreads();
    if (l == 0) {
        const uint4* P0 = (const uint4*)(p.ws + OFF_PC); uint4* Yc = (uint4*)(p.ws + OFF_Y + (size_t)TLAT * 2048);
        for (int i = blockIdx.x * NT + otid(); i < 1024 * 1024 / 8; i += gridDim.x * NT) {
            float a[8], b[8], c[8]; unpack8(P0[i], a); unpack8(P0[i + 131072], b); unpack8(P0[i + 262144], c);
            uint4 o; o.x = pack2(a[0] + b[0] + c[0], a[1] + b[1] + c[1]); o.y = pack2(a[2] + b[2] + c[2], a[3] + b[3] + c[3]);
            o.z = pack2(a[4] + b[4] + c[4], a[5] + b[5] + c[5]); o.w = pack2(a[6] + b[6] + c[6], a[7] + b[7] + c[7]);
            Yc[i] = o;
        }
    }
}

__device__ __forceinline__ bool moe_find(const int* cnt, int tile, int& e, int& mt, int& rowbase, int& ce) {
    const int lane = otid() & 63;
    const int c = lane < 16 ? cnt[lane] : 0;
    const int nt = (c + 255) >> 8;
    int pt = nt, pr = c;
#pragma unroll
    for (int o = 1; o < 16; o <<= 1) { const int a = shup(pt, o, lane), b = shup(pr, o, lane); if (lane >= o) { pt += a; pr += b; } }
    const bool mine = lane < 16 && tile >= pt - nt && tile < pt;
    const unsigned long long m = __ballot(mine);
    if (m == 0ull) return false;
    const int src = __ffsll((long long)m) - 1;
    e = src;
    mt = tile - (__builtin_amdgcn_readlane(pt, src) - __builtin_amdgcn_readlane(nt, src));
    rowbase = __builtin_amdgcn_readlane(pr, src) - __builtin_amdgcn_readlane(c, src);
    ce = __builtin_amdgcn_readlane(c, src);
    return true;
}
struct Moe1Sched {
    static constexpr bool GATHER = true;
    const char* ws; const int* cnt; const int* lts; int G, c;
    __device__ __forceinline__ bool next(int i, pg8::Unit& u) const {
        const int L = i * G + c; const int tile = L >> 2, pn = L & 3;
        int e, mt, rowbase, ce;
        if (!moe_find(cnt, tile, e, mt, rowbase, ce)) return false;
        u.pm = mt; u.pn = pn; u.tag = e; u.x0 = rowbase; u.x1 = ce;
        u.A = ws + OFF_H; u.B = ws + OFF_WGU + ((size_t)e * 1024 + pn * 256) * 2048;
        return true;
    }
    __device__ __forceinline__ unsigned row_off(const pg8::Unit& u, int r) const {
        int idx = u.pm * 256 + r; if (idx >= u.x1) idx = u.x1 - 1;
        return (unsigned)(lts[(size_t)u.tag * TALL + idx] >> 1) * 2048u;
    }
};
struct Moe1Epi {
    unsigned char* ws_; int l;
    typedef pg8::f32x4 f32x4;
    __device__ __forceinline__ void operator()(const f32x4 (&acc)[2][2][4][2], const pg8::Unit& u, int wr, int wc, int fr0, int fq0) const {
        unsigned char* ws = ws_;
        asm volatile("" : "+v"(ws));
        int fr = fr0, fq = fq0; asm volatile("" : "+v"(fr), "+v"(fq));
        const int mt = u.pm, rowbase = u.x0, ce = u.x1;
        bf16* HB = (bf16*)(ws + OFF_HB);
#pragma unroll
        for (int ai = 0; ai < 2; ++ai)
#pragma unroll
            for (int m = 0; m < 4; ++m) {
                const int idx = mt * 256 + 128 * ai + 64 * wr + 16 * m + fr;
                if (idx < ce) {
                    float o[8];
#pragma unroll
                    for (int n = 0; n < 2; ++n)
#pragma unroll
                        for (int j = 0; j < 4; ++j) { const float g = acc[ai][0][m][n][j], uu = acc[ai][1][m][n][j]; o[n * 4 + j] = fsilu_(g) * uu; }
                    InprojEpi::st8(HB + (size_t)(rowbase + idx) * 512 + 128 * u.pn + 32 * wc + 8 * fq, o);
                }
                __builtin_amdgcn_sched_barrier(0);
            }
    }
};
__device__ __forceinline__ void phase_moe1(const Params& p, int l, char* smem) {
    Moe1Sched S; S.ws = (const char*)p.ws; S.cnt = (const int*)(p.ws + OFF_CTL) + l * 16; S.lts = (const int*)(p.ws + OFF_LTS); S.G = gridDim.x; S.c = blockIdx.x;
    Moe1Epi E; E.ws_ = p.ws; E.l = l;
    pg8::gemm_stream<Moe1Sched, Moe1Epi>((PG8_LAS unsigned char*)smem, 1024, S, E);
    __syncthreads();
    if (l == 0) {
        const int* cnt = (const int*)(p.ws + OFF_CTL) + l * 16;
        int tiles = 0;
        for (int i = 0; i < 16; ++i) tiles += (__builtin_amdgcn_readfirstlane(cnt[i]) + 255) >> 8;
        const int rem = (tiles * 4) % (int)gridDim.x;
        conv_run(p, 1, 0, smem, (rem > 0 && rem < (int)gridDim.x - 32) ? rem : 0);
    }
}
struct Moe2Sched {
    static constexpr bool GATHER = false;
    const char* ws; const int* cnt; int G, c;
    __device__ __forceinline__ bool next(int i, pg8::Unit& u) const {
        const int L = i * G + c; const int tile = L >> 2, pn = L & 3;
        int e, mt, rowbase, ce;
        if (!moe_find(cnt, tile, e, mt, rowbase, ce)) return false;
        u.pm = mt; u.pn = pn; u.tag = e; u.x0 = rowbase; u.x1 = ce;
        u.A = ws + OFF_HB + (size_t)(rowbase + mt * 256) * 1024; u.B = ws + OFF_WD + ((size_t)e * 1024 + pn * 256) * 1024;
        return true;
    }
};
struct Moe2Epi {
    unsigned char* ws_; int l;
    typedef pg8::f32x4 f32x4;
    __device__ __forceinline__ void operator()(const f32x4 (&acc)[2][2][4][2], const pg8::Unit& u, int wr, int wc, int fr0, int fq0) const {
        unsigned char* ws = ws_;
        asm volatile("" : "+s"(ws));
        int fr = fr0, fq = fq0; asm volatile("" : "+v"(fr), "+v"(fq));
        const int e = u.tag, mt = u.pm, ce = u.x1;
        const int* lts = (const int*)(ws + OFF_LTS) + (size_t)e * TALL; const float* lw = (const float*)(ws + OFF_LW) + (size_t)e * TALL;
        bf16* YB = (bf16*)(ws + OFF_YB);
        int tsv[2][4]; float wv[2][4];
#pragma unroll
        for (int ai = 0; ai < 2; ++ai)
#pragma unroll
            for (int m = 0; m < 4; ++m) {
                int idx = mt * 256 + 128 * ai + 64 * wr + 16 * m + fr; if (idx >= ce) idx = ce - 1;
                tsv[ai][m] = lts[idx]; wv[ai][m] = lw[idx];
            }
#pragma unroll
        for (int ai = 0; ai < 2; ++ai)
#pragma unroll
            for (int m = 0; m < 4; ++m) {
                const int idx = mt * 256 + 128 * ai + 64 * wr + 16 * m + fr;
                if (idx < ce) {
                    const int ts = tsv[ai][m]; const float w = wv[ai][m];
#pragma unroll
                    for (int bj = 0; bj < 2; ++bj) {
                        float o[8];
#pragma unroll
                        for (int n = 0; n < 2; ++n)
#pragma unroll
                            for (int j = 0; j < 4; ++j) o[n * 4 + j] = w * acc[ai][bj][m][n][j];
                        InprojEpi::st8(YB + (size_t)ts * 1024 + 256 * u.pn + 128 * bj + 32 * wc + 8 * fq, o);
                    }
                }
            }
    }
};
__device__ __forceinline__ void phase_moe2(const Params& p, int l, char* smem) {
    Moe2Sched S; S.ws = (const char*)p.ws; S.cnt = (const int*)(p.ws + OFF_CTL) + l * 16; S.G = gridDim.x; S.c = blockIdx.x;
    Moe2Epi E; E.ws_ = p.ws; E.l = l;
    pg8::gemm_stream<Moe2Sched, Moe2Epi>((PG8_LAS unsigned char*)smem, 512, S, E);
    __syncthreads();
}

namespace ga {
using s16x4  = __attribute__((ext_vector_type(4))) short;
using u32x4  = __attribute__((ext_vector_type(4))) unsigned;
constexpr int QBLK = 32, KVBLK = 64;
constexpr float SCALE = 0.088388347648318440f;
constexpr float THR = 8.f;
constexpr int LDQ = 1024, LDK = 256, LDO = 1024;
constexpr int SHM_V = KVBLK * 128 * 2, SHM_K = KVBLK * 128 * 2;
constexpr int SHM_ATTN = 2 * SHM_V + 2 * SHM_K + 8 * 64 * 4;
#define KSWZ(row, colB) ((row) * 256 + ((colB) ^ (((row) & 7) << 4)))
#define SBAR() __builtin_amdgcn_sched_barrier(0)
__device__ __forceinline__ int crow(int r, int hi) { return (r & 3) + 8 * (r >> 2) + 4 * hi; }
__device__ __forceinline__ unsigned cvtpk(float lo, float hi) { return pack2(lo, hi); }
__device__ __forceinline__ void partialSM_fixed(f32x16& p0, f32x16& p1, float mnC) {
  constexpr float C = SCALE * 1.4426950408889634f;
#pragma unroll
  for (int r = 0; r < 16; ++r) p0[r] = __builtin_amdgcn_exp2f(fmaf(p0[r], C, mnC));
#pragma unroll
  for (int r = 0; r < 16; ++r) p1[r] = fmaf(p1[r], C, mnC);
}
__device__ __forceinline__ void partialSM(f32x16& p0, f32x16& p1, float& m_reg, float& mn, float& alpha) {
  constexpr float C = SCALE * 1.4426950408889634f;
  float pmax = p0[0];
#pragma unroll
  for (int r = 1; r < 16; ++r) pmax = fmaxf(pmax, p0[r]);
#pragma unroll
  for (int r = 0; r < 16; ++r) pmax = fmaxf(pmax, p1[r]);
  { auto rr = __builtin_amdgcn_permlane32_swap(__float_as_uint(pmax), __float_as_uint(pmax), false, false);
    pmax = fmaxf(__uint_as_float(rr[0]), __uint_as_float(rr[1])); }
  if (__builtin_expect(__all(pmax - m_reg <= THR / SCALE), 1)) { mn = m_reg; alpha = 1.f; }
  else { mn = fmaxf(m_reg, pmax); alpha = __builtin_amdgcn_exp2f((m_reg - mn) * C); m_reg = mn; }
  float mnC = -mn * C;
#pragma unroll
  for (int r = 0; r < 16; ++r) p0[r] = fmaf(p0[r], C, mnC);
#pragma unroll
  for (int r = 0; r < 16; ++r) p1[r] = fmaf(p1[r], C, mnC);
#pragma unroll
  for (int r = 0; r < 16; ++r) p0[r] = __builtin_amdgcn_exp2f(p0[r]);
}
__device__ __forceinline__ void finishSM(f32x16& p0, f32x16& p1, float alpha, float& l_reg, bf16x8& pa0, bf16x8& pa1, bf16x8& pa2, bf16x8& pa3) {
#pragma unroll
  for (int r = 0; r < 16; ++r) p1[r] = __builtin_amdgcn_exp2f(p1[r]);
  float ps = 0;
#pragma unroll
  for (int r = 0; r < 16; ++r) ps += p0[r];
#pragma unroll
  for (int r = 0; r < 16; ++r) ps += p1[r];
  { auto rr = __builtin_amdgcn_permlane32_swap(__float_as_uint(ps), __float_as_uint(ps), false, false);
    ps = __uint_as_float(rr[0]) + __uint_as_float(rr[1]); }
  l_reg = l_reg * alpha + ps;
#define PK4(P, BASE, OUT) do { unsigned a0 = cvtpk(P[BASE + 0], P[BASE + 1]), a1 = cvtpk(P[BASE + 2], P[BASE + 3]);   \
    unsigned b0 = cvtpk(P[BASE + 4], P[BASE + 5]), b1 = cvtpk(P[BASE + 6], P[BASE + 7]);                              \
    auto r0 = __builtin_amdgcn_permlane32_swap(a0, b0, false, false); auto r1 = __builtin_amdgcn_permlane32_swap(a1, b1, false, false); \
    u32x4 w = {r0[0], r1[0], r0[1], r1[1]}; OUT = *reinterpret_cast<bf16x8*>(&w); } while (0)
  PK4(p0, 0, pa0); PK4(p0, 8, pa1); PK4(p1, 0, pa2); PK4(p1, 8, pa3);
#undef PK4
}
__device__ __forceinline__ void qkt(f32x16& p0, f32x16& p1, const char* Ks, const bf16x8* qr, int r32, int hi) {
  p0 = f32x16{}; p1 = f32x16{};
#pragma unroll
  for (int d0 = 0; d0 < 8; ++d0) { int cb = (d0 * 16 + hi * 8) * 2;
    bf16x8 b0 = *reinterpret_cast<const bf16x8*>(Ks + KSWZ(r32, cb));
    bf16x8 b1 = *reinterpret_cast<const bf16x8*>(Ks + KSWZ(32 + r32, cb));
    p0 = __builtin_amdgcn_mfma_f32_32x32x16_bf16(b0, qr[d0], p0, 0, 0, 0);
    p1 = __builtin_amdgcn_mfma_f32_32x32x16_bf16(b1, qr[d0], p1, 0, 0, 0); }
}
__device__ __forceinline__ int v_st(int k, int c) { const int kk = (k & ~0xC) | ((k & 4) << 1) | ((k & 8) >> 1); return ((kk >> 3) * 4 + (c >> 5)) * 512 + ((kk & 7) * 32 + (c & 31)) * 2; }
__device__ __forceinline__ int v_rd_base(int lane) { return ((lane & 3) << 3) | (((lane >> 2) & 3) << 6) | (((lane >> 4) & 1) << 5) | (((lane >> 5) & 1) << 8); }
constexpr int v_rd_off(int d0, int ks, int half) { return d0 * 512 + ks * 4096 + half * 2048; }
template <int OFF> __device__ __forceinline__ s16x4 tr_read(int vb) {
  s16x4 r; asm volatile("ds_read_b64_tr_b16 %0, %1 offset:%2" : "=&v"(r) : "v"(vb), "i"(OFF) : "memory"); return r;
}
template <int D0> __device__ __forceinline__ void pv_one(f32x16& od, int vb, bf16x8 pa0, bf16x8 pa1, bf16x8 pa2, bf16x8 pa3) {
  const s16x4 l0 = tr_read<v_rd_off(D0, 0, 0)>(vb), h0 = tr_read<v_rd_off(D0, 0, 1)>(vb), l1 = tr_read<v_rd_off(D0, 1, 0)>(vb), h1 = tr_read<v_rd_off(D0, 1, 1)>(vb);
  const s16x4 l2 = tr_read<v_rd_off(D0, 2, 0)>(vb), h2 = tr_read<v_rd_off(D0, 2, 1)>(vb), l3 = tr_read<v_rd_off(D0, 3, 0)>(vb), h3 = tr_read<v_rd_off(D0, 3, 1)>(vb);
  asm volatile("s_waitcnt lgkmcnt(0)" ::: "memory"); SBAR();
#define PK(L, H) (bf16x8){L[0], L[1], L[2], L[3], H[0], H[1], H[2], H[3]}
  od = __builtin_amdgcn_mfma_f32_32x32x16_bf16(pa0, PK(l0, h0), od, 0, 0, 0);
  od = __builtin_amdgcn_mfma_f32_32x32x16_bf16(pa1, PK(l1, h1), od, 0, 0, 0);
  od = __builtin_amdgcn_mfma_f32_32x32x16_bf16(pa2, PK(l2, h2), od, 0, 0, 0);
  od = __builtin_amdgcn_mfma_f32_32x32x16_bf16(pa3, PK(l3, h3), od, 0, 0, 0);
#undef PK
}
__device__ __forceinline__ void pv_d0(f32x16* o, int vb, bf16x8 pa0, bf16x8 pa1, bf16x8 pa2, bf16x8 pa3) {
  pv_one<0>(o[0], vb, pa0, pa1, pa2, pa3); pv_one<1>(o[1], vb, pa0, pa1, pa2, pa3); pv_one<2>(o[2], vb, pa0, pa1, pa2, pa3); pv_one<3>(o[3], vb, pa0, pa1, pa2, pa3);
}

__device__ __forceinline__ void attn_dense_body(bf16* Qb, const bf16* Klat, const bf16* Vlat, const bf16* Kctx, const bf16* Vctx,
                                                int nlat, int seq, char* lds, float mfix) {
  const int tid = otid(), wid = tid >> 6, lane = tid & 63, r32 = lane & 31, hi = lane >> 5;
  char* V_lds = lds; char* K_lds = lds + 2 * SHM_V;
  float* wsl = (float*)(lds + 2 * SHM_V + 2 * SHM_K) + wid * 64; float* li_l = wsl; float* al_l = wsl + 32;
  float l_reg = 0; f32x16 o[4] = {}; bf16x8 qr[8];
  const bf16* Qw = Qb + (long)(wid * QBLK + r32) * LDQ + hi * 8;
#pragma unroll
  for (int d0 = 0; d0 < 8; ++d0) qr[d0] = *reinterpret_cast<const bf16x8*>(Qw + d0 * 16);
  const int sr = tid >> 4, sc = (tid & 15) * 8, vst0 = v_st(sr, sc), vst1 = v_st(32 + sr, sc);
  const int vb0 = (int)(uintptr_t)V_lds + v_rd_base(lane);
  struct { bf16x8 vs0, vs1, ks0, ks1; } sr_[2];
#define KVROW(k0) ((k0) < nlat ? (long)(k0) * LDK : (long)((k0) - nlat) * LDK)
#define SLOAD(i, k0) do { const bf16* kb_ = ((k0) < nlat ? Klat : Kctx) + KVROW(k0); const bf16* vb_ = ((k0) < nlat ? Vlat : Vctx) + KVROW(k0); \
    sr_[i].vs0 = *reinterpret_cast<const bf16x8*>(vb_ + (long)sr * LDK + sc); sr_[i].vs1 = *reinterpret_cast<const bf16x8*>(vb_ + (long)(32 + sr) * LDK + sc); \
    sr_[i].ks0 = *reinterpret_cast<const bf16x8*>(kb_ + (long)sr * LDK + sc); sr_[i].ks1 = *reinterpret_cast<const bf16x8*>(kb_ + (long)(32 + sr) * LDK + sc); } while (0)
#define SWRITE(b, i) do { *(bf16x8*)(V_lds + (b) * SHM_V + vst0) = sr_[i].vs0;          \
    *(bf16x8*)(V_lds + (b) * SHM_V + vst1) = sr_[i].vs1; int kc = sc * 2;               \
    *(bf16x8*)(K_lds + (b) * SHM_K + KSWZ(sr, kc)) = sr_[i].ks0;                       \
    *(bf16x8*)(K_lds + (b) * SHM_K + KSWZ(32 + sr, kc)) = sr_[i].ks1; } while (0)
#define SWAIT() asm volatile("s_waitcnt vmcnt(4)" ::: "memory")
#define RESC(a) do { if (__any((a) < 1.f)) { if (hi == 0) al_l[r32] = (a); asm volatile("s_waitcnt lgkmcnt(0)" ::: "memory"); \
    _Pragma("unroll") for (int d = 0; d < 4; ++d) _Pragma("unroll") for (int r = 0; r < 16; ++r) o[d][r] *= al_l[crow(r, hi)]; } } while (0)
  f32x16 pA0, pA1, pB0, pB1; bf16x8 pa0, pa1, pa2, pa3; const int NTL = seq / KVBLK;
  const float mnC = -mfix * (SCALE * 1.4426950408889634f);
  constexpr int SE = 0, SO = 1;
  SLOAD(SE, 0); asm volatile("s_waitcnt vmcnt(0)" ::: "memory"); SWRITE(0, SE); __syncthreads();
  qkt(pA0, pA1, K_lds, qr, r32, hi); partialSM_fixed(pA0, pA1, mnC);
  SLOAD(SO, KVBLK); if (2 < NTL) SLOAD(SE, 2 * KVBLK);
  SWAIT(); SWRITE(1, SO); __syncthreads();
  for (int j = 1; j + 1 < NTL; j += 2) {
    SBAR(); qkt(pB0, pB1, K_lds + SHM_K, qr, r32, hi);
    finishSM(pA0, pA1, 1.f, l_reg, pa0, pa1, pa2, pa3); SBAR();
    SLOAD(SO, (j + 2) * KVBLK); SBAR();
    pv_d0(o, vb0, pa0, pa1, pa2, pa3); partialSM_fixed(pB0, pB1, mnC);
    __syncthreads(); SWAIT(); SWRITE(0, SE);
    __syncthreads();
    SBAR(); qkt(pA0, pA1, K_lds, qr, r32, hi);
    finishSM(pB0, pB1, 1.f, l_reg, pa0, pa1, pa2, pa3); SBAR();
    if (j + 3 < NTL) SLOAD(SE, (j + 3) * KVBLK); SBAR();
    pv_d0(o, vb0 + (int)SHM_V, pa0, pa1, pa2, pa3); partialSM_fixed(pA0, pA1, mnC);
    __syncthreads(); SWAIT(); SWRITE(1, SO);
    __syncthreads();
  }
  SBAR(); qkt(pB0, pB1, K_lds + SHM_K, qr, r32, hi);
  finishSM(pA0, pA1, 1.f, l_reg, pa0, pa1, pa2, pa3); SBAR();
  pv_d0(o, vb0, pa0, pa1, pa2, pa3); partialSM_fixed(pB0, pB1, mnC);
  __syncthreads();
  finishSM(pB0, pB1, 1.f, l_reg, pa0, pa1, pa2, pa3); SBAR();
  pv_d0(o, vb0 + (int)SHM_V, pa0, pa1, pa2, pa3);
  if (hi == 0) li_l[r32] = l_reg; asm volatile("s_waitcnt lgkmcnt(0)" ::: "memory");
  float rli[16];
#pragma unroll
  for (int r = 0; r < 16; ++r) rli[r] = __builtin_amdgcn_rcpf(li_l[crow(r, hi)]);
  bf16* Ow = Qb + (long)(wid * QBLK) * LDO;
#pragma unroll
  for (int r = 0; r < 16; ++r) { int orow = crow(r, hi);
#pragma unroll
    for (int d0 = 0; d0 < 4; ++d0) Ow[(long)orow * LDO + d0 * 32 + r32] = f2bf(o[d0][r] * rli[r]); }
  __syncthreads();
#undef KVROW
#undef SLOAD
#undef SWRITE
#undef SWAIT
#undef RESC
}
#undef KSWZ
}

__device__ __forceinline__ void ga_item(const Params& p, int l, int it, char* smem) {
    const float mfix = ((const float*)(p.ws + OFF_DEC))[16 + l];
    bf16* QA = (bf16*)(p.ws + OFF_QA); const bf16* KA = (const bf16*)(p.ws + OFF_KA); const bf16* VA = (const bf16*)(p.ws + OFF_VA);
    if (it < 512) {
        const int pair = it & 7, j = it >> 3, hg = j >> 4, qb = j & 15, b = pair >> 1, kvh = pair & 1, head = kvh * 4 + hg;
        ga::attn_dense_body(QA + (size_t)(b * SEQ + qb * 256) * 1024 + head * 128,
                            KA + (size_t)(b * SEQ) * 256 + kvh * 128, VA + (size_t)(b * SEQ) * 256 + kvh * 128,
                            KA + (size_t)(TLAT + b * CTXL) * 256 + kvh * 128, VA + (size_t)(TLAT + b * CTXL) * 256 + kvh * 128,
                            4096, 4352, smem, mfix);
    } else {
        const int j = it - 512, b = j >> 3, head = j & 7, kvh = head >> 2;
        const bf16* kc = KA + (size_t)(TLAT + b * CTXL) * 256 + kvh * 128; const bf16* vc = VA + (size_t)(TLAT + b * CTXL) * 256 + kvh * 128;
        ga::attn_dense_body(QA + (size_t)(TLAT + b * CTXL) * 1024 + head * 128, kc, vc, kc, vc, 0, 256, smem, mfix);
    }
}
__device__ __forceinline__ int chunk_key0(int c) { return c < 32 ? c * 128 : 4096 + (c - 32) * 128; }
__device__ __forceinline__ void ret1_item(const Params& p, int l, int it, char* smem) {
    const int tid = otid(), lr = tid >> 3;
    const bf16* VT = (const bf16*)(p.ws + OFF_VR);
    bf16* F = (bf16*)(p.ws + OFF_F);
    {
        const int dir = it & 1, j = it >> 1, c = j % 34, bh = j / 34;
        const int key0 = chunk_key0(c);
        const bf16* KT = (const bf16*)(p.ws + (dir ? OFF_KBT : OFF_KFT));
        const bf16* a = VT + ((size_t)bh * 256 + lr) * KEYS + key0;
        const bf16* b = KT + ((size_t)bh * 128 + lr) * KEYS + key0;
        f32x16 acc[2][2]; zero_acc<2>(acc);
        gemm_mainloop<2>(acc, a, a + 64 * KEYS, a + 128 * KEYS, a + 192 * KEYS, b, b + 64 * KEYS, 128, smem);
        bf16* dst = F + ((size_t)(dir * 16 + bh) * 34 + c) * 32768;
        for (int h = 0; h < 2; ++h) {
            stage_half(acc, h, smem);
            __syncthreads();
            epi_plain_bf16((const float*)smem, dst, 128, h * 128, 0);
            __syncthreads();
        }
    }
}

__device__ __forceinline__ void phase_ret_scan(const Params& p, int l) {
    const int tid = otid();
    unsigned* F = (unsigned*)(p.ws + OFF_F);
    for (int g = blockIdx.x * NT + tid; g < 2 * 16 * 16384; g += gridDim.x * NT) {
        const int e2 = g & 16383, bh = (g >> 14) & 15, dir = g >> 18, h = bh & 3;
        const float lg = ((const float*)(p.ws + OFF_DEC))[l * 8 + dir * 4 + h];
        const float g128 = fexp_(128.f * lg);
        unsigned* base = F + (size_t)(dir * 16 + bh) * 34 * 16384 + e2;
        unsigned u[34];
#pragma unroll
        for (int c = 0; c < 34; ++c) u[c] = base[(size_t)c * 16384];
        float s0 = 0.f, s1 = 0.f;
        if (dir == 0) {
#pragma unroll
            for (int k = 0; k < 34; ++k) {
                const int c = k == 0 ? 32 : (k == 1 ? 33 : k - 2);
                const unsigned v = u[c];
                base[(size_t)c * 16384] = pack2(s0, s1);
                s0 = g128 * s0 + lo2f(v); s1 = g128 * s1 + hi2f(v);
            }
        } else {
#pragma unroll
            for (int k = 0; k < 34; ++k) {
                const int c = k == 0 ? 33 : (k == 1 ? 32 : 33 - k);
                const unsigned v = u[c];
                base[(size_t)c * 16384] = pack2(s0, s1);
                s0 = g128 * s0 + lo2f(v); s1 = g128 * s1 + hi2f(v);
            }
        }
    }
}

namespace r3 {
constexpr int KROWB = 272, VROWB = 264;
constexpr int KS_BYTES = 128 * KROWB, VT_BYTES = 256 * VROWB;
__device__ __forceinline__ int crow(int r, int hi) { return (r & 3) + 8 * (r >> 2) + 4 * hi; }
__device__ __forceinline__ bf16x8 scaleq(bf16x8 q, float sc) {
    ga::u32x4 w = *reinterpret_cast<ga::u32x4*>(&q);
    ga::u32x4 o = {pack2(lo2f(w[0]) * sc, hi2f(w[0]) * sc), pack2(lo2f(w[1]) * sc, hi2f(w[1]) * sc), pack2(lo2f(w[2]) * sc, hi2f(w[2]) * sc), pack2(lo2f(w[3]) * sc, hi2f(w[3]) * sc)};
    return *reinterpret_cast<bf16x8*>(&o);
}
__device__ __forceinline__ void body(const Params& p, int l, int b, int h, int c, char* lds) {
    const int tid = otid(), wid = tid >> 6, lane = tid & 63, r32 = lane & 31, hi = lane >> 5, wq = wid & 3, wv = wid >> 2;
    const bf16* QR = (const bf16*)(p.ws + OFF_QR); const bf16* KR = (const bf16*)(p.ws + OFF_KR);
    const bf16* VT = (const bf16*)(p.ws + OFF_VR); bf16* UR = (bf16*)(p.ws + OFF_UR);
    const bf16* F = (const bf16*)(p.ws + OFF_F);
    const int bh = b * 4 + h, key0 = chunk_key0(c);
    const int row0 = c < 32 ? b * SEQ + c * 128 : TLAT + b * CTXL + (c - 32) * 128;
    const float* dec = (const float*)(p.ws + OFF_DEC) + 64 + (size_t)((l * 4 + h) * 6) * 128;
    char* Ks = lds; char* Vt = lds + KS_BYTES; float* red = (float*)(lds + KS_BYTES + VT_BYTES);
    {
        uint4 kv[4], vv[8];
#pragma unroll
        for (int i = 0; i < 4; ++i) { const int idx = tid + NT * i; kv[i] = *(const uint4*)(KR + (size_t)(row0 + (idx >> 4)) * 512 + h * 128 + (idx & 15) * 8); }
#pragma unroll
        for (int i = 0; i < 8; ++i) { const int idx = tid + NT * i; vv[i] = *(const uint4*)(VT + ((size_t)bh * 256 + (idx >> 4)) * KEYS + key0 + (idx & 15) * 8); }
#pragma unroll
        for (int i = 0; i < 4; ++i) { const int idx = tid + NT * i; *(uint4*)(Ks + (idx >> 4) * KROWB + (idx & 15) * 16) = kv[i]; }
#pragma unroll
        for (int i = 0; i < 8; ++i) { const int idx = tid + NT * i; char* d = Vt + (idx >> 4) * VROWB + (idx & 15) * 16;
            *(uint2*)d = make_uint2(vv[i].x, vv[i].y); *(uint2*)(d + 8) = make_uint2(vv[i].z, vv[i].w); }
    }
    const int iq = 32 * wq + r32;
    bf16x8 qr[8];
    {
        const bf16* Qw = QR + (size_t)(row0 + iq) * 512 + h * 128 + hi * 8;
#pragma unroll
        for (int d0 = 0; d0 < 8; ++d0) qr[d0] = *reinterpret_cast<const bf16x8*>(Qw + d0 * 16);
    }
    __syncthreads();
    f32x16 o[4] = {};
    const bf16* St0 = F + ((size_t)(0 * 16 + bh) * 34 + c) * 32768; const bf16* St1 = F + ((size_t)(1 * 16 + bh) * 34 + c) * 32768;
#define R3_LD(P, i) (*(const uint4*)((P) + (size_t)(tid + NT * (i)) * 8))
    uint4 sv0 = R3_LD(St0, 0), sv1 = R3_LD(St0, 1), sv2 = R3_LD(St0, 2), sv3 = R3_LD(St0, 3), sv4 = R3_LD(St0, 4), sv5 = R3_LD(St0, 5), sv6 = R3_LD(St0, 6), sv7 = R3_LD(St0, 7);
#pragma unroll 1
    for (int kb = 0; kb < 4; ++kb) {
        f32x16 pz = {};
#pragma unroll
        for (int d0 = 0; d0 < 8; ++d0) {
            const bf16x8 kf = *reinterpret_cast<const bf16x8*>(Ks + (32 * kb + r32) * KROWB + (d0 * 16 + hi * 8) * 2);
            pz = __builtin_amdgcn_mfma_f32_32x32x16_bf16(kf, qr[d0], pz, 0, 0, 0);
        }
#pragma unroll
        for (int r = 0; r < 16; ++r) {
            const int dd = iq - (32 * kb + crow(r, hi));
            pz[r] *= (dd >= 0) ? dec[512 + dd] : dec[640 - dd];
        }
#pragma unroll
        for (int s2 = 0; s2 < 2; ++s2) {
            ga::u32x4 pw = {pack2(pz[8 * s2 + 0], pz[8 * s2 + 1]), pack2(pz[8 * s2 + 2], pz[8 * s2 + 3]), pack2(pz[8 * s2 + 4], pz[8 * s2 + 5]), pack2(pz[8 * s2 + 6], pz[8 * s2 + 7])};
            const bf16x8 pa = *reinterpret_cast<bf16x8*>(&pw);
#pragma unroll
            for (int db = 0; db < 4; ++db) {
                const char* vp = Vt + (128 * wv + 32 * db + r32) * VROWB + (32 * kb + 16 * s2 + 4 * hi) * 2;
                const uint2 lo = *(const uint2*)vp, hi2 = *(const uint2*)(vp + 16);
                ga::u32x4 bw = {lo.x, lo.y, hi2.x, hi2.y};
                o[db] = __builtin_amdgcn_mfma_f32_32x32x16_bf16(pa, *reinterpret_cast<bf16x8*>(&bw), o[db], 0, 0, 0);
            }
        }
    }
    char* Ss = lds;
#define R3_ST(i, v) do { const int idx = tid + NT * (i); *(uint4*)(Ss + (idx >> 4) * KROWB + (idx & 15) * 16) = (v); } while (0)
#define R3_STATE_WRITE() do { R3_ST(0, sv0); R3_ST(1, sv1); R3_ST(2, sv2); R3_ST(3, sv3); R3_ST(4, sv4); R3_ST(5, sv5); R3_ST(6, sv6); R3_ST(7, sv7); } while (0)
#define R3_STATE_MMA(SC) do { const float sc_ = (SC); _Pragma("unroll") for (int s = 0; s < 8; ++s) { const bf16x8 qa = scaleq(qr[s], sc_); \
        _Pragma("unroll") for (int db = 0; db < 4; ++db) { \
            const bf16x8 bfr = *reinterpret_cast<const bf16x8*>(Ss + (128 * wv + 32 * db + r32) * KROWB + (16 * s + 8 * hi) * 2); \
            o[db] = __builtin_amdgcn_mfma_f32_32x32x16_bf16(qa, bfr, o[db], 0, 0, 0); } } } while (0)
    __syncthreads();
    R3_STATE_WRITE();
    sv0 = R3_LD(St1, 0); sv1 = R3_LD(St1, 1); sv2 = R3_LD(St1, 2); sv3 = R3_LD(St1, 3); sv4 = R3_LD(St1, 4); sv5 = R3_LD(St1, 5); sv6 = R3_LD(St1, 6); sv7 = R3_LD(St1, 7);
    __syncthreads();
    R3_STATE_MMA(dec[256 + iq]);
    __syncthreads();
    R3_STATE_WRITE();
    __syncthreads();
    R3_STATE_MMA(dec[384 + iq]);
#undef R3_STATE_WRITE
#undef R3_STATE_MMA
#undef R3_ST
#undef R3_LD
    float ssq[16];
#pragma unroll
    for (int r = 0; r < 16; ++r) { ssq[r] = o[0][r] * o[0][r] + o[1][r] * o[1][r] + o[2][r] * o[2][r] + o[3][r] * o[3][r]; }
#pragma unroll
    for (int r = 0; r < 16; ++r) {
        float v = ssq[r];
        v += shx(v, 1, lane); v += shx(v, 2, lane); v += shx(v, 4, lane); v += shx(v, 8, lane); v += shx(v, 16, lane);
        ssq[r] = v;
    }
    if (r32 == 0) {
#pragma unroll
        for (int r = 0; r < 16; ++r) red[wv * 128 + 32 * wq + crow(r, hi)] = ssq[r];
    }
    __syncthreads();
    char* Os = lds;
#pragma unroll
    for (int r = 0; r < 16; ++r) {
        const int il = crow(r, hi);
        const float rs = rsqrtf((red[32 * wq + il] + red[128 + 32 * wq + il]) * (1.f / 256.f) + EPS);
#pragma unroll
        for (int db = 0; db < 4; ++db) *(bf16*)(Os + (32 * wq + il) * 528 + (128 * wv + 32 * db + r32) * 2) = f2bf(o[db][r] * rs);
    }
    __syncthreads();
    {
        uint4 uv[8];
#pragma unroll
        for (int k = 0; k < 8; ++k) { const int cidx = tid + NT * k; uv[k] = *(const uint4*)(UR + (size_t)(row0 + (cidx >> 5)) * 1024 + h * 256 + (cidx & 31) * 8); }
#pragma unroll
        for (int k = 0; k < 8; ++k) {
            const int cidx = tid + NT * k;
            const uint4 ov = *(const uint4*)(Os + (cidx >> 5) * 528 + (cidx & 31) * 16);
            float uf[8], of[8]; unpack8(uv[k], uf); unpack8(ov, of);
            uint4 w; w.x = pack2(of[0] * fsilu_(uf[0]), of[1] * fsilu_(uf[1])); w.y = pack2(of[2] * fsilu_(uf[2]), of[3] * fsilu_(uf[3]));
            w.z = pack2(of[4] * fsilu_(uf[4]), of[5] * fsilu_(uf[5])); w.w = pack2(of[6] * fsilu_(uf[6]), of[7] * fsilu_(uf[7]));
            *(uint4*)(UR + (size_t)(row0 + (cidx >> 5)) * 1024 + h * 256 + (cidx & 31) * 8) = w;
        }
    }
    __syncthreads();
}
}

__device__ __forceinline__ void ret3_item(const Params& p, int l, int it, char* smem) {
    int b, h, c;
    if (it < 512) { c = it & 31; h = (it >> 5) & 3; b = it >> 7; }
    else { int j = it - 512; c = 32 + (j & 1); h = (j >> 1) & 3; b = j >> 3; }
    r3::body(p, l, b, h, c, smem);
}

namespace swa {
constexpr int KROWB = 144, VROWB = 136;
constexpr int KT_BYTES = 64 * KROWB, VT_BYTES = 64 * VROWB, BUF_BYTES = KT_BYTES + VT_BYTES;
constexpr float LOG2E = 1.4426950408889634f;
constexpr float THR = 8.f;
__device__ __forceinline__ int crow(int r, int hi) { return (r & 3) + 8 * (r >> 2) + 4 * hi; }

__device__ __forceinline__ void body(const Params& p, int l, int b, int kvh, int qrow0, int q0pos, char* lds) {
    const int tid = otid(), wid = tid >> 6, lane = tid & 63, r32 = lane & 31, hi = lane >> 5;
    bf16* QS = (bf16*)(p.ws + OFF_QS); const bf16* KS = (const bf16*)(p.ws + OFF_KS); const bf16* VT = (const bf16*)(p.ws + OFF_VS);
    float* wsl = (float*)(lds + 2 * BUF_BYTES) + wid * 64; float* li_l = wsl; float* al_l = wsl + 32;
    const int head = kvh * 8 + wid;
    const float sinkv = p.sink[l * 16 + head];
    float m_reg = sinkv, l_reg = 1.f;
    f32x16 o[2] = {};
    bf16x8 qr[4];
    bf16* Qw = QS + (size_t)(qrow0 + r32) * 1024 + head * 64 + hi * 8;
#pragma unroll
    for (int d0 = 0; d0 < 4; ++d0) qr[d0] = *reinterpret_cast<const bf16x8*>(Qw + d0 * 16);
    int t0 = 0, nloc = 0;
    if (q0pos >= 0) {
        const int lo = q0pos - 128 < 0 ? 0 : q0pos - 128, hiq = q0pos + 160 > SEQ ? SEQ : q0pos + 160;
        t0 = lo >> 6; nloc = ((hiq - 1) >> 6) - t0 + 1;
    }
    const int ntiles = nloc + 4;
    const int sk = tid >> 3, sch = tid & 7;
    const bf16* vtb = VT + ((size_t)(b * 2 + kvh) * 64 + sk) * KEYS + sch * 8;
    uint4 rkA, rvA, rkB, rvB;
#define TLOAD(t, RK, RV) do { const int t_ = (t); const bool loc_ = t_ < nloc; const int key0_ = loc_ ? (t0 + t_) * 64 : 4096 + (t_ - nloc) * 64; \
        const int krow_ = loc_ ? b * SEQ + key0_ : TLAT + b * CTXL + (t_ - nloc) * 64; \
        RK = *(const uint4*)(KS + (size_t)(krow_ + sk) * 128 + kvh * 64 + sch * 8); RV = *(const uint4*)(vtb + key0_); } while (0)
#define TWRITE(buf, RK, RV) do { char* kb_ = lds + (buf) * BUF_BYTES; *(uint4*)(kb_ + sk * KROWB + sch * 16) = RK; \
        char* vb_ = kb_ + KT_BYTES + sk * VROWB + sch * 16; *(uint2*)vb_ = make_uint2(RV.x, RV.y); *(uint2*)(vb_ + 8) = make_uint2(RV.z, RV.w); } while (0)
#define TILE_COMPUTE(t) do { \
        const char* Kb = lds + ((t) & 1) * BUF_BYTES; const char* Vb = Kb + KT_BYTES; \
        f32x16 p0 = {}, p1 = {}; \
        _Pragma("unroll") for (int d0 = 0; d0 < 4; ++d0) { \
            bf16x8 k0 = *reinterpret_cast<const bf16x8*>(Kb + r32 * KROWB + (d0 * 16 + hi * 8) * 2); \
            bf16x8 k1 = *reinterpret_cast<const bf16x8*>(Kb + (32 + r32) * KROWB + (d0 * 16 + hi * 8) * 2); \
            p0 = __builtin_amdgcn_mfma_f32_32x32x16_bf16(k0, qr[d0], p0, 0, 0, 0); \
            p1 = __builtin_amdgcn_mfma_f32_32x32x16_bf16(k1, qr[d0], p1, 0, 0, 0); } \
        if ((t) < nloc && !((t0 + (t)) * 64 >= q0pos - 97 && (t0 + (t)) * 64 + 63 <= q0pos + 128)) { const int kbase = (t0 + (t)) * 64 - (q0pos + r32); \
            _Pragma("unroll") for (int r = 0; r < 16; ++r) { int d0_ = kbase + crow(r, hi); int d1_ = d0_ + 32; \
                if (d0_ < -128 || d0_ > 128) p0[r] = -1e30f; if (d1_ < -128 || d1_ > 128) p1[r] = -1e30f; } } \
        float pmax = p0[0]; \
        _Pragma("unroll") for (int r = 1; r < 16; ++r) pmax = fmaxf(pmax, p0[r]); \
        _Pragma("unroll") for (int r = 0; r < 16; ++r) pmax = fmaxf(pmax, p1[r]); \
        { auto rr = __builtin_amdgcn_permlane32_swap(__float_as_uint(pmax), __float_as_uint(pmax), false, false); \
          pmax = fmaxf(__uint_as_float(rr[0]), __uint_as_float(rr[1])); } \
        float alpha = 1.f; \
        if (!__all(pmax - m_reg <= THR)) { const float mn = fmaxf(m_reg, pmax); \
            alpha = __builtin_amdgcn_exp2f((m_reg - mn) * LOG2E); m_reg = mn; \
            if (hi == 0) al_l[r32] = alpha; \
            asm volatile("s_waitcnt lgkmcnt(0)" ::: "memory"); \
            _Pragma("unroll") for (int d = 0; d < 2; ++d) _Pragma("unroll") for (int r = 0; r < 16; ++r) o[d][r] *= al_l[crow(r, hi)]; } \
        const float mC = -m_reg * LOG2E; float ps = 0.f; \
        _Pragma("unroll") for (int r = 0; r < 16; ++r) { p0[r] = __builtin_amdgcn_exp2f(fmaf(p0[r], LOG2E, mC)); ps += p0[r]; } \
        _Pragma("unroll") for (int r = 0; r < 16; ++r) { p1[r] = __builtin_amdgcn_exp2f(fmaf(p1[r], LOG2E, mC)); ps += p1[r]; } \
        { auto rr = __builtin_amdgcn_permlane32_swap(__float_as_uint(ps), __float_as_uint(ps), false, false); \
          ps = __uint_as_float(rr[0]) + __uint_as_float(rr[1]); } \
        l_reg = l_reg * alpha + ps; \
        _Pragma("unroll") for (int s4 = 0; s4 < 4; ++s4) { unsigned w0, w1, w2, w3; \
            if (s4 < 2) { w0 = pack2(p0[8 * s4 + 0], p0[8 * s4 + 1]); w1 = pack2(p0[8 * s4 + 2], p0[8 * s4 + 3]); w2 = pack2(p0[8 * s4 + 4], p0[8 * s4 + 5]); w3 = pack2(p0[8 * s4 + 6], p0[8 * s4 + 7]); } \
            else { const int s2 = s4 - 2; w0 = pack2(p1[8 * s2 + 0], p1[8 * s2 + 1]); w1 = pack2(p1[8 * s2 + 2], p1[8 * s2 + 3]); w2 = pack2(p1[8 * s2 + 4], p1[8 * s2 + 5]); w3 = pack2(p1[8 * s2 + 6], p1[8 * s2 + 7]); } \
            ga::u32x4 pw = {w0, w1, w2, w3}; bf16x8 pa = *reinterpret_cast<bf16x8*>(&pw); \
            _Pragma("unroll") for (int db = 0; db < 2; ++db) { \
                const char* vp = Vb + (db * 32 + r32) * VROWB + (16 * s4 + 4 * hi) * 2; \
                uint2 lo = *(const uint2*)vp, hi2 = *(const uint2*)(vp + 16); \
                ga::u32x4 bw = {lo.x, lo.y, hi2.x, hi2.y}; bf16x8 vb = *reinterpret_cast<bf16x8*>(&bw); \
                o[db] = __builtin_amdgcn_mfma_f32_32x32x16_bf16(pa, vb, o[db], 0, 0, 0); } } \
    } while (0)
    TLOAD(0, rkA, rvA); TLOAD(1, rkB, rvB);
    TWRITE(0, rkA, rvA); __syncthreads();
    int t = 0;
    for (; t + 1 < ntiles; t += 2) {
        if (t + 2 < ntiles) TLOAD(t + 2, rkA, rvA);
        TILE_COMPUTE(t);
        TWRITE(1, rkB, rvB);
        __syncthreads();
        if (t + 3 < ntiles) TLOAD(t + 3, rkB, rvB);
        TILE_COMPUTE(t + 1);
        if (t + 2 < ntiles) TWRITE(0, rkA, rvA);
        __syncthreads();
    }
    if (t < ntiles) { TILE_COMPUTE(t); __syncthreads(); }
#undef TILE_COMPUTE
    if (hi == 0) li_l[r32] = l_reg;
    asm volatile("s_waitcnt lgkmcnt(0)" ::: "memory");
    bf16* Ow = QS + (size_t)qrow0 * 1024 + head * 64;
#pragma unroll
    for (int r = 0; r < 16; ++r) {
        const int orow = crow(r, hi); const float rl = 1.f / li_l[orow];
#pragma unroll
        for (int db = 0; db < 2; ++db) Ow[(size_t)orow * 1024 + db * 32 + r32] = f2bf(o[db][r] * rl);
    }
    __syncthreads();
#undef TLOAD
#undef TWRITE
}
}

__device__ __forceinline__ void swa_item(const Params& p, int l, int it, char* smem) {
    if (it < 1024) {
        const int pair = it & 7, j = it >> 3, b = pair >> 1, kvh = pair & 1;
        swa::body(p, l, b, kvh, b * SEQ + j * 32, j * 32, smem);
    } else {
        const int j = it - 1024, pair = j & 7, qb = j >> 3, b = pair >> 1, kvh = pair & 1;
        swa::body(p, l, b, kvh, TLAT + b * CTXL + qb * 32, -1, smem);
    }
}
__device__ __forceinline__ void phase_mixA(const Params& p, int l, char* smem) {
    const int ncg = (l == 0) ? 48 : 0;
    const int total = 256 + ncg + 16 * 34 * 2;
    for (int it = blockIdx.x; it < total; it += gridDim.x) {
        if (it < 256) ga_item(p, l, it, smem);
        else if (it < 256 + ncg) ctx_gate_item(p, it - 256, smem);
        else ret1_item(p, l, it - 256 - ncg, smem);
    }
}
__device__ __forceinline__ void phase_mixB(const Params& p, int l, char* smem) {
    const int n_r3 = 512 + (l == 0 ? 32 : 0), n_sw = 1024 + (l == 0 ? 64 : 0), n_gc = (l == 0 ? 32 : 0);
    const int total = 256 + n_r3 + n_sw + n_gc;
    for (int it = blockIdx.x; it < total; it += gridDim.x) {
        if (it < 256) ga_item(p, l, 256 + it, smem);
        else if (it < 256 + n_r3) ret3_item(p, l, it - 256, smem);
        else if (it < 256 + n_r3 + n_sw) swa_item(p, l, it - 256 - n_r3, smem);
        else ga_item(p, l, 512 + (it - 256 - n_r3 - n_sw), smem);
    }
}

#define XB_TMO      128
#define XB_XCNT(j)  (256  + 64 * (j))
#define XB_XSUB(j)  (1280 + 64 * (j))
#define XB_XGEN(j)  (2304 + 64 * (j))
#define XB_TOP      3328
#define XB_TOPGEN   3392
#define XCD_BAR_WORDS 3456
#define XB_SPIN_CAP (1u << 22)
#define LAS __attribute__((address_space(3)))
__device__ __forceinline__ unsigned xb_ld(unsigned* p)              { return __hip_atomic_load(p, __ATOMIC_RELAXED, __HIP_MEMORY_SCOPE_AGENT); }
__device__ __forceinline__ unsigned xb_add(unsigned* p, unsigned v) { return __hip_atomic_fetch_add(p, v, __ATOMIC_RELAXED, __HIP_MEMORY_SCOPE_AGENT); }
__device__ __forceinline__ unsigned xb_xcc_id() { return (unsigned)__builtin_amdgcn_s_getreg((3 << 11) | 20) & 0xFu; }
#define XB_SPIN(cond, bar) do { unsigned _sp = 0; while (cond) { __builtin_amdgcn_s_sleep(1); \
    if ((++_sp & 255u) == 0u) { if (xb_ld(&(bar)[XB_TMO])) break; if (_sp > XB_SPIN_CAP) { atomicAdd(&(bar)[XB_TMO], 1u); break; } } } } while (0)
struct XcdBarrier { unsigned* bar; unsigned x; volatile LAS unsigned* st; };
__device__ __forceinline__ XcdBarrier xcd_barrier_post(unsigned* bar, volatile LAS unsigned* st) {
    XcdBarrier b; b.bar = bar; b.x = xb_xcc_id(); b.st = st;
    if (threadIdx.x == 0) (void)xb_add(&bar[XB_XCNT(b.x)], 1u);
    return b;
}
__device__ __forceinline__ void xcd_barrier_complete(unsigned* bar, unsigned x, unsigned& nloc, unsigned& nx) {
    const unsigned G = gridDim.x * gridDim.y * gridDim.z;
    unsigned sum, cnt, mine, sp = 0u;
    for (;;) {
        sum = 0u; cnt = 0u; mine = 0u;
#pragma unroll
        for (unsigned j = 0; j < 16; ++j) { const unsigned c = xb_ld(&bar[XB_XCNT(j)]); sum += c; cnt += (c > 0u) ? 1u : 0u; mine = (j == x) ? c : mine; }
        if (sum == G) break;
        __builtin_amdgcn_s_sleep(1);
        if ((++sp & 255u) == 0u) { if (xb_ld(&bar[XB_TMO])) break; if (sp > XB_SPIN_CAP) { atomicAdd(&bar[XB_TMO], 1u); break; } }
    }
    nloc = mine > 0u ? mine : 1u; nx = cnt > 0u ? cnt : 1u;
}
__device__ __forceinline__ void xcd_barrier(const XcdBarrier& b) {
    asm volatile("s_waitcnt vmcnt(0)" ::: "memory");
    __syncthreads();
    if (threadIdx.x == 0) {
        unsigned* bar = b.bar;
        __builtin_amdgcn_s_waitcnt(0);
        unsigned nloc = b.st[0], nx = b.st[1];
        if (nloc == 0u) { xcd_barrier_complete(bar, b.x, nloc, nx); b.st[0] = nloc; b.st[1] = nx; }
        const unsigned old = xb_add(&bar[XB_XSUB(b.x)], 1u);
        const unsigned gen = old / nloc;
        if (old + 1u == (gen + 1u) * nloc) {
            __builtin_amdgcn_fence(__ATOMIC_RELEASE, "agent");
            asm volatile("s_waitcnt vmcnt(0)" ::: "memory");
            const unsigned og = xb_add(&bar[XB_TOP], 1u);
            const unsigned tg = og / nx;
            if (og + 1u == (tg + 1u) * nx) xb_add(&bar[XB_TOPGEN], 1u);
            else XB_SPIN(xb_ld(&bar[XB_TOPGEN]) == tg, bar);
            __builtin_amdgcn_fence(__ATOMIC_ACQUIRE, "agent");
            xb_add(&bar[XB_XGEN(b.x)], 1u);
            asm volatile("s_waitcnt vmcnt(0)" ::: "memory");
        } else {
            XB_SPIN(xb_ld(&bar[XB_XGEN(b.x)]) == gen, bar);
            __builtin_amdgcn_fence(__ATOMIC_ACQUIRE, "agent");
            asm volatile("s_waitcnt vmcnt(0)" ::: "memory");
        }
    }
    __syncthreads();
}

constexpr int PH_PER_LAYER = 11;
constexpr int NPHASE = 2 + 2 * PH_PER_LAYER;
constexpr int LDS_BYTES = pg8::STAGE_BYTES + 4096;

__device__ __forceinline__ void run_phase(const Params& p, int ph, char* smem) {
#ifndef PHASE_MASK
    if (ph == 0) { phase0(p, smem); return; }
    if (ph == NPHASE - 1) { phase_final(p); return; }
#else
    if (ph == 0 || ph == NPHASE - 1) return;
#endif
    const int l = (ph - 1) / PH_PER_LAYER, s = (ph - 1) % PH_PER_LAYER;
#ifdef PHASE_MASK
    if (!((PHASE_MASK >> s) & 1)) return;
#endif
    switch (s) {
        case 0: phase_norm1(p, l); break;
        case 1: phase_inproj(p, l, smem); break;
        case 2: phase_mixA(p, l, smem); break;
        case 3: phase_ret_scan(p, l); break;
        case 4: phase_mixB(p, l, smem); break;
        case 5: phase_gates(p, l, smem); break;
        case 6: phase_merge(p, l, smem); break;
        case 7: phase_outproj(p, l, smem); break;
        case 8: {
            phase_norm2(p, l, smem);
        } break;
        case 9: phase_moe1(p, l, smem); break;
        case 10: phase_moe2(p, l, smem); break;
    }
}

__global__ void __launch_bounds__(NT, 2) mega(Params p) {
    extern __shared__ __attribute__((aligned(16))) char smem[];
    cg::grid_group grid = cg::this_grid();
    volatile LAS unsigned* st = (volatile LAS unsigned*)(smem + LDS_BYTES);
    if (threadIdx.x < 4) st[threadIdx.x] = 0u;
    __syncthreads();
    XcdBarrier bar = xcd_barrier_post((unsigned*)(p.ws + OFF_BAR), st);
    for (int ph = p.ph_lo; ph < p.ph_hi; ++ph) {
        run_phase(p, ph, smem);
        if (ph + 1 < p.ph_hi) {
            if (ph == p.ph_lo) grid.sync();
            else xcd_barrier(bar);
        }
    }
}

extern "C" void kernel_launch(void* const* d_in, const int* in_sizes, int n_in, void* d_out, int out_size, void* d_ws, size_t ws_size,
                              hipStream_t stream) {
    static int grid_blocks = 0;
    if (!grid_blocks) {
        int dev = 0, cus = 0, per_cu = 0;
        hipGetDevice(&dev);
        hipDeviceGetAttribute(&cus, hipDeviceAttributeMultiprocessorCount, dev);
        hipFuncSetAttribute((const void*)mega, hipFuncAttributeMaxDynamicSharedMemorySize, LDS_BYTES + 16);
        hipOccupancyMaxActiveBlocksPerMultiprocessor(&per_cu, (const void*)mega, NT, LDS_BYTES + 16);
        if (per_cu < 1) { fprintf(stderr, "occupancy query returned %d\n", per_cu); per_cu = 1; }
        if (per_cu > 1) per_cu = 1;
        grid_blocks = cus * per_cu; if (grid_blocks > MAXBLK) grid_blocks = MAXBLK;
        if (ws_size < WS_END) fprintf(stderr, "workspace too small: %zu < %zu\n", ws_size, (size_t)WS_END);
    }
    Params p{};
    const float** f = (const float**)&p;
    for (int i = 0; i < 23; ++i) f[i] = (const float*)d_in[i];
    p.out = (float*)d_out; p.ws = (unsigned char*)d_ws;
#if MULTI_LAUNCH
    for (int ph = 0; ph < NPHASE; ++ph) {
        p.ph_lo = ph; p.ph_hi = ph + 1;
        hipMemsetAsync((char*)d_ws + OFF_BAR, 0, 16384, stream);
        hipLaunchKernelGGL(mega, dim3(grid_blocks), dim3(NT), LDS_BYTES + 16, stream, p);
    }
#else
    p.ph_lo = 0; p.ph_hi = NPHASE;
    void* args[] = {&p};
    hipMemsetAsync((char*)d_ws + OFF_BAR, 0, 16384, stream);
    hipError_t e = hipLaunchCooperativeKernel((const void*)mega, dim3(grid_blocks), dim3(NT), args, LDS_BYTES + 16, stream);
    if (e != hipSuccess) fprintf(stderr, "cooperative launch failed: %s (grid %d)\n", hipGetErrorString(e), grid_blocks);
#endif
}
```

```cpp
#include <hip/hip_runtime.h>
#include <hip/hip_cooperative_groups.h>
#include <cstdio>
#include <cstdint>
namespace cg = cooperative_groups;

#ifndef MULTI_LAUNCH
#define MULTI_LAUNCH 0
#endif

typedef unsigned short bf16;
typedef __attribute__((ext_vector_type(8))) short bf16x8;
typedef __attribute__((ext_vector_type(16))) float f32x16;

constexpr int NT = 512;
constexpr int D = 1024, NB = 4, SEQ = 4096, CTXL = 256;
constexpr int TLAT = NB * SEQ, TCTX = NB * CTXL, TALL = TLAT + TCTX;
constexpr int DIN = 8960, DQKV = 5888;
constexpr int NEXP = 16, DEXP = 512;
constexpr float EPS = 1e-6f;

constexpr size_t OFF_CTL  = 0;
constexpr size_t OFF_BAR  = 4096;
constexpr size_t OFF_LTS  = 4096 + 16384;
constexpr size_t OFF_LW   = OFF_LTS + (size_t)16 * TALL * 4;
constexpr size_t OFF_MOD  = OFF_LW + (size_t)16 * TALL * 4;
constexpr size_t OFF_ROPE = OFF_MOD + (size_t)2 * 5 * 6144 * 4;
constexpr size_t OFF_DEC  = OFF_ROPE + 65536;
constexpr size_t OFF_CX   = OFF_DEC + 32768;
constexpr size_t OFF_H    = OFF_CX + (size_t)TCTX * D * 4;
constexpr size_t OFF_QR   = OFF_H + (size_t)TALL * 1024 * 2;
constexpr size_t OFF_KR   = OFF_QR + (size_t)TALL * 512 * 2;
constexpr size_t OFF_VR   = OFF_KR + (size_t)TALL * 512 * 2;
constexpr size_t OFF_UR   = OFF_VR + (size_t)TALL * 1024 * 2;
constexpr size_t OFF_QS   = OFF_UR + (size_t)TALL * 1024 * 2;
constexpr size_t OFF_KS   = OFF_QS + (size_t)TALL * 1024 * 2;
constexpr size_t OFF_VS   = OFF_KS + (size_t)TALL * 128 * 2;
constexpr size_t OFF_QA   = OFF_VS + (size_t)TALL * 128 * 2;
constexpr size_t OFF_KA   = OFF_QA + (size_t)TALL * 1024 * 2;
constexpr size_t OFF_VA   = OFF_KA + (size_t)TALL * 256 * 2;
constexpr size_t OFF_F    = OFF_VA + (size_t)TALL * 256 * 2;
constexpr size_t F_BYTES  = (size_t)71303168;
constexpr size_t OFF_WT   = OFF_F + F_BYTES;
constexpr int WR_G = 6656, WR_BR = 9728, WR_OUT = 12800, WT_ROWS = 13824;
constexpr size_t WT_LAYER = (size_t)WT_ROWS * 1024 * 2;
constexpr size_t OFF_KFT  = OFF_WT + WT_LAYER;
constexpr size_t OFF_KBT  = OFF_KFT + (size_t)16 * 128 * 4352 * 2;
constexpr size_t OFF_SM   = OFF_KBT + (size_t)16 * 128 * 4352 * 2;
constexpr int MAXBLK = 320;
constexpr size_t OFF_GC   = OFF_SM + (size_t)MAXBLK * 128 * 128 * 2;
constexpr size_t OFF_PC   = OFF_GC + (size_t)3 * 1024 * 1024 * 2;
constexpr size_t WS_END   = OFF_PC + (size_t)3 * 1024 * 1024 * 2;
constexpr int KEYS = 4352;
constexpr size_t OFF_Y    = OFF_QR;
constexpr size_t OFF_HB   = OFF_VR;
constexpr size_t OFF_YB   = OFF_QS;
constexpr size_t OFF_WGU  = OFF_F;
__host__ __device__ constexpr size_t wgu_off(int l, int e) { return (l == 1 && e < 8 ? OFF_SM : OFF_WGU) + (size_t)e * 1024 * 2048; }
constexpr size_t OFF_WD   = OFF_F + (size_t)16 * 1024 * 1024 * 2;

struct Params {
    const float *x, *c, *ctx, *c_ctx, *w_mod, *b_mod, *g1, *g2, *w_in, *ret_logit, *sink, *gq, *gk,
                *w_br_ret, *w_br_swa, *w_br_ga, *w_out, *w_router, *b_router, *w_gate, *w_up, *w_down, *g_final;
    float* out;
    unsigned char* ws;
    int ph_lo, ph_hi;
};

__device__ __forceinline__ int otid() { int t = threadIdx.x; asm volatile("" : "+v"(t)); return t; }
__device__ __forceinline__ bf16 f2bf(float f) { unsigned u = __float_as_uint(f); u += 0x7fffu + ((u >> 16) & 1u); return (bf16)(u >> 16); }
__device__ __forceinline__ float bf2f(bf16 h) { return __uint_as_float(((unsigned)h) << 16); }
typedef float f32x2_t __attribute__((ext_vector_type(2)));
typedef __bf16 bf16x2_t __attribute__((ext_vector_type(2)));
__device__ __forceinline__ unsigned pack2(float a, float b) { f32x2_t v = {a, b}; bf16x2_t r = __builtin_convertvector(v, bf16x2_t); return __builtin_bit_cast(unsigned, r); }
__device__ __forceinline__ float lo2f(unsigned u) { return __uint_as_float(u << 16); }
__device__ __forceinline__ float hi2f(unsigned u) { return __uint_as_float(u & 0xffff0000u); }
__device__ __forceinline__ void unpack8(uint4 u, float (&f)[8]) {
    f[0] = lo2f(u.x); f[1] = hi2f(u.x); f[2] = lo2f(u.y); f[3] = hi2f(u.y); f[4] = lo2f(u.z); f[5] = hi2f(u.z); f[6] = lo2f(u.w); f[7] = hi2f(u.w);
}
__device__ __forceinline__ float shx(float v, int o, int lane) { return __int_as_float(__builtin_amdgcn_ds_bpermute((lane ^ o) << 2, __float_as_int(v))); }
__device__ __forceinline__ int shup(int v, int o, int lane) { return __builtin_amdgcn_ds_bpermute(((lane - o) & 63) << 2, v); }
__device__ __forceinline__ float wsum(float v, int lane) {
#pragma unroll
    for (int o = 32; o > 0; o >>= 1) v += shx(v, o, lane);
    return v;
}
__device__ __forceinline__ float reduce16(const float (&v)[16], int lane) {
    float w[8], x[4], y[2];
#pragma unroll
    for (int i = 0; i < 8; ++i) { auto r = __builtin_amdgcn_permlane32_swap(__float_as_uint(v[i]), __float_as_uint(v[i + 8]), false, false);
        w[i] = __uint_as_float(r[0]) + __uint_as_float(r[1]); }
    const bool b4 = lane & 16, b3 = lane & 8, b2 = lane & 4;
#pragma unroll
    for (int i = 0; i < 4; ++i) { const float keep = b4 ? w[i + 4] : w[i], send = b4 ? w[i] : w[i + 4]; x[i] = keep + shx(send, 16, lane); }
#pragma unroll
    for (int i = 0; i < 2; ++i) { const float keep = b3 ? x[i + 2] : x[i], send = b3 ? x[i] : x[i + 2]; y[i] = keep + shx(send, 8, lane); }
    float z; { const float keep = b2 ? y[1] : y[0], send = b2 ? y[0] : y[1]; z = keep + shx(send, 4, lane); }
    z += shx(z, 1, lane); z += shx(z, 2, lane);
    return z;
}
__device__ __forceinline__ float wmax(float v, int lane) {
#pragma unroll
    for (int o = 32; o > 0; o >>= 1) v = fmaxf(v, shx(v, o, lane));
    return v;
}
__device__ __forceinline__ float fexp_(float x) { return __builtin_amdgcn_exp2f(x * 1.4426950408889634f); }
__device__ __forceinline__ float flogsig_(float x) { return -0.6931471805599453f * __builtin_amdgcn_logf(1.f + fexp_(-x)); }
__device__ __forceinline__ float sigmoidf_(float x) { return 1.f / (1.f + expf(-x)); }
__device__ __forceinline__ float siluf_(float x) { return x / (1.f + expf(-x)); }
__device__ __forceinline__ float fsilu_(float x) { return x * __builtin_amdgcn_rcpf(1.f + __builtin_amdgcn_exp2f(-1.4426950408889634f * x)); }

__device__ __forceinline__ void mod_item(const Params& p, int item, char* smem) {
    float* sc = (float*)smem;
    float* red = sc + 5 * 1024;
    const int tid = otid();
    for (int i = tid; i < 5 * 1024; i += NT) {
        int v = i >> 10, k = i & 1023;
        float xv = v < 4 ? p.c[v * 1024 + k] : p.c_ctx[k];
        sc[i] = siluf_(xv);
    }
    __syncthreads();
    const int l = item / 96, cgp = item % 96, cq = tid & 15, ks = tid >> 4;
    const float* w = p.w_mod + (size_t)l * 1024 * 6144 + cgp * 64 + cq * 4;
    float4 a0 = {0, 0, 0, 0}, a1 = a0, a2 = a0, a3 = a0, a4 = a0;
#pragma unroll 8
    for (int kk = 0; kk < 32; ++kk) {
        const int k = ks * 32 + kk;
        const float4 wv = *(const float4*)(w + (size_t)k * 6144);
        const float s0 = sc[k], s1 = sc[1024 + k], s2 = sc[2048 + k], s3 = sc[3072 + k], s4 = sc[4096 + k];
        a0.x += s0 * wv.x; a0.y += s0 * wv.y; a0.z += s0 * wv.z; a0.w += s0 * wv.w;
        a1.x += s1 * wv.x; a1.y += s1 * wv.y; a1.z += s1 * wv.z; a1.w += s1 * wv.w;
        a2.x += s2 * wv.x; a2.y += s2 * wv.y; a2.z += s2 * wv.z; a2.w += s2 * wv.w;
        a3.x += s3 * wv.x; a3.y += s3 * wv.y; a3.z += s3 * wv.z; a3.w += s3 * wv.w;
        a4.x += s4 * wv.x; a4.y += s4 * wv.y; a4.z += s4 * wv.z; a4.w += s4 * wv.w;
    }
    *(float4*)(red + (ks * 5 + 0) * 64 + cq * 4) = a0; *(float4*)(red + (ks * 5 + 1) * 64 + cq * 4) = a1; *(float4*)(red + (ks * 5 + 2) * 64 + cq * 4) = a2;
    *(float4*)(red + (ks * 5 + 3) * 64 + cq * 4) = a3; *(float4*)(red + (ks * 5 + 4) * 64 + cq * 4) = a4;
    __syncthreads();
    if (tid < 320) {
        int v = tid >> 6, c2 = tid & 63; float sum = 0;
        for (int k2 = 0; k2 < 32; ++k2) sum += red[(k2 * 5 + v) * 64 + c2];
        float* mod = (float*)(p.ws + OFF_MOD);
        mod[(size_t)(l * 5 + v) * 6144 + cgp * 64 + c2] = sum + p.b_mod[l * 6144 + cgp * 64 + c2];
    }
    __syncthreads();
}

__device__ __forceinline__ int inproj_col_normal(int unit, int p) {
    const int bj = p >> 7, w = p & 127;
    const int r128 = 128 * (w >> 6) + 64 * ((w >> 5) & 1) + 32 * bj + (w & 31);
    if (unit < 2) return 0 + 256 * unit + r128;
    if (unit < 4) return 512 + 256 * (unit - 2) + r128;
    if (unit < 8) return 2048 + 256 * (unit - 4) + p;
    if (unit < 12) return 3072 + 256 * (unit - 8) + 64 * (w >> 5) + 32 * ((w >> 4) & 1) + 16 * bj + (w & 15);
    if (unit == 12) return 4096 + 64 * ((w >> 5) & 1) + 32 * ((w >> 4) & 1) + 16 * bj + (w & 15);
    if (unit < 17) return 4352 + 256 * (unit - 13) + r128;
    if (unit == 17) return 5376 + r128;
    return 5632 + p;
}
__device__ __forceinline__ int inproj_col_swapped(int sidx, int r) {
    const int ai = r >> 7, w = r & 127;
    if (sidx < 4) return 1024 + 256 * sidx + r;
    if (sidx < 6) return 512 + 128 * (2 * (sidx - 4) + (w >> 6)) + 64 * ((w >> 5) & 1) + 32 * ai + (w & 31);
    return 4224 + (r & 127);
}

constexpr int CONV_NONMOE = 16 * (WT_ROWS / 256);
constexpr int CONV_MOE = 1024 + 512;
struct ConvTile { const float* s[4]; int ld; bf16* dst; int dld; };
__device__ __forceinline__ ConvTile conv_tile_nonmoe(const Params& p, int l, int it) {
    ConvTile t; const int lane64 = otid() & 63;
    const int kt = it & 15, rg = it >> 4;
    t.dst = (bf16*)(p.ws + OFF_WT) + (size_t)rg * 256 * 1024 + kt * 64; t.dld = 1024;
#pragma unroll
    for (int j = 0; j < 4; ++j) {
        const int R = rg * 256 + lane64 + 64 * j;
        const float* src; int ld, col;
        if (R < WR_G) { src = p.w_in + (size_t)l * 1024 * DIN; ld = DIN;
            if (R < 4864) col = inproj_col_normal(R >> 8, R & 255); else col = inproj_col_swapped((R - 4864) >> 8, (R - 4864) & 255); }
        else if (R < WR_BR) { src = p.w_in + (size_t)l * 1024 * DIN; ld = DIN; col = 5888 + (R - WR_G); }
        else if (R < WR_OUT) { const int br = (R - WR_BR) >> 10; src = (br == 0 ? p.w_br_ret : br == 1 ? p.w_br_swa : p.w_br_ga) + (size_t)l * 1024 * 1024; ld = 1024; col = (R - WR_BR) & 1023; }
        else { src = p.w_out + (size_t)l * 1024 * 1024; ld = 1024; col = R - WR_OUT; }
        t.s[j] = src + (size_t)kt * 64 * ld + col; t.ld = ld;
    }
    return t;
}
__device__ __forceinline__ ConvTile conv_tile_moe(const Params& p, int l, int it) {
    ConvTile t; const int lane64 = otid() & 63;
    if (it < 1024) {
        const int kt = it & 15, u = (it >> 4) & 3, e = it >> 6;
        t.dst = (bf16*)(p.ws + wgu_off(l, e)) + (size_t)(u * 256) * 1024 + kt * 64; t.dld = 1024; t.ld = 512;
#pragma unroll
        for (int j = 0; j < 4; ++j) {
            const float* src = (j < 2 ? p.w_gate : p.w_up) + ((size_t)(l * 16 + e) * 1024 + (size_t)kt * 64) * 512;
            t.s[j] = src + 128 * u + lane64 + 64 * (j & 1);
        }
    } else {
        const int i2 = it - 1024; const int kt = i2 & 7, g = (i2 >> 3) & 3, e = i2 >> 5;
        t.dst = (bf16*)(p.ws + OFF_WD) + ((size_t)e * 1024 + g * 256) * 512 + kt * 64; t.dld = 512; t.ld = 1024;
#pragma unroll
        for (int j = 0; j < 4; ++j) t.s[j] = p.w_down + ((size_t)(l * 16 + e) * 512 + (size_t)kt * 64) * 1024 + 256 * g + lane64 + 64 * j;
    }
    return t;
}
__device__ __forceinline__ void conv_run(const Params& p, int l, int which, char* smem, int b0 = 0, int t_lo = 0, int t_hi = -1) {
    const int tid = otid(), wave = tid >> 6, lane = tid & 63;
    const int ntiles = t_hi < 0 ? (which ? CONV_MOE : CONV_NONMOE) : t_hi;
    unsigned* T = (unsigned*)smem;
    float va[4][8], vb[4][8];
    if ((int)blockIdx.x < b0) return;
    const int cstride = gridDim.x - b0;
    int it = t_lo + (int)blockIdx.x - b0;
    if (it >= ntiles) return;
    ConvTile ct = which ? conv_tile_moe(p, l, it) : conv_tile_nonmoe(p, l, it);
#define CONV_LOAD(dstv, tile) do { _Pragma("unroll") for (int j = 0; j < 4; ++j) _Pragma("unroll") for (int r = 0; r < 8; ++r) dstv[j][r] = (tile).s[j][(size_t)(wave * 8 + r) * (tile).ld]; } while (0)
    CONV_LOAD(va, ct);
    for (;;) {
        const int nit = it + cstride; const bool more = nit < ntiles;
        ConvTile nt = ct;
        if (more) { nt = which ? conv_tile_moe(p, l, nit) : conv_tile_nonmoe(p, l, nit); CONV_LOAD(vb, nt); }
#pragma unroll
        for (int j = 0; j < 4; ++j)
#pragma unroll
            for (int r = 0; r < 8; r += 2) T[(lane + 64 * j) * 33 + wave * 4 + (r >> 1)] = pack2(va[j][r], va[j][r + 1]);
        __syncthreads();
        {
            const int n = tid >> 1, half = tid & 1;
            const unsigned* row = T + n * 33 + half * 16;
            uint4 o0, o1, o2, o3;
            o0.x = row[0]; o0.y = row[1]; o0.z = row[2]; o0.w = row[3]; o1.x = row[4]; o1.y = row[5]; o1.z = row[6]; o1.w = row[7];
            o2.x = row[8]; o2.y = row[9]; o2.z = row[10]; o2.w = row[11]; o3.x = row[12]; o3.y = row[13]; o3.z = row[14]; o3.w = row[15];
            uint4* d = (uint4*)(ct.dst + (size_t)n * ct.dld + half * 32);
            d[0] = o0; d[1] = o1; d[2] = o2; d[3] = o3;
        }
        __syncthreads();
        if (!more) break;
        it = nit; ct = nt;
#pragma unroll
        for (int j = 0; j < 4; ++j)
#pragma unroll
            for (int r = 0; r < 8; ++r) va[j][r] = vb[j][r];
    }
#undef CONV_LOAD
}

__device__ __forceinline__ void phase0(const Params& p, char* smem) {
    const int tid = otid();
    if (blockIdx.x == 0) { int* ctl = (int*)(p.ws + OFF_CTL); if (tid < 64) ctl[tid] = 0; }
    {
        const int tb = gridDim.x > 192 ? 192 : 0;
        const int nb = (int)gridDim.x - tb, b0 = (int)blockIdx.x - tb;
        if (b0 >= 0) {
            const int g0 = b0 * NT + otid(); const int gs = nb * NT;
            float* rp = (float*)(p.ws + OFF_ROPE);
            for (int i = g0; i < 64 * 32; i += gs) {
                int pos = i >> 5, j = i & 31;
                float fr = exp2f(-(float)j * (13.287712379549449f / 32.f)); float a = (float)pos * fr;
                rp[i] = cosf(a); rp[2048 + i] = sinf(a);
            }
            for (int i = g0; i < 64 * 16; i += gs) {
                int pos = i >> 4, j = i & 15;
                float fr = exp2f(-(float)j * (13.287712379549449f / 16.f)); float a = (float)pos * fr;
                rp[4096 + i] = cosf(a); rp[4096 + 1024 + i] = sinf(a);
            }
            for (int i = g0; i < 64 * 32; i += gs) {
                int j = i >> 6, pos = i & 63;
                float fr = exp2f(-(float)j * (13.287712379549449f / 32.f)); float a = (float)pos * fr;
                rp[6144 + i] = cosf(a); rp[8192 + i] = sinf(a);
            }
            float* dec = (float*)(p.ws + OFF_DEC);
            if (g0 < 16) { const float x = p.ret_logit[g0]; dec[g0] = flogsig_(x); }
            if (b0 == 0 && tid < 64) {
#pragma unroll
                for (int l2 = 0; l2 < 2; ++l2) {
                    float mq = fmaxf(fabsf(p.gq[l2 * 128 + tid]), fabsf(p.gq[l2 * 128 + 64 + tid])), mk = fmaxf(fabsf(p.gk[l2 * 128 + tid]), fabsf(p.gk[l2 * 128 + 64 + tid]));
                    mq = wmax(mq, tid); mk = wmax(mk, tid);
                    if (tid == 0) dec[16 + l2] = 128.f * mq * mk;
                }
            }
            for (int i = g0; i < 2 * 4 * 128; i += gs) {
                const int j = i & 127, h = (i >> 7) & 3, l = i >> 9;
                const float lgf = flogsig_(p.ret_logit[l * 8 + h]), lgb = flogsig_(p.ret_logit[l * 8 + 4 + h]);
                float* d = dec + 64 + (size_t)((l * 4 + h) * 6) * 128;
                const float ks = 0.08838834764831845f;
                d[j] = ks * fexp_((float)(127 - j) * lgf); d[128 + j] = ks * fexp_((float)j * lgb);
                d[256 + j] = fexp_((float)(j + 1) * lgf); d[384 + j] = fexp_((float)(128 - j) * lgb);
                d[512 + j] = fexp_((float)j * lgf); d[640 + j] = fexp_((float)j * lgb);
            }
        }
    }
    for (int it = blockIdx.x; it < 192; it += gridDim.x) mod_item(p, it, smem);
}

__device__ __forceinline__ bf16* xres_row(const Params& p, int r) {
    return r >= TLAT ? (bf16*)(p.ws + OFF_CX) + (size_t)(r - TLAT) * D : (bf16*)p.out + (size_t)r * (2 * D);
}
struct RowIn { float4 x[4]; uint2 xb[4], y0[4], y1[4]; };
__device__ __forceinline__ void norm1_load(const Params& p, int l, int r, int lane, RowIn& d) {
    const bool isctx = r >= TLAT;
    if (l == 0) {
        const float* xin = isctx ? p.ctx + (size_t)(r - TLAT) * D : p.x + (size_t)r * D;
#pragma unroll
        for (int j = 0; j < 4; ++j) d.x[j] = *(const float4*)(xin + j * 256 + lane * 4);
    } else {
        const bf16* xr = xres_row(p, r);
        const bf16* YB = (const bf16*)(p.ws + OFF_YB);
#pragma unroll
        for (int j = 0; j < 4; ++j) {
            const int col = j * 256 + lane * 4;
            d.xb[j] = *(const uint2*)(xr + col);
            d.y0[j] = *(const uint2*)(YB + (size_t)(r * 2) * D + col); d.y1[j] = *(const uint2*)(YB + (size_t)(r * 2 + 1) * D + col);
        }
    }
}
__device__ __forceinline__ void phase_norm1(const Params& p, int l) {
    const int tid = otid(), wave = tid >> 6, lane = tid & 63;
    const float* mod = (const float*)(p.ws + OFF_MOD);
    bf16* H = (bf16*)(p.ws + OFF_H);
    const int stride = gridDim.x * 8;
    int r = blockIdx.x * 8 + wave;
    RowIn cur, nxt;
    if (r < TALL) norm1_load(p, l, r, lane, cur);
    int vc = -1; float4 gs[4], shv[4], gtv[4];
    while (r < TALL) {
        const int rn = r + stride;
        if (rn < TALL) norm1_load(p, l, rn, lane, nxt);
        const bool isctx = r >= TLAT; const int v = __builtin_amdgcn_readfirstlane(isctx ? 4 : r / SEQ);
        if (v != vc) {
            vc = v;
            const float* md = mod + (size_t)(l * 5 + v) * 6144;
#pragma unroll
            for (int j = 0; j < 4; ++j) {
                const int col = j * 256 + lane * 4;
                const float4 g = *(const float4*)(p.g1 + l * 1024 + col), sh = *(const float4*)(md + col), sc = *(const float4*)(md + 1024 + col);
                gs[j].x = g.x * (1.f + sc.x); gs[j].y = g.y * (1.f + sc.y); gs[j].z = g.z * (1.f + sc.z); gs[j].w = g.w * (1.f + sc.w); shv[j] = sh;
                if (l > 0) gtv[j] = *(const float4*)(mod + (size_t)((l - 1) * 5 + v) * 6144 + 5 * 1024 + col);
            }
        }
        float4 xv[4];
        bf16* xr = xres_row(p, r);
        if (l == 0) {
#pragma unroll
            for (int j = 0; j < 4; ++j) { xv[j] = cur.x[j]; uint2 o; o.x = pack2(xv[j].x, xv[j].y); o.y = pack2(xv[j].z, xv[j].w); *(uint2*)(xr + j * 256 + lane * 4) = o; }
        } else {
#pragma unroll
            for (int j = 0; j < 4; ++j) {
                const int col = j * 256 + lane * 4;
                const uint2 xb = cur.xb[j]; float4 a; a.x = lo2f(xb.x); a.y = hi2f(xb.x); a.z = lo2f(xb.y); a.w = hi2f(xb.y);
                const float4 g = gtv[j];
                const uint2 y0 = cur.y0[j], y1 = cur.y1[j];
                a.x += g.x * (lo2f(y0.x) + lo2f(y1.x)); a.y += g.y * (hi2f(y0.x) + hi2f(y1.x));
                a.z += g.z * (lo2f(y0.y) + lo2f(y1.y)); a.w += g.w * (hi2f(y0.y) + hi2f(y1.y));
                uint2 o; o.x = pack2(a.x, a.y); o.y = pack2(a.z, a.w); *(uint2*)(xr + col) = o; xv[j] = a;
            }
        }
        float ss = 0;
#pragma unroll
        for (int j = 0; j < 4; ++j) ss += xv[j].x * xv[j].x + xv[j].y * xv[j].y + xv[j].z * xv[j].z + xv[j].w * xv[j].w;
        ss = wsum(ss, lane);
        const float rstd = rsqrtf(ss * (1.f / 1024.f) + EPS);
#pragma unroll
        for (int j = 0; j < 4; ++j) {
            const int col = j * 256 + lane * 4;
            const float h0 = xv[j].x * rstd * gs[j].x + shv[j].x, h1 = xv[j].y * rstd * gs[j].y + shv[j].y;
            const float h2 = xv[j].z * rstd * gs[j].z + shv[j].z, h3 = xv[j].w * rstd * gs[j].w + shv[j].w;
            uint2 o; o.x = pack2(h0, h1); o.y = pack2(h2, h3);
            *(uint2*)(H + (size_t)r * D + col) = o;
        }
        cur = nxt; r = rn;
    }
}

__device__ __forceinline__ int kiter_max(int nrows, int g) { return (nrows + g * 8 - 1) / (g * 8); }
typedef float n2_f32x4 __attribute__((ext_vector_type(4)));
constexpr int N2_WPROW = 2064;
__device__ __forceinline__ void phase_norm2(const Params& p, int l, char* smem) {
    const int tid = otid(), wave = tid >> 6, lane = tid & 63;
    const float* mod = (const float*)(p.ws + OFF_MOD);
    bf16* H = (bf16*)(p.ws + OFF_H);
    int* cnt = (int*)(p.ws + OFF_CTL) + l * 16;
    int* lts = (int*)(p.ws + OFF_LTS);
    float* lw = (float*)(p.ws + OFF_LW);
    const int nrows = (l == 0) ? TALL : TLAT, nch = nrows >> 6, G = gridDim.x, bid = blockIdx.x;
    int* lcnt = (int*)smem;
    float* rstd_s = (float*)(smem + 256);
    float* bias_s = (float*)(smem + 512);
    float* red = (float*)(smem + 640);
    int* rinfo = (int*)(smem + 1280);
    char* Wp = smem + 12288;
    if (tid < 32) lcnt[tid] = 0;
    int vc = -1; float4 gs[4], shv[4];
    int pass = 0;
    for (int ch = bid; ch < nch; ch += G, ++pass) {
        const int r0 = ch * 64;
        const int v = r0 >= TLAT ? 4 : r0 / SEQ;
        if (v != vc) {
            vc = v;
            const float* md = mod + (size_t)(l * 5 + v) * 6144;
#pragma unroll
            for (int j = 0; j < 4; ++j) {
                const int col = j * 256 + lane * 4;
                const float4 g = *(const float4*)(p.g2 + l * 1024 + col), sh = *(const float4*)(md + 3072 + col), sc = *(const float4*)(md + 4096 + col);
                gs[j].x = g.x * (1.f + sc.x); gs[j].y = g.y * (1.f + sc.y); gs[j].z = g.z * (1.f + sc.z); gs[j].w = g.w * (1.f + sc.w); shv[j] = sh;
            }
            float pb[16];
#pragma unroll
            for (int e = 0; e < 16; ++e) pb[e] = 0.f;
#pragma unroll
            for (int kk = 0; kk < 2; ++kk) {
                const int k = tid + NT * kk;
                const float gk = p.g2[l * 1024 + k] * (1.f + md[4096 + k]), sk = md[3072 + k];
                const float4 w0 = *(const float4*)(p.w_router + k * 16), w1 = *(const float4*)(p.w_router + k * 16 + 4), w2 = *(const float4*)(p.w_router + k * 16 + 8), w3 = *(const float4*)(p.w_router + k * 16 + 12);
                const float wv[16] = {w0.x, w0.y, w0.z, w0.w, w1.x, w1.y, w1.z, w1.w, w2.x, w2.y, w2.z, w2.w, w3.x, w3.y, w3.z, w3.w};
#pragma unroll
                for (int e = 0; e < 16; ++e) { *(bf16*)(Wp + e * N2_WPROW + k * 2) = f2bf(gk * wv[e]); pb[e] += sk * wv[e]; }
            }
            const float z = reduce16(pb, lane);
            if ((lane & 3) == 0) red[wave * 16 + ((lane >> 2) & 15)] = z;
            __syncthreads();
            if (tid < 16) { float bsum = 0.f;
#pragma unroll
                for (int w = 0; w < 8; ++w) bsum += red[w * 16 + tid];
                bias_s[tid] = bsum; }
        }
        {
            uint2 xn[4];
            { const bf16* x0 = xres_row(p, r0 + wave);
#pragma unroll
              for (int j = 0; j < 4; ++j) xn[j] = *(const uint2*)(x0 + j * 256 + lane * 4); }
#pragma unroll 1
            for (int t = 0; t < 8; ++t) {
                const int i = wave + 8 * t, r = r0 + i;
                float4 xv[4];
#pragma unroll
                for (int j = 0; j < 4; ++j) { const uint2 xb = xn[j]; xv[j].x = lo2f(xb.x); xv[j].y = hi2f(xb.x); xv[j].z = lo2f(xb.y); xv[j].w = hi2f(xb.y); }
                if (t < 7) { const bf16* x1 = xres_row(p, r + 8);
#pragma unroll
                    for (int j = 0; j < 4; ++j) xn[j] = *(const uint2*)(x1 + j * 256 + lane * 4); }
                float ss = 0;
#pragma unroll
                for (int j = 0; j < 4; ++j) ss += xv[j].x * xv[j].x + xv[j].y * xv[j].y + xv[j].z * xv[j].z + xv[j].w * xv[j].w;
                ss = wsum(ss, lane);
                const float rstd = rsqrtf(ss * (1.f / 1024.f) + EPS);
                if (lane == 0) rstd_s[i] = rstd;
#pragma unroll
                for (int j = 0; j < 4; ++j) {
                    const int col = j * 256 + lane * 4;
                    uint2 o; o.x = pack2(xv[j].x * rstd * gs[j].x + shv[j].x, xv[j].y * rstd * gs[j].y + shv[j].y);
                    o.y = pack2(xv[j].z * rstd * gs[j].z + shv[j].z, xv[j].w * rstd * gs[j].w + shv[j].w);
                    *(uint2*)(H + (size_t)r * D + col) = o;
                }
            }
        }
        __syncthreads();
        if (wave < 4) {
            const int rl = lane & 15, kg = lane >> 4, rowl = 16 * wave + rl;
            const bf16* xr = xres_row(p, r0 + rowl) + 8 * kg;
            const char* wa = Wp + rl * N2_WPROW + 16 * kg;
            n2_f32x4 acc = {0.f, 0.f, 0.f, 0.f};
#pragma unroll 1
            for (int kb = 0; kb < 4; ++kb) {
                bf16x8 xb[8];
#pragma unroll
                for (int q = 0; q < 8; ++q) xb[q] = *reinterpret_cast<const bf16x8*>(xr + (kb * 8 + q) * 32);
#pragma unroll
                for (int q = 0; q < 8; ++q) {
                    const bf16x8 af = *reinterpret_cast<const bf16x8*>(wa + (kb * 8 + q) * 64);
                    acc = __builtin_amdgcn_mfma_f32_16x16x32_bf16(af, xb[q], acc, 0, 0, 0);
                }
            }
            const float rs = rstd_s[rowl];
            float sg[4], bb[4];
#pragma unroll
            for (int q = 0; q < 4; ++q) { sg[q] = sigmoidf_(rs * acc[q] + bias_s[4 * kg + q]); bb[q] = sg[q] + p.b_router[4 * kg + q]; }
            int i1 = 0; float m1 = bb[0]; float s1 = sg[0];
#pragma unroll
            for (int q = 1; q < 4; ++q) if (bb[q] > m1) { m1 = bb[q]; i1 = q; s1 = sg[q]; }
            int i2 = -1; float m2 = -1e30f; float s2 = 0.f;
#pragma unroll
            for (int q = 0; q < 4; ++q) if (q != i1 && bb[q] > m2) { m2 = bb[q]; i2 = q; s2 = sg[q]; }
            float bg = m1 + m2; int bgi = kg; int pk = (4 * kg + i1) | ((4 * kg + i2) << 8); float b1 = s1, b2 = s2;
#pragma unroll
            for (int off = 16; off <= 32; off <<= 1) {
                const float og = shx(bg, off, lane), o1 = shx(b1, off, lane), o2 = shx(b2, off, lane);
                const int ogi = __builtin_amdgcn_ds_bpermute((lane ^ off) << 2, bgi), opk = __builtin_amdgcn_ds_bpermute((lane ^ off) << 2, pk);
                const bool take = (og > bg) || (og == bg && ogi < bgi);
                if (take) { bg = og; bgi = ogi; pk = opk; b1 = o1; b2 = o2; }
            }
            if (kg == 0) {
                const int be0 = pk & 255, be1 = pk >> 8;
                const float inv = 1.f / (b1 + b2);
                const int p0 = atomicAdd(&lcnt[be0], 1), p1 = atomicAdd(&lcnt[be1], 1);
                int* ri = rinfo + (pass * 64 + rowl) * 4;
                ri[0] = pk; ri[1] = p0 | (p1 << 16); ri[2] = __float_as_int(b1 * inv); ri[3] = __float_as_int(b2 * inv);
            }
        }
        __syncthreads();
    }
    __syncthreads();
    const int tid2 = otid();
    if (tid2 < 16) lcnt[16 + tid2] = atomicAdd(&cnt[tid2], lcnt[tid2]);
    __syncthreads();
    {
        const int nent = pass * 128;
        for (int en = tid2; en < nent; en += NT) {
            const int s2 = en & 1, idx = en >> 1, pq = idx >> 6, i = idx & 63;
            const int r = (bid + pq * G) * 64 + i;
            const int* ri = rinfo + idx * 4;
            const int e = (ri[0] >> (8 * s2)) & 255, pos = (ri[1] >> (16 * s2)) & 65535;
            const int gp = lcnt[16 + e] + pos;
            lts[(size_t)e * TALL + gp] = r * 2 + s2; lw[(size_t)e * TALL + gp] = __int_as_float(ri[2 + s2]);
        }
    }
    __syncthreads();
}

__device__ __forceinline__ void phase_final(const Params& p) {
    const int tid = otid(), wave = tid >> 6, lane = tid & 63;
    const float* mod = (const float*)(p.ws + OFF_MOD);
    const int stride = gridDim.x * 8;
    int r = blockIdx.x * 8 + wave;
    RowIn cur, nxt;
    if (r < TLAT) norm1_load(p, 2, r, lane, cur);
    int vc = -1; float4 gtv[4], gfv[4];
#pragma unroll
    for (int j = 0; j < 4; ++j) gfv[j] = *(const float4*)(p.g_final + j * 256 + lane * 4);
    while (r < TLAT) {
        const int rn = r + stride;
        if (rn < TLAT) norm1_load(p, 2, rn, lane, nxt);
        const int v = __builtin_amdgcn_readfirstlane(r / SEQ);
        if (v != vc) { vc = v;
#pragma unroll
            for (int j = 0; j < 4; ++j) gtv[j] = *(const float4*)(mod + (size_t)(1 * 5 + v) * 6144 + 5 * 1024 + j * 256 + lane * 4); }
        float* xr = p.out + (size_t)r * D;
        float4 xv[4];
#pragma unroll
        for (int j = 0; j < 4; ++j) {
            const int col = j * 256 + lane * 4;
            const uint2 xb = cur.xb[j]; float4 a; a.x = lo2f(xb.x); a.y = hi2f(xb.x); a.z = lo2f(xb.y); a.w = hi2f(xb.y);
            const float4 g = gtv[j];
            const uint2 y0 = cur.y0[j], y1 = cur.y1[j];
            a.x += g.x * (lo2f(y0.x) + lo2f(y1.x)); a.y += g.y * (hi2f(y0.x) + hi2f(y1.x));
            a.z += g.z * (lo2f(y0.y) + lo2f(y1.y)); a.w += g.w * (hi2f(y0.y) + hi2f(y1.y));
            xv[j] = a;
        }
        float ss = 0;
#pragma unroll
        for (int j = 0; j < 4; ++j) ss += xv[j].x * xv[j].x + xv[j].y * xv[j].y + xv[j].z * xv[j].z + xv[j].w * xv[j].w;
        ss = wsum(ss, lane);
        const float rstd = rsqrtf(ss * (1.f / 1024.f) + EPS);
#pragma unroll
        for (int j = 0; j < 4; ++j) {
            const int col = j * 256 + lane * 4;
            const float4 g = gfv[j];
            float4 o; o.x = xv[j].x * rstd * g.x; o.y = xv[j].y * rstd * g.y; o.z = xv[j].z * rstd * g.z; o.w = xv[j].w * rstd * g.w;
            *(float4*)(xr + col) = o;
        }
        cur = nxt; r = rn;
    }
}

constexpr int LDS_ROW = 144;
constexpr int A_STAGE = 256 * LDS_ROW;
constexpr int B_STAGE = 128 * LDS_ROW;
constexpr int STAGE = A_STAGE + B_STAGE;
constexpr int GEMM_LDS = 2 * STAGE;
constexpr int CT_LD = 132;

template <int MI>
__device__ __forceinline__ void zero_acc(f32x16 (&acc)[MI][2]) {
#pragma unroll
    for (int a = 0; a < MI; ++a)
#pragma unroll
        for (int b = 0; b < 2; ++b)
#pragma unroll
            for (int r = 0; r < 16; ++r) acc[a][b][r] = 0.f;
}

__device__ __forceinline__ uint4 scale8(uint4 u, float sc) {
    uint4 o;
    o.x = pack2(lo2f(u.x) * sc, hi2f(u.x) * sc); o.y = pack2(lo2f(u.y) * sc, hi2f(u.y) * sc);
    o.z = pack2(lo2f(u.z) * sc, hi2f(u.z) * sc); o.w = pack2(lo2f(u.w) * sc, hi2f(u.w) * sc);
    return o;
}
template <int MI, bool BS = false>
__device__ __forceinline__ void gemm_mainloop(f32x16 (&acc)[MI][2], const bf16* ap0, const bf16* ap1, const bf16* ap2, const bf16* ap3,
                                              const bf16* bp0, const bf16* bp1, int K, char* smem, float bs0 = 1.f, float bs1 = 1.f) {
    const int tid = otid(), lane = tid & 63, wave = tid >> 6, wm = wave >> 1, wn = wave & 1;
    const int kc = tid & 7, lr = tid >> 3;
    uint4 ra0, ra1, ra2, ra3, rb0, rb1;
    ra0 = *(const uint4*)(ap0 + kc * 8); ra1 = *(const uint4*)(ap1 + kc * 8);
    if (MI == 2) { ra2 = *(const uint4*)(ap2 + kc * 8); ra3 = *(const uint4*)(ap3 + kc * 8); }
    rb0 = *(const uint4*)(bp0 + kc * 8); rb1 = *(const uint4*)(bp1 + kc * 8);
    if (BS) { rb0 = scale8(rb0, bs0); rb1 = scale8(rb1, bs1); }
    {
        char* st = smem;
        *(uint4*)(st + (lr) * LDS_ROW + kc * 16) = ra0; *(uint4*)(st + (lr + 64) * LDS_ROW + kc * 16) = ra1;
        if (MI == 2) { *(uint4*)(st + (lr + 128) * LDS_ROW + kc * 16) = ra2; *(uint4*)(st + (lr + 192) * LDS_ROW + kc * 16) = ra3; }
        *(uint4*)(st + A_STAGE + (lr) * LDS_ROW + kc * 16) = rb0; *(uint4*)(st + A_STAGE + (lr + 64) * LDS_ROW + kc * 16) = rb1;
    }
    __syncthreads();
    const int nk = K >> 6;
    const int aoff = (wm * (32 * MI) + (lane & 31)) * LDS_ROW + (lane >> 5) * 16;
    const int boff = A_STAGE + (wn * 64 + (lane & 31)) * LDS_ROW + (lane >> 5) * 16;
    for (int kt = 0; kt < nk; ++kt) {
        char* cur = smem + (kt & 1) * STAGE;
        const bool more = (kt + 1 < nk);
        if (more) {
            const int ko = (kt + 1) * 64 + kc * 8;
            ra0 = *(const uint4*)(ap0 + ko); ra1 = *(const uint4*)(ap1 + ko);
            if (MI == 2) { ra2 = *(const uint4*)(ap2 + ko); ra3 = *(const uint4*)(ap3 + ko); }
            rb0 = *(const uint4*)(bp0 + ko); rb1 = *(const uint4*)(bp1 + ko);
        }
#pragma unroll
        for (int ks = 0; ks < 4; ++ks) {
            bf16x8 b0 = *(const bf16x8*)(cur + boff + ks * 32);
            bf16x8 b1 = *(const bf16x8*)(cur + boff + 32 * LDS_ROW + ks * 32);
#pragma unroll
            for (int mi = 0; mi < MI; ++mi) {
                bf16x8 a0 = *(const bf16x8*)(cur + aoff + mi * 32 * LDS_ROW + ks * 32);
                acc[mi][0] = __builtin_amdgcn_mfma_f32_32x32x16_bf16(a0, b0, acc[mi][0], 0, 0, 0);
                acc[mi][1] = __builtin_amdgcn_mfma_f32_32x32x16_bf16(a0, b1, acc[mi][1], 0, 0, 0);
            }
        }
        if (more) {
            if (BS) { rb0 = scale8(rb0, bs0); rb1 = scale8(rb1, bs1); }
            char* st = smem + ((kt + 1) & 1) * STAGE;
            *(uint4*)(st + (lr) * LDS_ROW + kc * 16) = ra0; *(uint4*)(st + (lr + 64) * LDS_ROW + kc * 16) = ra1;
            if (MI == 2) { *(uint4*)(st + (lr + 128) * LDS_ROW + kc * 16) = ra2; *(uint4*)(st + (lr + 192) * LDS_ROW + kc * 16) = ra3; }
            *(uint4*)(st + A_STAGE + (lr) * LDS_ROW + kc * 16) = rb0; *(uint4*)(st + A_STAGE + (lr + 64) * LDS_ROW + kc * 16) = rb1;
        }
        __syncthreads();
    }
}

__device__ __forceinline__ void stage_full(const f32x16 (&acc)[1][2], char* smem) {
    const int tid = otid(), lane = tid & 63, wave = tid >> 6, wm = wave >> 1, wn = wave & 1;
    float* Ct = (float*)smem;
#pragma unroll
    for (int ni = 0; ni < 2; ++ni)
#pragma unroll
        for (int r = 0; r < 16; ++r) {
            int row = wm * 32 + (r & 3) + 8 * (r >> 2) + 4 * (lane >> 5);
            int col = wn * 64 + ni * 32 + (lane & 31);
            Ct[row * CT_LD + col] = acc[0][ni][r];
        }
}

__device__ __forceinline__ void stage_half(const f32x16 (&acc)[2][2], int h, char* smem) {
    const int tid = otid(), lane = tid & 63, wave = tid >> 6, wm = wave >> 1, wn = wave & 1;
    float* Ct = (float*)smem;
    if ((wm >> 1) == h) {
#pragma unroll
        for (int mi = 0; mi < 2; ++mi)
#pragma unroll
            for (int ni = 0; ni < 2; ++ni)
#pragma unroll
                for (int r = 0; r < 16; ++r) {
                    int row = (wm & 1) * 64 + mi * 32 + (r & 3) + 8 * (r >> 2) + 4 * (lane >> 5);
                    int col = wn * 64 + ni * 32 + (lane & 31);
                    Ct[row * CT_LD + col] = acc[mi][ni][r];
                }
    }
}

__device__ __forceinline__ void store32_bf16(bf16* dst, const float (&v)[32]) {
#pragma unroll
    for (int i = 0; i < 4; ++i) {
        uint4 o; o.x = pack2(v[i * 8 + 0], v[i * 8 + 1]); o.y = pack2(v[i * 8 + 2], v[i * 8 + 3]);
        o.z = pack2(v[i * 8 + 4], v[i * 8 + 5]); o.w = pack2(v[i * 8 + 6], v[i * 8 + 7]);
        *(uint4*)(dst + i * 8) = o;
    }
}

__device__ __forceinline__ void epi_plain_bf16(const float* Ct, bf16* dst, int ld, int mrow0, int n0) {
    const int tid = otid(), r = tid >> 2, q = tid & 3;
    float v[32];
    const float* src = Ct + r * CT_LD + 32 * q;
#pragma unroll
    for (int j = 0; j < 32; ++j) v[j] = src[j];
    store32_bf16(dst + (size_t)(mrow0 + r) * ld + n0 + 32 * q, v);
}

__device__ __forceinline__ void epi_outproj(const Params& p, int l, const float* Ct, int mrow0, int n0) {
    const int tid = otid(), r = tid >> 2, q = tid & 3;
    const int row = mrow0 + r;
    const bool isctx = row >= TLAT; const int v = isctx ? 4 : row / SEQ;
    const float* gt = (const float*)(p.ws + OFF_MOD) + (size_t)(l * 5 + v) * 6144 + 2048 + n0 + 32 * q;
    float* CX = (float*)(p.ws + OFF_CX);
    const float* xin; float* xo;
    if (isctx) { xo = CX + (size_t)(row - TLAT) * D + n0 + 32 * q; xin = (l == 0) ? p.ctx + (size_t)(row - TLAT) * D + n0 + 32 * q : xo; }
    else { xo = p.out + (size_t)row * D + n0 + 32 * q; xin = (l == 0) ? p.x + (size_t)row * D + n0 + 32 * q : xo; }
    const float* src = Ct + r * CT_LD + 32 * q;
#pragma unroll
    for (int i = 0; i < 8; ++i) {
        float4 a = *(const float4*)(xin + i * 4); float4 g = *(const float4*)(gt + i * 4);
        a.x += g.x * src[i * 4 + 0]; a.y += g.y * src[i * 4 + 1]; a.z += g.z * src[i * 4 + 2]; a.w += g.w * src[i * 4 + 3];
        *(float4*)(xo + i * 4) = a;
    }
}

__device__ __forceinline__ float log_sigmoid_(float x) { return -log1pf(expf(-x)); }

namespace pg8 {
#define PG8_LAS __attribute__((address_space(3)))
typedef float f32x4 __attribute__((ext_vector_type(4)));
typedef unsigned u32x4 __attribute__((ext_vector_type(4)));
constexpr int BM = 256, BK = 64, HALF = 128, HTB = HALF * BK * 2, STAGE_BYTES = 8 * HTB, NXCD = 8, WGM = 8;
__device__ __forceinline__ int lds_byte(int r, int c) { const int st = (r >> 4) * 2 + (c >> 5), rr = r & 15, cc = c & 31, ob = rr * 64 + cc * 2; return st * 1024 + (ob ^ (((ob >> 9) & 1) << 5)); }
__device__ __forceinline__ void stage_rc(int b, int& R, int& C) { const int st = b / 1024, sb = b % 1024, swz = sb ^ (((sb >> 9) & 1) << 5); R = (st >> 1) * 16 + swz / 64; C = (st & 1) * 32 + (swz % 64) / 2; }
__device__ __forceinline__ int perm32(int rho) { const int n = rho >> 4, i = rho & 15; return 8 * (i >> 2) + 4 * n + (i & 3); }
__device__ __forceinline__ unsigned cvt_pk_bf16(float lo, float hi) { return pack2(lo, hi); }

struct Unit { const char* A; const char* B; int pm, pn, tag, x0, x1; };

__device__ __forceinline__ bool static_unit(int i, int G, int c, int nM, int nN, int& pm, int& pn) {
    const int nwg = nM * nN; const long L = (long)i * G + c; if (L >= nwg) return false;
    int wgid = (int)L; { const int q = nwg / NXCD, r = nwg % NXCD, xcd = wgid % NXCD, off = wgid / NXCD; wgid = (xcd < r ? xcd * (q + 1) : r * (q + 1) + (xcd - r) * q) + off; }
    const int nig = WGM * nN, gid = wgid / nig, fm = gid * WGM, gsz = (nM - fm) < WGM ? (nM - fm) : WGM;
    pm = fm + ((wgid % nig) % gsz); pn = (wgid % nig) / gsz; return true;
}

template <class Sched, class Epi>
__device__ __forceinline__ void gemm_stream(PG8_LAS unsigned char* lds, const int K, const Sched& S, const Epi& E) {
    const int tid = otid(), wid = __builtin_amdgcn_readfirstlane(tid >> 6), lane = tid & 63, wr = wid >> 2, wc = wid & 3, fr = lane & 15, fq = lane >> 4;
    const int nt = K / BK;
    int sR[2], sC[2];
    constexpr int NH = Sched::GATHER ? 2 : 1;
    unsigned voffA[NH][2], voffB[1][2], voffAn[NH][2];
#pragma unroll
    for (int i = 0; i < 2; ++i) { int R, C; stage_rc(tid * 16 + i * 8192, R, C); sR[i] = R; sC[i] = C; const int Rb = (R & ~31) + perm32(R & 31);
        voffB[0][i] = (unsigned)(Rb * K + C) * 2u;
#pragma unroll
        for (int h = 0; h < NH; ++h) { voffA[h][i] = (unsigned)((h * HALF + R) * K + C) * 2u; voffAn[h][i] = voffA[h][i]; } }
    const size_t kstep = (size_t)(BK * 2);
    const size_t hstepA = Sched::GATHER ? 0 : (size_t)HALF * K * 2, hstepB = (size_t)HALF * K * 2;
    const unsigned ldsw = (unsigned)wid * 1024u;
    const int aoff = lds_byte(wr * 64 + fr, fq * 8), boff = lds_byte(wc * 32 + fr, fq * 8);
#define PG8_SA(b, h) (((b) * 2 + (h)) * HTB)
#define PG8_SB(b, h) ((4 + (b) * 2 + (h)) * HTB)
#define PG8_STAGE(bufoff, gbase, voff) do { _Pragma("unroll") for (int _i = 0; _i < 2; ++_i) \
        __builtin_amdgcn_global_load_lds((const unsigned*)((const char*)(gbase) + (voff)[_i]), (PG8_LAS unsigned*)(lds + (bufoff) + ldsw + _i * 8192), 16, 0, 0); } while (0)
#define PG8_LDA(dst, b, h) do { _Pragma("unroll") for (int m = 0; m < 4; ++m) _Pragma("unroll") for (int k = 0; k < 2; ++k) dst[m][k] = *(const PG8_LAS bf16x8*)(lds + PG8_SA(b, h) + aoff + m * 2048 + k * 1024); } while (0)
#define PG8_LDB(dst, b, h) do { _Pragma("unroll") for (int n = 0; n < 2; ++n) _Pragma("unroll") for (int k = 0; k < 2; ++k) dst[n][k] = *(const PG8_LAS bf16x8*)(lds + PG8_SB(b, h) + boff + n * 2048 + k * 1024); } while (0)
#define PG8_MMA(ai, bj, At, Bt) do { __builtin_amdgcn_s_setprio(1); _Pragma("unroll") for (int m = 0; m < 4; ++m) _Pragma("unroll") for (int n = 0; n < 2; ++n) _Pragma("unroll") for (int k = 0; k < 2; ++k) \
        acc[ai][bj][m][n] = __builtin_amdgcn_mfma_f32_16x16x32_bf16(Bt[n][k], At[m][k], acc[ai][bj][m][n], 0, 0, 0); __builtin_amdgcn_s_setprio(0); } while (0)
#define PG8_WAIT_V(n) asm volatile("s_waitcnt vmcnt(" #n ")" ::: "memory")
#define PG8_WAIT_L(n) asm volatile("s_waitcnt lgkmcnt(" #n ")" ::: "memory")
#define PG8_BAR __builtin_amdgcn_s_barrier()
#define PG8_SCHED __builtin_amdgcn_sched_barrier(0)
#define PG8_GOFF(u, dst) do { if constexpr (Sched::GATHER) { _Pragma("unroll") for (int _h = 0; _h < 2; ++_h) _Pragma("unroll") for (int _i = 0; _i < 2; ++_i) \
        dst[_h][_i] = S.row_off(u, _h * HALF + sR[_i]) + (unsigned)sC[_i] * 2u; } } while (0)
    Unit cur, nxt; int ui = 0;
    if (!S.next(0, cur)) return;
    f32x4 acc[2][2][4][2];
#pragma unroll
    for (int a = 0; a < 2; ++a)
#pragma unroll
        for (int b = 0; b < 2; ++b)
#pragma unroll
            for (int m = 0; m < 4; ++m)
#pragma unroll
                for (int n = 0; n < 2; ++n) acc[a][b][m][n] = (f32x4){0.f, 0.f, 0.f, 0.f};
    bf16x8 At[4][2], B0[2][2], B1[2][2];
    const char* cA = cur.A; const char* cB = cur.B;
    PG8_GOFF(cur, voffA);
    PG8_STAGE(PG8_SB(0, 0), cB, voffB[0]); PG8_STAGE(PG8_SA(0, 0), cA, voffA[0]); PG8_STAGE(PG8_SB(0, 1), cB + hstepB, voffB[0]); PG8_STAGE(PG8_SA(0, 1), cA + hstepA, voffA[NH - 1]);
    if (wr == 1) PG8_BAR;
    PG8_WAIT_V(4); PG8_BAR;
    PG8_STAGE(PG8_SB(1, 0), cB + kstep, voffB[0]); PG8_STAGE(PG8_SA(1, 0), cA + kstep, voffA[0]); PG8_STAGE(PG8_SB(1, 1), cB + kstep + hstepB, voffB[0]);
    PG8_WAIT_V(6); PG8_BAR;
    for (;;) {
        const bool has_next = S.next(ui + 1, nxt);
        const char* nA = has_next ? nxt.A : cA; const char* nB = has_next ? nxt.B : cB;
        if constexpr (Sched::GATHER) { if (has_next) { PG8_GOFF(nxt, voffAn); } else {
#pragma unroll
            for (int _h = 0; _h < NH; ++_h)
#pragma unroll
                for (int _i = 0; _i < 2; ++_i) voffAn[_h][_i] = voffA[_h][_i]; } }
        for (int t = 0; t < nt; t += 2) {
            const bool last = (t == nt - 2);
            const char* a1 = cA + (size_t)(t + 1) * kstep;
            const char* a2 = last ? nA : cA + (size_t)(t + 2) * kstep; const char* b2 = last ? nB : cB + (size_t)(t + 2) * kstep;
            const char* a3 = a2 + kstep; const char* b3 = b2 + kstep;
            unsigned vA2[NH][2];
#pragma unroll
            for (int _h = 0; _h < NH; ++_h)
#pragma unroll
                for (int _i = 0; _i < 2; ++_i) vA2[_h][_i] = (Sched::GATHER && last) ? voffAn[_h][_i] : voffA[_h][_i];
            PG8_LDB(B0, 0, 0); PG8_SCHED; PG8_LDA(At, 0, 0); PG8_STAGE(PG8_SA(1, 1), a1 + hstepA, voffA[NH - 1]);
            PG8_WAIT_L(8); PG8_BAR; PG8_WAIT_L(0); PG8_MMA(0, 0, At, B0); PG8_BAR; PG8_SCHED;
            PG8_LDB(B1, 0, 1); PG8_STAGE(PG8_SB(0, 0), b2, voffB[0]);
            PG8_BAR; PG8_WAIT_L(0); PG8_MMA(0, 1, At, B1); PG8_BAR;
            PG8_LDA(At, 0, 1); PG8_STAGE(PG8_SA(0, 0), a2, vA2[0]);
            PG8_BAR; PG8_WAIT_L(0); PG8_MMA(1, 0, At, B0); PG8_BAR; PG8_SCHED;
            PG8_STAGE(PG8_SB(0, 1), b2 + hstepB, voffB[0]);
            PG8_WAIT_V(6); PG8_BAR; PG8_MMA(1, 1, At, B1); PG8_BAR;
            PG8_LDB(B0, 1, 0); PG8_SCHED; PG8_LDA(At, 1, 0); PG8_STAGE(PG8_SA(0, 1), a2 + hstepA, vA2[NH - 1]);
            PG8_WAIT_L(8); PG8_BAR; PG8_WAIT_L(0); PG8_MMA(0, 0, At, B0); PG8_BAR; PG8_SCHED;
            PG8_LDB(B1, 1, 1); PG8_STAGE(PG8_SB(1, 0), b3, voffB[0]);
            PG8_BAR; PG8_WAIT_L(0); PG8_MMA(0, 1, At, B1); PG8_BAR;
            PG8_LDA(At, 1, 1); PG8_STAGE(PG8_SA(1, 0), a3, vA2[0]);
            PG8_BAR; PG8_WAIT_L(0); PG8_MMA(1, 0, At, B0); PG8_BAR; PG8_SCHED;
            PG8_STAGE(PG8_SB(1, 1), b3 + hstepB, voffB[0]);
            PG8_WAIT_V(6); PG8_BAR; PG8_MMA(1, 1, At, B1); PG8_BAR;
        }
        E(acc, cur, wr, wc, fr, fq);
        if (!has_next) break;
#pragma unroll
        for (int a = 0; a < 2; ++a)
#pragma unroll
            for (int b = 0; b < 2; ++b)
#pragma unroll
                for (int m = 0; m < 4; ++m)
#pragma unroll
                    for (int n = 0; n < 2; ++n) acc[a][b][m][n] = (f32x4){0.f, 0.f, 0.f, 0.f};
        cur = nxt; cA = nA; cB = nB; ++ui;
        if constexpr (Sched::GATHER) {
#pragma unroll
            for (int _h = 0; _h < NH; ++_h)
#pragma unroll
                for (int _i = 0; _i < 2; ++_i) voffA[_h][_i] = voffAn[_h][_i]; }
    }
    PG8_WAIT_V(0);
    if (wr == 0) PG8_BAR;
    PG8_BAR;
#undef PG8_SA
#undef PG8_SB
#undef PG8_STAGE
#undef PG8_LDA
#undef PG8_LDB
#undef PG8_MMA
#undef PG8_WAIT_V
#undef PG8_WAIT_L
#undef PG8_BAR
#undef PG8_SCHED
#undef PG8_GOFF
}
}

struct InprojSched {
    static constexpr bool GATHER = false;
    const char* H; const char* W; int G, c;
    __device__ __forceinline__ bool next(int i, pg8::Unit& u) const {
        int pm, pn;
        if (!pg8::static_unit(i, G, c, TALL / 256, 26, pm, pn)) return false;
        u.pm = pm; u.pn = pn; u.tag = 0;
        const char* hp = H + (size_t)pm * 256 * 2048; const char* wp = W + (size_t)pn * 256 * 2048;
        if (pn < 19) { u.A = hp; u.B = wp; } else { u.A = wp; u.B = hp; }
        return true;
    }
};

struct InprojEpi {
    unsigned char* ws_; const float* gq_; const float* gk_; float* red_;
    typedef pg8::f32x4 f32x4;

    __device__ __forceinline__ static void st8(bf16* d, const float (&o)[8]) {
        pg8::u32x4 w; w.x = pg8::cvt_pk_bf16(o[0], o[1]); w.y = pg8::cvt_pk_bf16(o[2], o[3]); w.z = pg8::cvt_pk_bf16(o[4], o[5]); w.w = pg8::cvt_pk_bf16(o[6], o[7]);
        *(pg8::u32x4*)d = w;
    }
    template <bool NORM>
    __device__ __forceinline__ void rope128(unsigned char* ws, float* red, const f32x4 (&acc)[2][2][4][2], bf16* dst, int ld, int colbase, float scale, const float* gain,
                                            int pm, int wr, int wc, int fr, int fq) const {
        const bool isctx = pm >= 64;
        const int a = wc & 1, i0 = 8 * fq;
        bf16* d0 = dst + colbase + (wc >> 1) * 128 + 64 * a + i0;
        float g1[8], g2[8];
        if (NORM) {
#pragma unroll
            for (int j = 0; j < 8; ++j) { g1[j] = gain[64 * a + i0 + j] * scale; g2[j] = gain[64 * a + 32 + i0 + j] * scale; }
#pragma unroll
            for (int ai = 0; ai < 2; ++ai)
#pragma unroll
                for (int m = 0; m < 4; ++m) {
                    float ss = 0.f;
#pragma unroll
                    for (int bj = 0; bj < 2; ++bj)
#pragma unroll
                        for (int n = 0; n < 2; ++n)
#pragma unroll
                            for (int j = 0; j < 4; ++j) ss += acc[ai][bj][m][n][j] * acc[ai][bj][m][n][j];
                    { const int ln = fr + 16 * fq; ss += shx(ss, 16, ln); ss += shx(ss, 32, ln); }
                    if (fq == 0) red[(128 * ai + 64 * wr + 16 * m + fr) * 4 + wc] = ss;
                }
            asm volatile("s_waitcnt lgkmcnt(0)" ::: "memory");
            __builtin_amdgcn_s_barrier();
        }
        float fr8[8];
#pragma unroll
        for (int j = 0; j < 8; ++j) fr8[j] = exp2f(-(float)(i0 + j) * (13.287712379549449f / 32.f)) * 0.15915494309189535f;
        float cs[8], sn[8];
#define R128_TRIG(POS) do { const float pf_ = (float)(POS); _Pragma("unroll") for (int j = 0; j < 8; ++j) { const float x_ = pf_ * fr8[j]; \
            cs[j] = isctx ? 1.f : __builtin_amdgcn_cosf(x_); sn[j] = isctx ? 0.f : __builtin_amdgcn_sinf(x_); } } while (0)
#define R128_APPLY(ai, m) do { \
            const int rl = 128 * (ai) + 64 * wr + 16 * (m) + fr; const int row = 256 * pm + rl; \
            float x1[8], x2[8]; \
            _Pragma("unroll") for (int n = 0; n < 2; ++n) _Pragma("unroll") for (int j = 0; j < 4; ++j) { x1[n * 4 + j] = acc[ai][0][m][n][j]; x2[n * 4 + j] = acc[ai][1][m][n][j]; } \
            if (NORM) { const float rstd = rsqrtf((red[rl * 4 + wc] + red[rl * 4 + (wc ^ 1)]) * (1.f / 128.f) + EPS); \
                _Pragma("unroll") for (int j = 0; j < 8; ++j) { x1[j] *= rstd * g1[j]; x2[j] *= rstd * g2[j]; } } \
            else { _Pragma("unroll") for (int j = 0; j < 8; ++j) { x1[j] *= scale; x2[j] *= scale; } } \
            float o1[8], o2[8]; \
            _Pragma("unroll") for (int j = 0; j < 8; ++j) { o1[j] = x1[j] * cs[j] - x2[j] * sn[j]; o2[j] = x1[j] * sn[j] + x2[j] * cs[j]; } \
            st8(d0 + (size_t)row * ld, o1); st8(d0 + (size_t)row * ld + 32, o2); } while (0)
        if (a == 0) {
#pragma unroll
            for (int ai = 0; ai < 2; ++ai) {
                R128_TRIG(((256 * pm + 128 * ai + 64 * wr) & (SEQ - 1)) >> 6);
#pragma unroll
                for (int m = 0; m < 4; ++m) { R128_APPLY(ai, m); __builtin_amdgcn_sched_barrier(0); }
            }
        } else {
#pragma unroll
            for (int m = 0; m < 4; ++m) {
                R128_TRIG(16 * m + fr);
#pragma unroll
                for (int ai = 0; ai < 2; ++ai) { R128_APPLY(ai, m); __builtin_amdgcn_sched_barrier(0); }
            }
        }
#undef R128_APPLY
#undef R128_TRIG
    }
    __device__ __forceinline__ void rope64(unsigned char* ws, const f32x4 (&acc)[2][2][4][2], bf16* dst, int ld, int colbase, float scale, int nheads,
                                           int pm, int wr, int wc, int fr, int fq) const {
        if (wc >= nheads) return;
        const bool isctx = pm >= 64;
        const int a = fq >> 1, i0 = 8 * (fq & 1);
        bf16* d0 = dst + colbase + 64 * wc + 32 * a + i0;
        float fr8[8];
#pragma unroll
        for (int j = 0; j < 8; ++j) fr8[j] = exp2f(-(float)(i0 + j) * (13.287712379549449f / 16.f)) * 0.15915494309189535f;
#pragma unroll
        for (int ai = 0; ai < 2; ++ai)
#pragma unroll
            for (int m = 0; m < 4; ++m) {
                const int row = 256 * pm + 128 * ai + 64 * wr + 16 * m + fr;
                const int t = row & (SEQ - 1); const float pf = (float)(a ? (t & 63) : (t >> 6));
                float x1[8], x2[8], o1[8], o2[8];
#pragma unroll
                for (int n = 0; n < 2; ++n)
#pragma unroll
                    for (int j = 0; j < 4; ++j) { x1[n * 4 + j] = acc[ai][0][m][n][j] * scale; x2[n * 4 + j] = acc[ai][1][m][n][j] * scale; }
                if (!isctx) {
#pragma unroll
                    for (int j = 0; j < 8; ++j) { const float x = pf * fr8[j]; const float c = __builtin_amdgcn_cosf(x), sv = __builtin_amdgcn_sinf(x);
                        o1[j] = x1[j] * c - x2[j] * sv; o2[j] = x1[j] * sv + x2[j] * c; }
                } else {
#pragma unroll
                    for (int j = 0; j < 8; ++j) { o1[j] = x1[j]; o2[j] = x2[j]; }
                }
                st8(d0 + (size_t)row * ld, o1); st8(d0 + (size_t)row * ld + 16, o2);
                __builtin_amdgcn_sched_barrier(0);
            }
    }
    __device__ __forceinline__ void plain(const f32x4 (&acc)[2][2][4][2], bf16* dst, int ld, int colbase, int pm, int wr, int wc, int fr, int fq) const {
#pragma unroll
        for (int ai = 0; ai < 2; ++ai)
#pragma unroll
            for (int m = 0; m < 4; ++m) {
                const int row = 256 * pm + 128 * ai + 64 * wr + 16 * m + fr;
#pragma unroll
                for (int bj = 0; bj < 2; ++bj) {
                    float o[8];
#pragma unroll
                    for (int n = 0; n < 2; ++n)
#pragma unroll
                        for (int j = 0; j < 4; ++j) o[n * 4 + j] = acc[ai][bj][m][n][j];
                    st8(dst + (size_t)row * ld + colbase + 128 * bj + 32 * wc + 8 * fq, o);
                }
            }
    }
    __device__ __forceinline__ void swapped(unsigned char* ws, const f32x4 (&acc)[2][2][4][2], int sidx, int l, int pm, int wr, int wc, int fr, int fq) const {
        const bool isctx = pm >= 64;
        const int b = isctx ? pm - 64 : pm >> 4;
        const int key0 = isctx ? 4096 : (pm & 15) * 256;
        const int tk0 = 32 * wc + 8 * fq;
        if (sidx < 4 || sidx == 6) {
            const int nai = sidx == 6 ? 1 : 2;
            bf16* base = sidx == 6 ? (bf16*)(ws + OFF_VS) + (size_t)(b * 2) * 64 * KEYS : (bf16*)(ws + OFF_VR) + (size_t)(b * 4 + sidx) * 256 * KEYS;
#pragma unroll
            for (int ai = 0; ai < 2; ++ai) {
                if (ai < nai) {
#pragma unroll
                    for (int m = 0; m < 4; ++m) {
                        const int e = 128 * ai + 64 * wr + 16 * m + fr;
#pragma unroll
                        for (int bj = 0; bj < 2; ++bj) {
                            float o[8];
#pragma unroll
                            for (int n = 0; n < 2; ++n)
#pragma unroll
                                for (int j = 0; j < 4; ++j) o[n * 4 + j] = acc[ai][bj][m][n][j];
                            st8(base + (size_t)e * KEYS + key0 + 128 * bj + tk0, o);
                        }
                    }
                }
            }
        } else {
            const int h = 2 * (sidx - 4) + wr;
            const float* dec = (const float*)(ws + OFF_DEC) + 64 + (size_t)((l * 4 + h) * 6) * 128;
            const float f_lo = exp2f(-(float)fr * (13.287712379549449f / 32.f)) * 0.15915494309189535f, f_hi = exp2f(-(float)(16 + fr) * (13.287712379549449f / 32.f)) * 0.15915494309189535f;
            float df[8], db[8];
            { const float4 a0 = *(const float4*)(dec + tk0), a1 = *(const float4*)(dec + tk0 + 4), b0 = *(const float4*)(dec + 128 + tk0), b1 = *(const float4*)(dec + 128 + tk0 + 4);
              df[0] = a0.x; df[1] = a0.y; df[2] = a0.z; df[3] = a0.w; df[4] = a1.x; df[5] = a1.y; df[6] = a1.z; df[7] = a1.w;
              db[0] = b0.x; db[1] = b0.y; db[2] = b0.z; db[3] = b0.w; db[4] = b1.x; db[5] = b1.y; db[6] = b1.z; db[7] = b1.w; }
            bf16* kf = (bf16*)(ws + OFF_KFT) + (size_t)(b * 4 + h) * 128 * KEYS;
            bf16* kb = (bf16*)(ws + OFF_KBT) + (size_t)(b * 4 + h) * 128 * KEYS;
#pragma unroll
            for (int m = 0; m < 4; ++m) {
                const int a = m >> 1, i = 16 * (m & 1) + fr;
                const int d1 = 64 * a + i, d2 = d1 + 32;
#pragma unroll
                for (int bj = 0; bj < 2; ++bj) {
                    const int tok0 = key0 + 128 * bj + tk0;
                    float cs[8], sn[8];
                    if (!isctx) {
                        const float fi = (m & 1) ? f_hi : f_lo;
                        if (a == 0) {
                            const float x = (float)(tok0 >> 6) * fi; const float c = __builtin_amdgcn_cosf(x), sv = __builtin_amdgcn_sinf(x);
#pragma unroll
                            for (int j = 0; j < 8; ++j) { cs[j] = c; sn[j] = sv; }
                        } else {
#pragma unroll
                            for (int j = 0; j < 8; ++j) { const float x = (float)((tok0 & 63) + j) * fi; cs[j] = __builtin_amdgcn_cosf(x); sn[j] = __builtin_amdgcn_sinf(x); }
                        }
                    } else {
#pragma unroll
                        for (int j = 0; j < 8; ++j) { cs[j] = 1.f; sn[j] = 0.f; }
                    }
                    float o1[8], o2[8];
#pragma unroll
                    for (int n = 0; n < 2; ++n)
#pragma unroll
                        for (int j = 0; j < 4; ++j) {
                            const int jj = n * 4 + j;
                            const float x1 = acc[0][bj][m][n][j], x2 = acc[1][bj][m][n][j];
                            o1[jj] = x1 * cs[jj] - x2 * sn[jj]; o2[jj] = x1 * sn[jj] + x2 * cs[jj];
                        }
                    float v[8];
#pragma unroll
                    for (int j = 0; j < 8; ++j) v[j] = o1[j] * df[j];
                    st8(kf + (size_t)d1 * KEYS + tok0, v);
#pragma unroll
                    for (int j = 0; j < 8; ++j) v[j] = o2[j] * df[j];
                    st8(kf + (size_t)d2 * KEYS + tok0, v);
#pragma unroll
                    for (int j = 0; j < 8; ++j) v[j] = o1[j] * db[j];
                    st8(kb + (size_t)d1 * KEYS + tok0, v);
#pragma unroll
                    for (int j = 0; j < 8; ++j) v[j] = o2[j] * db[j];
                    st8(kb + (size_t)d2 * KEYS + tok0, v);
                    __builtin_amdgcn_sched_barrier(0);
                }
            }
        }
    }
    int l;
    __device__ __forceinline__ void operator()(const f32x4 (&acc)[2][2][4][2], const pg8::Unit& u, int wr, int wc, int fr0, int fq0) const {
        unsigned zo = 0; asm volatile("" : "+s"(zo));
        unsigned char* ws = ws_ + zo; float* red = red_; const float* gq = gq_ + zo; const float* gk = gk_ + zo;
        int fr = fr0, fq = fq0; asm volatile("" : "+v"(fr), "+v"(fq));
        const int pn = u.pn, pm = u.pm;
        if (pn < 2)        rope128<false>(ws, red, acc, (bf16*)(ws + OFF_QR), 512, 256 * pn, 1.f, nullptr, pm, wr, wc, fr, fq);
        else if (pn < 4)   rope128<false>(ws, red, acc, (bf16*)(ws + OFF_KR), 512, 256 * (pn - 2), 0.08838834764831845f, nullptr, pm, wr, wc, fr, fq);
        else if (pn < 8)   plain(acc, (bf16*)(ws + OFF_UR), 1024, 256 * (pn - 4), pm, wr, wc, fr, fq);
        else if (pn < 12)  rope64(ws, acc, (bf16*)(ws + OFF_QS), 1024, 256 * (pn - 8), 0.125f, 4, pm, wr, wc, fr, fq);
        else if (pn == 12) rope64(ws, acc, (bf16*)(ws + OFF_KS), 128, 0, 1.f, 2, pm, wr, wc, fr, fq);
        else if (pn < 17)  rope128<true>(ws, red, acc, (bf16*)(ws + OFF_QA), 1024, 256 * (pn - 13), 1.f, gq, pm, wr, wc, fr, fq);
        else if (pn == 17) rope128<true>(ws, red, acc, (bf16*)(ws + OFF_KA), 256, 0, 1.f, gk, pm, wr, wc, fr, fq);
        else if (pn == 18) plain(acc, (bf16*)(ws + OFF_VA), 256, 0, pm, wr, wc, fr, fq);
        else swapped(ws, acc, pn - 19, l, pm, wr, wc, fr, fq);
    }
};

__device__ __forceinline__ void phase_inproj(const Params& p, int l, char* smem) {
    InprojSched S; S.H = (const char*)(p.ws + OFF_H); S.W = (const char*)(p.ws + OFF_WT); S.G = gridDim.x; S.c = blockIdx.x;
    InprojEpi E; E.ws_ = p.ws; E.gq_ = p.gq + l * 128; E.gk_ = p.gk + l * 128; E.red_ = (float*)(smem + pg8::STAGE_BYTES); E.l = l;
    pg8::gemm_stream<InprojSched, InprojEpi>((PG8_LAS unsigned char*)smem, 1024, S, E);
    __syncthreads();
}


struct OutSched {
    static constexpr bool GATHER = false;
    const char* Y; const char* W; int G, c, nM;
    __device__ __forceinline__ bool next(int i, pg8::Unit& u) const {
        int pm, pn;
        if (!pg8::static_unit(i, G, c, nM, 4, pm, pn)) return false;
        u.pm = pm; u.pn = pn; u.tag = 0; u.A = Y + (size_t)pm * 256 * 2048; u.B = W + (size_t)pn * 256 * 2048;
        return true;
    }
};
struct OutEpi {
    unsigned char* ws_; const float* xin_; const float* cin_; float* out_; int l;
    typedef pg8::f32x4 f32x4;
    __device__ __forceinline__ void operator()(const f32x4 (&acc)[2][2][4][2], const pg8::Unit& u, int wr, int wc, int fr0, int fq0) const {
        unsigned zo = 0; asm volatile("" : "+s"(zo));
        unsigned char* ws = ws_ + zo; const float* xin = xin_ + zo; const float* cin = cin_ + zo; float* out = out_ + zo;
        int fr = fr0, fq = fq0; asm volatile("" : "+v"(fr), "+v"(fq));
        const int pm = u.pm, pn = u.pn;
        const bool isctx = pm >= 64;
        const int v = isctx ? 4 : pm >> 4;
        const int col0 = 256 * pn + 32 * wc + 8 * fq;
        const float* gt = (const float*)(ws + OFF_MOD) + (size_t)(l * 5 + v) * 6144 + 2048 + col0;
        float4 g[2][2];
#pragma unroll
        for (int bj = 0; bj < 2; ++bj)
#pragma unroll
            for (int n = 0; n < 2; ++n) g[bj][n] = *(const float4*)(gt + 128 * bj + 4 * n);
        const int row0 = 256 * pm + 64 * wr + fr;
        bf16* xo = isctx ? (bf16*)(ws + OFF_CX) + (size_t)(row0 - TLAT) * D + col0 : (bf16*)out + (size_t)row0 * (2 * D) + col0;
        const size_t rs = isctx ? D : 2 * D;
#pragma unroll
        for (int ai = 0; ai < 2; ++ai) {
            uint4 a[4][2];
#pragma unroll
            for (int m = 0; m < 4; ++m)
#pragma unroll
                for (int bj = 0; bj < 2; ++bj) a[m][bj] = *(const uint4*)(xo + (size_t)(128 * ai + 16 * m) * rs + 128 * bj);
#pragma unroll
            for (int m = 0; m < 4; ++m)
#pragma unroll
                for (int bj = 0; bj < 2; ++bj) {
                    float af[8], o[8]; unpack8(a[m][bj], af);
#pragma unroll
                    for (int n = 0; n < 2; ++n) { const float4 gg = g[bj][n];
                        o[n * 4 + 0] = af[n * 4 + 0] + gg.x * acc[ai][bj][m][n][0]; o[n * 4 + 1] = af[n * 4 + 1] + gg.y * acc[ai][bj][m][n][1];
                        o[n * 4 + 2] = af[n * 4 + 2] + gg.z * acc[ai][bj][m][n][2]; o[n * 4 + 3] = af[n * 4 + 3] + gg.w * acc[ai][bj][m][n][3]; }
                    InprojEpi::st8(xo + (size_t)(128 * ai + 16 * m) * rs + 128 * bj, o);
                }
            __builtin_amdgcn_sched_barrier(0);
        }
    }
};
__device__ __forceinline__ void phase_outproj(const Params& p, int l, char* smem) {
    OutSched S; S.Y = (const char*)(p.ws + OFF_Y); S.W = (const char*)(p.ws + OFF_WT) + (size_t)WR_OUT * 2048; S.G = gridDim.x; S.c = blockIdx.x; S.nM = (l == 0 ? TALL : TLAT) / 256;
    OutEpi E; E.ws_ = p.ws; E.xin_ = p.x; E.cin_ = p.ctx; E.out_ = p.out; E.l = l;
    pg8::gemm_stream<OutSched, OutEpi>((PG8_LAS unsigned char*)smem, 1024, S, E);
    __syncthreads();
    if (l == 0) conv_run(p, l, 1, smem, 16); else conv_run(p, l, 1, smem, 0, 512, 1024);
}

__device__ __forceinline__ size_t gate_region(int br) { return br == 0 ? OFF_VR : (br == 1 ? OFF_KFT : OFF_F); }
struct GateSched {
    static constexpr bool GATHER = false;
    const char* ws; int G, c, nM, nctx;
    __device__ __forceinline__ bool next(int i, pg8::Unit& u) const {
        int pm, pn;
        if (pg8::static_unit(i, G, c, nM, 12, pm, pn)) {
            u.pm = pm; u.pn = pn; u.tag = 0;
            u.A = ws + OFF_H + (size_t)pm * 256 * 2048; u.B = ws + OFF_WT + (size_t)(WR_G + pn * 256) * 2048;
            return true;
        }
        const int q = i * G + c - nM * 12;
        if (q < 0 || q >= nctx) return false;
        const int t = q / 3, br = q - 3 * t, pmc = t >> 2, pn4 = t & 3;
        u.pm = pmc; u.pn = pn4; u.tag = 2 + br;
        u.A = ws + (br == 0 ? OFF_UR : br == 1 ? OFF_QS : OFF_QA) + (size_t)(64 + pmc) * 256 * 2048;
        u.B = ws + OFF_WT + (size_t)(WR_BR + br * 1024 + pn4 * 256) * 2048;
        return true;
    }
};
struct CtxGateSched {
    static constexpr bool GATHER = false;
    const char* ws; int q;
    __device__ __forceinline__ bool next(int i, pg8::Unit& u) const {
        if (i > 0) return false;
        const int pmc = q / 12, pn12 = q - 12 * pmc;
        u.pm = pmc; u.pn = pn12; u.tag = 1;
        u.A = ws + OFF_H + (size_t)(64 + pmc) * 256 * 2048; u.B = ws + OFF_WT + (size_t)(WR_G + pn12 * 256) * 2048;
        return true;
    }
};
struct GateEpi {
    unsigned char* ws_;
    typedef pg8::f32x4 f32x4;
    __device__ __forceinline__ void operator()(const f32x4 (&acc)[2][2][4][2], const pg8::Unit& u, int wr, int wc, int fr0, int fq0) const {
        unsigned zo = 0; asm volatile("" : "+s"(zo));
        unsigned char* ws = ws_ + zo;
        int fr = fr0, fq = fq0; asm volatile("" : "+v"(fr), "+v"(fq));
        if (u.tag < 2) {
            const int br = u.pn >> 2, pn4 = u.pn & 3;
            bf16* Gp = u.tag == 0 ? (bf16*)(ws + gate_region(br)) : (bf16*)(ws + OFF_GC) + (size_t)br * 1024 * 1024;
#pragma unroll
            for (int ai = 0; ai < 2; ++ai)
#pragma unroll
                for (int m = 0; m < 4; ++m) {
                    const int row = 256 * u.pm + 128 * ai + 64 * wr + 16 * m + fr;
#pragma unroll
                    for (int bj = 0; bj < 2; ++bj) {
                        float o[8];
#pragma unroll
                        for (int n = 0; n < 2; ++n)
#pragma unroll
                            for (int j = 0; j < 4; ++j) o[n * 4 + j] = __builtin_amdgcn_rcpf(1.f + fexp_(-acc[ai][bj][m][n][j]));
                        InprojEpi::st8(Gp + (size_t)row * 1024 + 256 * pn4 + 128 * bj + 32 * wc + 8 * fq, o);
                    }
                    __builtin_amdgcn_sched_barrier(0);
                }
        } else {
            const int br = u.tag - 2;
            const bf16* Gc = (const bf16*)(ws + OFF_GC) + (size_t)br * 1024 * 1024;
            bf16* Pc = (bf16*)(ws + OFF_PC) + (size_t)br * 1024 * 1024;
            const size_t off0 = (size_t)(256 * u.pm + 64 * wr + fr) * 1024 + 256 * u.pn + 32 * wc + 8 * fq;
#pragma unroll
            for (int ai = 0; ai < 2; ++ai) {
                uint4 g[4][2];
#pragma unroll
                for (int m = 0; m < 4; ++m)
#pragma unroll
                    for (int bj = 0; bj < 2; ++bj) g[m][bj] = *(const uint4*)(Gc + off0 + (size_t)(128 * ai + 16 * m) * 1024 + 128 * bj);
#pragma unroll
                for (int m = 0; m < 4; ++m)
#pragma unroll
                    for (int bj = 0; bj < 2; ++bj) {
                        float gf[8]; unpack8(g[m][bj], gf);
                        float o[8];
#pragma unroll
                        for (int n = 0; n < 2; ++n)
#pragma unroll
                            for (int j = 0; j < 4; ++j) o[n * 4 + j] = gf[n * 4 + j] * acc[ai][bj][m][n][j];
                        InprojEpi::st8(Pc + off0 + (size_t)(128 * ai + 16 * m) * 1024 + 128 * bj, o);
                    }
                __builtin_amdgcn_sched_barrier(0);
            }
            __builtin_amdgcn_fence(__ATOMIC_RELEASE, "agent");
            if ((otid() & 63) == 0) __hip_atomic_fetch_add((unsigned*)(ws + OFF_CTL) + 48, 1u, __ATOMIC_RELAXED, __HIP_MEMORY_SCOPE_AGENT);
        }
    }
};
__device__ __forceinline__ void ctx_gate_item(const Params& p, int q, char* smem) {
    CtxGateSched S; S.ws = (const char*)p.ws; S.q = q;
    GateEpi E; E.ws_ = p.ws;
    pg8::gemm_stream<CtxGateSched, GateEpi>((PG8_LAS unsigned char*)smem, 1024, S, E);
    __syncthreads();
}
struct MergeSched {
    static constexpr bool GATHER = false;
    const char* ws; int G, c, nM;
    __device__ __forceinline__ bool next(int i, pg8::Unit& u) const {
        const int j = i / 3, br = i - 3 * j;
        int pm, pn;
        if (!pg8::static_unit(j, G, c, nM, 4, pm, pn)) return false;
        u.pm = pm; u.pn = pn; u.tag = br;
        u.A = ws + (br == 0 ? OFF_UR : br == 1 ? OFF_QS : OFF_QA) + (size_t)pm * 256 * 2048;
        u.B = ws + OFF_WT + (size_t)(WR_BR + br * 1024 + pn * 256) * 2048;
        return true;
    }
};
struct MergeEpi {
    unsigned char* ws_; int tagoff;
    typedef pg8::f32x4 f32x4;
    __device__ __forceinline__ void operator()(const f32x4 (&acc)[2][2][4][2], const pg8::Unit& u, int wr, int wc, int fr0, int fq0) const {
        unsigned zo = 0; asm volatile("" : "+s"(zo));
        unsigned char* ws = ws_ + zo;
        int fr = fr0, fq = fq0; asm volatile("" : "+v"(fr), "+v"(fq));
        const int br = u.tag - tagoff;
        const bf16* Gp = (const bf16*)(ws + gate_region(br));
        bf16* Y = (bf16*)(ws + OFF_Y);
        const size_t off0 = (size_t)(256 * u.pm + 64 * wr + fr) * 1024 + 256 * u.pn + 32 * wc + 8 * fq;
        uint4 gA[2][2], yA[2][2], gB[2][2], yB[2][2];
#define ME_LOAD(G, YV, ai, mp) do { _Pragma("unroll") for (int mm = 0; mm < 2; ++mm) _Pragma("unroll") for (int bj = 0; bj < 2; ++bj) { \
            const size_t off = off0 + (size_t)(128 * (ai) + 16 * (2 * (mp) + mm)) * 1024 + 128 * bj; \
            G[mm][bj] = *(const uint4*)(Gp + off); if (br > 0) YV[mm][bj] = *(const uint4*)(Y + off); } } while (0)
#define ME_PROC(G, YV, ai, mp) do { _Pragma("unroll") for (int mm = 0; mm < 2; ++mm) _Pragma("unroll") for (int bj = 0; bj < 2; ++bj) { \
            const size_t off = off0 + (size_t)(128 * (ai) + 16 * (2 * (mp) + mm)) * 1024 + 128 * bj; \
            float gf[8]; unpack8(G[mm][bj], gf); float o[8]; \
            _Pragma("unroll") for (int n = 0; n < 2; ++n) _Pragma("unroll") for (int j = 0; j < 4; ++j) o[n * 4 + j] = gf[n * 4 + j] * acc[ai][bj][2 * (mp) + mm][n][j]; \
            if (br > 0) { float yf[8]; unpack8(YV[mm][bj], yf); _Pragma("unroll") for (int j = 0; j < 8; ++j) o[j] += yf[j]; } \
            InprojEpi::st8(Y + off, o); } __builtin_amdgcn_sched_barrier(0); } while (0)
        ME_LOAD(gA, yA, 0, 0); __builtin_amdgcn_sched_barrier(0);
        ME_LOAD(gB, yB, 0, 1); __builtin_amdgcn_sched_barrier(0);
        ME_PROC(gA, yA, 0, 0);
        ME_LOAD(gA, yA, 1, 0); __builtin_amdgcn_sched_barrier(0);
        ME_PROC(gB, yB, 0, 1);
        ME_LOAD(gB, yB, 1, 1); __builtin_amdgcn_sched_barrier(0);
        ME_PROC(gA, yA, 1, 0);
        ME_PROC(gB, yB, 1, 1);
#undef ME_LOAD
#undef ME_PROC
    }
};
struct GMSched {
    static constexpr bool GATHER = false;
    const char* ws; int G, c, nM, nctx;
    __device__ __forceinline__ bool next(int i, pg8::Unit& u) const {
        const int myq = nctx > c ? (nctx - 1 - c) / G + 1 : 0;
        if (i < myq) {
            const int q = i * G + c, t = q / 3, br = q - 3 * t, pmc = t >> 2, pn4 = t & 3;
            u.pm = pmc; u.pn = pn4; u.tag = 2 + br;
            u.A = ws + (br == 0 ? OFF_UR : br == 1 ? OFF_QS : OFF_QA) + (size_t)(64 + pmc) * 256 * 2048;
            u.B = ws + OFF_WT + (size_t)(WR_BR + br * 1024 + pn4 * 256) * 2048;
            return true;
        }
        const int i2 = i - myq, j = i2 / 6, k = i2 - 6 * j, br = k >> 1;
        int pm, pn;
        if (!pg8::static_unit(j, G, c, nM, 4, pm, pn)) return false;
        u.pm = pm;
        if (!(k & 1)) { u.pn = br * 4 + pn; u.tag = 0;
            u.A = ws + OFF_H + (size_t)pm * 256 * 2048; u.B = ws + OFF_WT + (size_t)(WR_G + (br * 4 + pn) * 256) * 2048; }
        else { u.pn = pn; u.tag = 8 + br;
            u.A = ws + (br == 0 ? OFF_UR : br == 1 ? OFF_QS : OFF_QA) + (size_t)pm * 256 * 2048; u.B = ws + OFF_WT + (size_t)(WR_BR + br * 1024 + pn * 256) * 2048; }
        return true;
    }
};
struct GMEpi {
    GateEpi g; MergeEpi m;
    typedef pg8::f32x4 f32x4;
    __device__ __forceinline__ void operator()(const f32x4 (&acc)[2][2][4][2], const pg8::Unit& u, int wr, int wc, int fr0, int fq0) const {
        if (u.tag >= 8) m(acc, u, wr, wc, fr0, fq0); else g(acc, u, wr, wc, fr0, fq0);
    }
};
__device__ __forceinline__ void phase_gates_merge(const Params& p, int l, char* smem) {
    const int nctx = (l == 0) ? 48 : 0;
    GMSched S; S.ws = (const char*)p.ws; S.G = gridDim.x; S.c = blockIdx.x; S.nM = TLAT / 256; S.nctx = nctx;
    GMEpi E; E.g.ws_ = p.ws; E.m.ws_ = p.ws; E.m.tagoff = 8;
    pg8::gemm_stream<GMSched, GMEpi>((PG8_LAS unsigned char*)smem, 1024, S, E);
    __syncthreads();
    if (l == 0) {
        if (threadIdx.x == 0) {
            unsigned* ctr = (unsigned*)(p.ws + OFF_CTL) + 48; unsigned sp = 0;
            while (__hip_atomic_load(ctr, __ATOMIC_RELAXED, __HIP_MEMORY_SCOPE_AGENT) < (unsigned)(nctx * 8)) { __builtin_amdgcn_s_sleep(2); if (++sp > (1u << 24)) break; }
            __builtin_amdgcn_fence(__ATOMIC_ACQUIRE, "agent");
        }
        __syncthreads();
        const uint4* P0 = (const uint4*)(p.ws + OFF_PC); uint4* Yc = (uint4*)(p.ws + OFF_Y + (size_t)TLAT * 2048);
        for (int i = blockIdx.x * NT + otid(); i < 1024 * 1024 / 8; i += gridDim.x * NT) {
            float a[8], b[8], c[8]; unpack8(P0[i], a); unpack8(P0[i + 131072], b); unpack8(P0[i + 262144], c);
            uint4 o; o.x = pack2(a[0] + b[0] + c[0], a[1] + b[1] + c[1]); o.y = pack2(a[2] + b[2] + c[2], a[3] + b[3] + c[3]);
            o.z = pack2(a[4] + b[4] + c[4], a[5] + b[5] + c[5]); o.w = pack2(a[6] + b[6] + c[6], a[7] + b[7] + c[7]);
            Yc[i] = o;
        }
    }
}
__device__ __forceinline__ bool moe_find(int c, int tile, int& e, int& mt, int& rowbase, int& ce) {
    const int lane = otid() & 63;
    const int nt = (c + 255) >> 8;
    int pt = nt, pr = c;
#pragma unroll
    for (int o = 1; o < 16; o <<= 1) { const int a = shup(pt, o, lane), b = shup(pr, o, lane); if (lane >= o) { pt += a; pr += b; } }
    const bool mine = lane < 16 && tile >= pt - nt && tile < pt;
    const unsigned long long m = __ballot(mine);
    if (m == 0ull) return false;
    const int src = __ffsll((long long)m) - 1;
    e = src;
    mt = tile - (__builtin_amdgcn_readlane(pt, src) - __builtin_amdgcn_readlane(nt, src));
    rowbase = __builtin_amdgcn_readlane(pr, src) - __builtin_amdgcn_readlane(c, src);
    ce = __builtin_amdgcn_readlane(c, src);
    return true;
}
struct Moe1Sched {
    static constexpr bool GATHER = true;
    const char* ws; int cl; const int* lts; int G, c, l;
    __device__ __forceinline__ bool next(int i, pg8::Unit& u) const {
        const int L = i * G + c; const int tile = L >> 2, pn = L & 3;
        int e, mt, rowbase, ce;
        if (!moe_find(cl, tile, e, mt, rowbase, ce)) return false;
        u.pm = mt; u.pn = pn; u.tag = e; u.x0 = rowbase; u.x1 = ce;
        u.A = ws + OFF_H; u.B = ws + wgu_off(l, e) + (size_t)(pn * 256) * 2048;
        return true;
    }
    __device__ __forceinline__ unsigned row_off(const pg8::Unit& u, int r) const {
        int idx = u.pm * 256 + r; if (idx >= u.x1) idx = u.x1 - 1;
        return (unsigned)(lts[(size_t)u.tag * TALL + idx] >> 1) * 2048u;
    }
};
struct Moe1Epi {
    unsigned char* ws_; int l;
    typedef pg8::f32x4 f32x4;
    __device__ __forceinline__ void operator()(const f32x4 (&acc)[2][2][4][2], const pg8::Unit& u, int wr, int wc, int fr0, int fq0) const {
        unsigned zo = 0; asm volatile("" : "+v"(zo));
        unsigned char* ws = ws_ + zo;
        int fr = fr0, fq = fq0; asm volatile("" : "+v"(fr), "+v"(fq));
        const int mt = u.pm, rowbase = u.x0, ce = u.x1;
        bf16* HB = (bf16*)(ws + OFF_HB);
#pragma unroll
        for (int ai = 0; ai < 2; ++ai)
#pragma unroll
            for (int m = 0; m < 4; ++m) {
                const int idx = mt * 256 + 128 * ai + 64 * wr + 16 * m + fr;
                if (idx < ce) {
                    float o[8];
#pragma unroll
                    for (int n = 0; n < 2; ++n)
#pragma unroll
                        for (int j = 0; j < 4; ++j) { const float g = acc[ai][0][m][n][j], uu = acc[ai][1][m][n][j]; o[n * 4 + j] = fsilu_(g) * uu; }
                    InprojEpi::st8(HB + (size_t)(rowbase + idx) * 512 + 128 * u.pn + 32 * wc + 8 * fq, o);
                }
                __builtin_amdgcn_sched_barrier(0);
            }
    }
};
__device__ __forceinline__ void phase_moe1(const Params& p, int l, char* smem) {
    Moe1Sched S; S.ws = (const char*)p.ws; { const int ln_ = otid() & 63; S.cl = ln_ < 16 ? ((const int*)(p.ws + OFF_CTL))[l * 16 + ln_] : 0; } S.lts = (const int*)(p.ws + OFF_LTS); S.G = gridDim.x; S.c = blockIdx.x; S.l = l;
    Moe1Epi E; E.ws_ = p.ws; E.l = l;
    pg8::gemm_stream<Moe1Sched, Moe1Epi>((PG8_LAS unsigned char*)smem, 1024, S, E);
    __syncthreads();
    if (l == 0) {
        const int* cnt = (const int*)(p.ws + OFF_CTL) + l * 16;
        int tiles = 0;
        for (int i = 0; i < 16; ++i) tiles += (__builtin_amdgcn_readfirstlane(cnt[i]) + 255) >> 8;
        const int rem = (tiles * 4) % (int)gridDim.x;
        conv_run(p, 1, 0, smem, (rem > 0 && rem < (int)gridDim.x - 32) ? rem : 0);
    } else {
        const int* cnt = (const int*)(p.ws + OFF_CTL) + l * 16;
        int tiles = 0;
        for (int i = 0; i < 16; ++i) tiles += (__builtin_amdgcn_readfirstlane(cnt[i]) + 255) >> 8;
        const int rem = (tiles * 4) % (int)gridDim.x;
        conv_run(p, l, 1, smem, (rem > 0 && rem < (int)gridDim.x - 32) ? rem : 0, 1024, CONV_MOE);
    }
}
struct Moe2Sched {
    static constexpr bool GATHER = false;
    const char* ws; int cl; int G, c;
    __device__ __forceinline__ bool next(int i, pg8::Unit& u) const {
        const int L = i * G + c; const int tile = L >> 2, pn = L & 3;
        int e, mt, rowbase, ce;
        if (!moe_find(cl, tile, e, mt, rowbase, ce)) return false;
        u.pm = mt; u.pn = pn; u.tag = e; u.x0 = rowbase; u.x1 = ce;
        u.A = ws + OFF_HB + (size_t)(rowbase + mt * 256) * 1024; u.B = ws + OFF_WD + ((size_t)e * 1024 + pn * 256) * 1024;
        return true;
    }
};
struct Moe2Epi {
    unsigned char* ws_; int l;
    typedef pg8::f32x4 f32x4;
    __device__ __forceinline__ void operator()(const f32x4 (&acc)[2][2][4][2], const pg8::Unit& u, int wr, int wc, int fr0, int fq0) const {
        unsigned zo = 0; asm volatile("" : "+s"(zo));
        unsigned char* ws = ws_ + zo;
        int fr = fr0, fq = fq0; asm volatile("" : "+v"(fr), "+v"(fq));
        const int e = u.tag, mt = u.pm, ce = u.x1;
        const int* lts = (const int*)(ws + OFF_LTS) + (size_t)e * TALL; const float* lw = (const float*)(ws + OFF_LW) + (size_t)e * TALL;
        bf16* YB = (bf16*)(ws + OFF_YB);
        int tsv[2][4]; float wv[2][4];
#pragma unroll
        for (int ai = 0; ai < 2; ++ai)
#pragma unroll
            for (int m = 0; m < 4; ++m) {
                int idx = mt * 256 + 128 * ai + 64 * wr + 16 * m + fr; if (idx >= ce) idx = ce - 1;
                tsv[ai][m] = lts[idx]; wv[ai][m] = lw[idx];
            }
#pragma unroll
        for (int ai = 0; ai < 2; ++ai)
#pragma unroll
            for (int m = 0; m < 4; ++m) {
                const int idx = mt * 256 + 128 * ai + 64 * wr + 16 * m + fr;
                if (idx < ce) {
                    const int ts = tsv[ai][m]; const float w = wv[ai][m];
#pragma unroll
                    for (int bj = 0; bj < 2; ++bj) {
                        float o[8];
#pragma unroll
                        for (int n = 0; n < 2; ++n)
#pragma unroll
                            for (int j = 0; j < 4; ++j) o[n * 4 + j] = w * acc[ai][bj][m][n][j];
                        InprojEpi::st8(YB + (size_t)ts * 1024 + 256 * u.pn + 128 * bj + 32 * wc + 8 * fq, o);
                    }
                }
            }
    }
};
__device__ __forceinline__ void phase_moe2(const Params& p, int l, char* smem) {
    Moe2Sched S; S.ws = (const char*)p.ws; { const int ln_ = otid() & 63; S.cl = ln_ < 16 ? ((const int*)(p.ws + OFF_CTL))[l * 16 + ln_] : 0; } S.G = gridDim.x; S.c = blockIdx.x;
    Moe2Epi E; E.ws_ = p.ws; E.l = l;
    pg8::gemm_stream<Moe2Sched, Moe2Epi>((PG8_LAS unsigned char*)smem, 512, S, E);
    __syncthreads();
    if (l == 0) {
        const int* cnt = (const int*)(p.ws + OFF_CTL) + l * 16;
        int tiles = 0;
        for (int i = 0; i < 16; ++i) tiles += (__builtin_amdgcn_readfirstlane(cnt[i]) + 255) >> 8;
        const int rem = (tiles * 4) % (int)gridDim.x;
        conv_run(p, 1, 1, smem, (rem > 0 && rem < (int)gridDim.x - 32) ? rem : 0, 0, 512);
    }
}

namespace ga {
using s16x4  = __attribute__((ext_vector_type(4))) short;
using u32x4  = __attribute__((ext_vector_type(4))) unsigned;
constexpr int QBLK = 32, KVBLK = 64;
constexpr float SCALE = 0.088388347648318440f;
constexpr float THR = 8.f;
constexpr int LDQ = 1024, LDK = 256, LDO = 1024;
constexpr int SHM_V = KVBLK * 128 * 2, SHM_K = KVBLK * 128 * 2;
constexpr int SHM_ATTN = 2 * SHM_V + 2 * SHM_K + 8 * 64 * 4;
#define KSWZ(row, colB) ((row) * 256 + ((colB) ^ (((row) & 7) << 4)))
#define SBAR() __builtin_amdgcn_sched_barrier(0)
__device__ __forceinline__ int crow(int r, int hi) { return (r & 3) + 8 * (r >> 2) + 4 * hi; }
__device__ __forceinline__ unsigned cvtpk(float lo, float hi) { return pack2(lo, hi); }
__device__ __forceinline__ void partialSM_fixed(f32x16& p0, f32x16& p1, float mnC) {
  constexpr float C = SCALE * 1.4426950408889634f;
#pragma unroll
  for (int r = 0; r < 16; ++r) p0[r] = __builtin_amdgcn_exp2f(fmaf(p0[r], C, mnC));
#pragma unroll
  for (int r = 0; r < 16; ++r) p1[r] = fmaf(p1[r], C, mnC);
}
__device__ __forceinline__ void partialSM(f32x16& p0, f32x16& p1, float& m_reg, float& mn, float& alpha) {
  constexpr float C = SCALE * 1.4426950408889634f;
  float pmax = p0[0];
#pragma unroll
  for (int r = 1; r < 16; ++r) pmax = fmaxf(pmax, p0[r]);
#pragma unroll
  for (int r = 0; r < 16; ++r) pmax = fmaxf(pmax, p1[r]);
  { auto rr = __builtin_amdgcn_permlane32_swap(__float_as_uint(pmax), __float_as_uint(pmax), false, false);
    pmax = fmaxf(__uint_as_float(rr[0]), __uint_as_float(rr[1])); }
  if (__builtin_expect(__all(pmax - m_reg <= THR / SCALE), 1)) { mn = m_reg; alpha = 1.f; }
  else { mn = fmaxf(m_reg, pmax); alpha = __builtin_amdgcn_exp2f((m_reg - mn) * C); m_reg = mn; }
  float mnC = -mn * C;
#pragma unroll
  for (int r = 0; r < 16; ++r) p0[r] = fmaf(p0[r], C, mnC);
#pragma unroll
  for (int r = 0; r < 16; ++r) p1[r] = fmaf(p1[r], C, mnC);
#pragma unroll
  for (int r = 0; r < 16; ++r) p0[r] = __builtin_amdgcn_exp2f(p0[r]);
}
__device__ __forceinline__ void finishSM(f32x16& p0, f32x16& p1, float alpha, float& l_reg, bf16x8& pa0, bf16x8& pa1, bf16x8& pa2, bf16x8& pa3) {
#pragma unroll
  for (int r = 0; r < 16; ++r) p1[r] = __builtin_amdgcn_exp2f(p1[r]);
  float ps = 0;
#pragma unroll
  for (int r = 0; r < 16; ++r) ps += p0[r];
#pragma unroll
  for (int r = 0; r < 16; ++r) ps += p1[r];
  { auto rr = __builtin_amdgcn_permlane32_swap(__float_as_uint(ps), __float_as_uint(ps), false, false);
    ps = __uint_as_float(rr[0]) + __uint_as_float(rr[1]); }
  l_reg = l_reg * alpha + ps;
#define PK4(P, BASE, OUT) do { unsigned a0 = cvtpk(P[BASE + 0], P[BASE + 1]), a1 = cvtpk(P[BASE + 2], P[BASE + 3]);   \
    unsigned b0 = cvtpk(P[BASE + 4], P[BASE + 5]), b1 = cvtpk(P[BASE + 6], P[BASE + 7]);                              \
    auto r0 = __builtin_amdgcn_permlane32_swap(a0, b0, false, false); auto r1 = __builtin_amdgcn_permlane32_swap(a1, b1, false, false); \
    u32x4 w = {r0[0], r1[0], r0[1], r1[1]}; OUT = *reinterpret_cast<bf16x8*>(&w); } while (0)
  PK4(p0, 0, pa0); PK4(p0, 8, pa1); PK4(p1, 0, pa2); PK4(p1, 8, pa3);
#undef PK4
}
__device__ __forceinline__ void qkt(f32x16& p0, f32x16& p1, const char* Ks, const bf16x8* qr, int r32, int hi) {
  p0 = f32x16{}; p1 = f32x16{};
#pragma unroll
  for (int d0 = 0; d0 < 8; ++d0) { int cb = (d0 * 16 + hi * 8) * 2;
    bf16x8 b0 = *reinterpret_cast<const bf16x8*>(Ks + KSWZ(r32, cb));
    bf16x8 b1 = *reinterpret_cast<const bf16x8*>(Ks + KSWZ(32 + r32, cb));
    p0 = __builtin_amdgcn_mfma_f32_32x32x16_bf16(b0, qr[d0], p0, 0, 0, 0);
    p1 = __builtin_amdgcn_mfma_f32_32x32x16_bf16(b1, qr[d0], p1, 0, 0, 0); }
}
__device__ __forceinline__ int v_st(int k, int c) { const int kk = (k & ~0xC) | ((k & 4) << 1) | ((k & 8) >> 1); return ((kk >> 3) * 4 + (c >> 5)) * 512 + ((kk & 7) * 32 + (c & 31)) * 2; }
__device__ __forceinline__ int v_rd_base(int lane) { return ((lane & 3) << 3) | (((lane >> 2) & 3) << 6) | (((lane >> 4) & 1) << 5) | (((lane >> 5) & 1) << 8); }
constexpr int v_rd_off(int d0, int ks, int half) { return d0 * 512 + ks * 4096 + half * 2048; }
template <int OFF> __device__ __forceinline__ s16x4 tr_read(int vb) {
  s16x4 r; asm volatile("ds_read_b64_tr_b16 %0, %1 offset:%2" : "=&v"(r) : "v"(vb), "i"(OFF) : "memory"); return r;
}
template <int D0> __device__ __forceinline__ void pv_one(f32x16& od, int vb, bf16x8 pa0, bf16x8 pa1, bf16x8 pa2, bf16x8 pa3) {
  const s16x4 l0 = tr_read<v_rd_off(D0, 0, 0)>(vb), h0 = tr_read<v_rd_off(D0, 0, 1)>(vb), l1 = tr_read<v_rd_off(D0, 1, 0)>(vb), h1 = tr_read<v_rd_off(D0, 1, 1)>(vb);
  const s16x4 l2 = tr_read<v_rd_off(D0, 2, 0)>(vb), h2 = tr_read<v_rd_off(D0, 2, 1)>(vb), l3 = tr_read<v_rd_off(D0, 3, 0)>(vb), h3 = tr_read<v_rd_off(D0, 3, 1)>(vb);
  asm volatile("s_waitcnt lgkmcnt(0)" ::: "memory"); SBAR();
#define PK(L, H) (bf16x8){L[0], L[1], L[2], L[3], H[0], H[1], H[2], H[3]}
  od = __builtin_amdgcn_mfma_f32_32x32x16_bf16(pa0, PK(l0, h0), od, 0, 0, 0);
  od = __builtin_amdgcn_mfma_f32_32x32x16_bf16(pa1, PK(l1, h1), od, 0, 0, 0);
  od = __builtin_amdgcn_mfma_f32_32x32x16_bf16(pa2, PK(l2, h2), od, 0, 0, 0);
  od = __builtin_amdgcn_mfma_f32_32x32x16_bf16(pa3, PK(l3, h3), od, 0, 0, 0);
#undef PK
}
__device__ __forceinline__ void pv_d0(f32x16* o, int vb, bf16x8 pa0, bf16x8 pa1, bf16x8 pa2, bf16x8 pa3) {
  pv_one<0>(o[0], vb, pa0, pa1, pa2, pa3); pv_one<1>(o[1], vb, pa0, pa1, pa2, pa3); pv_one<2>(o[2], vb, pa0, pa1, pa2, pa3); pv_one<3>(o[3], vb, pa0, pa1, pa2, pa3);
}

__device__ __forceinline__ void attn_dense_body(bf16* Qb, const bf16* Klat, const bf16* Vlat, const bf16* Kctx, const bf16* Vctx,
                                                int nlat, int seq, char* lds, float mfix) {
  const int tid = otid(), wid = tid >> 6, lane = tid & 63, r32 = lane & 31, hi = lane >> 5;
  char* V_lds = lds; char* K_lds = lds + 2 * SHM_V;
  float* wsl = (float*)(lds + 2 * SHM_V + 2 * SHM_K) + wid * 64; float* li_l = wsl; float* al_l = wsl + 32;
  float l_reg = 0; f32x16 o[4] = {}; bf16x8 qr[8];
  const bf16* Qw = Qb + (long)(wid * QBLK + r32) * LDQ + hi * 8;
#pragma unroll
  for (int d0 = 0; d0 < 8; ++d0) qr[d0] = *reinterpret_cast<const bf16x8*>(Qw + d0 * 16);
  const int sr = tid >> 4, sc = (tid & 15) * 8, vst0 = v_st(sr, sc), vst1 = v_st(32 + sr, sc);
  const int vb0 = (int)(uintptr_t)V_lds + v_rd_base(lane);
  struct { bf16x8 vs0, vs1, ks0, ks1; } sr_[2];
#define KVROW(k0) ((k0) < nlat ? (long)(k0) * LDK : (long)((k0) - nlat) * LDK)
#define SLOAD(i, k0) do { const bf16* kb_ = ((k0) < nlat ? Klat : Kctx) + KVROW(k0); const bf16* vb_ = ((k0) < nlat ? Vlat : Vctx) + KVROW(k0); \
    sr_[i].vs0 = *reinterpret_cast<const bf16x8*>(vb_ + (long)sr * LDK + sc); sr_[i].vs1 = *reinterpret_cast<const bf16x8*>(vb_ + (long)(32 + sr) * LDK + sc); \
    sr_[i].ks0 = *reinterpret_cast<const bf16x8*>(kb_ + (long)sr * LDK + sc); sr_[i].ks1 = *reinterpret_cast<const bf16x8*>(kb_ + (long)(32 + sr) * LDK + sc); } while (0)
#define SWRITE(b, i) do { *(bf16x8*)(V_lds + (b) * SHM_V + vst0) = sr_[i].vs0;          \
    *(bf16x8*)(V_lds + (b) * SHM_V + vst1) = sr_[i].vs1; int kc = sc * 2;               \
    *(bf16x8*)(K_lds + (b) * SHM_K + KSWZ(sr, kc)) = sr_[i].ks0;                       \
    *(bf16x8*)(K_lds + (b) * SHM_K + KSWZ(32 + sr, kc)) = sr_[i].ks1; } while (0)
#define SWAIT() asm volatile("s_waitcnt vmcnt(4)" ::: "memory")
#define RESC(a) do { if (__any((a) < 1.f)) { if (hi == 0) al_l[r32] = (a); asm volatile("s_waitcnt lgkmcnt(0)" ::: "memory"); \
    _Pragma("unroll") for (int d = 0; d < 4; ++d) _Pragma("unroll") for (int r = 0; r < 16; ++r) o[d][r] *= al_l[crow(r, hi)]; } } while (0)
  f32x16 pA0, pA1, pB0, pB1; bf16x8 pa0, pa1, pa2, pa3; const int NTL = seq / KVBLK;
  const float mnC = -mfix * (SCALE * 1.4426950408889634f);
  constexpr int SE = 0, SO = 1;
  SLOAD(SE, 0); asm volatile("s_waitcnt vmcnt(0)" ::: "memory"); SWRITE(0, SE); __syncthreads();
  qkt(pA0, pA1, K_lds, qr, r32, hi); partialSM_fixed(pA0, pA1, mnC);
  SLOAD(SO, KVBLK); if (2 < NTL) SLOAD(SE, 2 * KVBLK);
  SWAIT(); SWRITE(1, SO); __syncthreads();
  for (int j = 1; j + 1 < NTL; j += 2) {
    SBAR(); qkt(pB0, pB1, K_lds + SHM_K, qr, r32, hi);
    finishSM(pA0, pA1, 1.f, l_reg, pa0, pa1, pa2, pa3); SBAR();
    SLOAD(SO, (j + 2) * KVBLK); SBAR();
    pv_d0(o, vb0, pa0, pa1, pa2, pa3); partialSM_fixed(pB0, pB1, mnC);
    __syncthreads(); SWAIT(); SWRITE(0, SE);
    __syncthreads();
    SBAR(); qkt(pA0, pA1, K_lds, qr, r32, hi);
    finishSM(pB0, pB1, 1.f, l_reg, pa0, pa1, pa2, pa3); SBAR();
    if (j + 3 < NTL) SLOAD(SE, (j + 3) * KVBLK); SBAR();
    pv_d0(o, vb0 + (int)SHM_V, pa0, pa1, pa2, pa3); partialSM_fixed(pA0, pA1, mnC);
    __syncthreads(); SWAIT(); SWRITE(1, SO);
    __syncthreads();
  }
  SBAR(); qkt(pB0, pB1, K_lds + SHM_K, qr, r32, hi);
  finishSM(pA0, pA1, 1.f, l_reg, pa0, pa1, pa2, pa3); SBAR();
  pv_d0(o, vb0, pa0, pa1, pa2, pa3); partialSM_fixed(pB0, pB1, mnC);
  __syncthreads();
  finishSM(pB0, pB1, 1.f, l_reg, pa0, pa1, pa2, pa3); SBAR();
  pv_d0(o, vb0 + (int)SHM_V, pa0, pa1, pa2, pa3);
  if (hi == 0) li_l[r32] = l_reg; asm volatile("s_waitcnt lgkmcnt(0)" ::: "memory");
  float rli[16];
#pragma unroll
  for (int r = 0; r < 16; ++r) rli[r] = __builtin_amdgcn_rcpf(li_l[crow(r, hi)]);
  bf16* Ow = Qb + (long)(wid * QBLK) * LDO;
#pragma unroll
  for (int r = 0; r < 16; ++r) { int orow = crow(r, hi);
#pragma unroll
    for (int d0 = 0; d0 < 4; ++d0) Ow[(long)orow * LDO + d0 * 32 + r32] = f2bf(o[d0][r] * rli[r]); }
  __syncthreads();
#undef KVROW
#undef SLOAD
#undef SWRITE
#undef SWAIT
#undef RESC
}
#undef KSWZ
}

__device__ __forceinline__ void ga_item(const Params& p, int l, int it, char* smem) {
    const float mfix = ((const float*)(p.ws + OFF_DEC))[16 + l];
    bf16* QA = (bf16*)(p.ws + OFF_QA); const bf16* KA = (const bf16*)(p.ws + OFF_KA); const bf16* VA = (const bf16*)(p.ws + OFF_VA);
    if (it < 512) {
        const int pair = it & 7, j = it >> 3, hg = j >> 4, qb = j & 15, b = pair >> 1, kvh = pair & 1, head = kvh * 4 + hg;
        ga::attn_dense_body(QA + (size_t)(b * SEQ + qb * 256) * 1024 + head * 128,
                            KA + (size_t)(b * SEQ) * 256 + kvh * 128, VA + (size_t)(b * SEQ) * 256 + kvh * 128,
                            KA + (size_t)(TLAT + b * CTXL) * 256 + kvh * 128, VA + (size_t)(TLAT + b * CTXL) * 256 + kvh * 128,
                            4096, 4352, smem, mfix);
    } else {
        const int j = it - 512, b = j >> 3, head = j & 7, kvh = head >> 2;
        const bf16* kc = KA + (size_t)(TLAT + b * CTXL) * 256 + kvh * 128; const bf16* vc = VA + (size_t)(TLAT + b * CTXL) * 256 + kvh * 128;
        ga::attn_dense_body(QA + (size_t)(TLAT + b * CTXL) * 1024 + head * 128, kc, vc, kc, vc, 0, 256, smem, mfix);
    }
}
__device__ __forceinline__ int chunk_key0(int c) { return c < 32 ? c * 128 : 4096 + (c - 32) * 128; }
constexpr int RS_ROWB = 272, RS_STAGE = 160 * RS_ROWB;
struct RsStage { pg8::u32x4 q0, q1, q2, q3, q4; };
__device__ __forceinline__ void ret_state_job(const Params& p, int l, int job, char* lds) {
    const int tid = otid(), wid = tid >> 6, lane = tid & 63, r16 = lane & 15, kg = lane >> 4;
    const int x = job & 7, slot = job >> 3, seqi = 4 * x + (slot >> 3), dvq = slot & 7, bh = seqi >> 1, dir = seqi & 1, h = bh & 3;
    const float g128 = fexp_(128.f * ((const float*)(p.ws + OFF_DEC))[l * 8 + dir * 4 + h]);
    const int cr = tid >> 4, cc = tid & 15;
    const bf16* kgp = (const bf16*)(p.ws + (dir ? OFF_KBT : OFF_KFT)) + ((size_t)bh * 128 + cr) * KEYS + cc * 8;
    const bf16* vgp = (const bf16*)(p.ws + OFF_VR) + ((size_t)bh * 256 + dvq * 32 + cr) * KEYS + cc * 8;
    char* wdst = lds + cr * RS_ROWB + cc * 16;
    const char* ka = lds + (wid * 16 + r16) * RS_ROWB + 16 * kg;
    const char* va = lds + (128 + r16) * RS_ROWB + 16 * kg;
    bf16* Fd = (bf16*)(p.ws + OFF_F) + (size_t)(dir * 16 + bh) * 34 * 32768 + (size_t)(dvq * 32 + r16) * 128 + wid * 16 + 4 * kg;
    pg8::f32x4 s0 = {0.f, 0.f, 0.f, 0.f}, s1 = s0;
    RsStage g0, g1, g2, g3, g4, g5;
#define RS_CH(KI) (dir ? ((KI) == 0 ? 33 : ((KI) == 1 ? 32 : 33 - (KI))) : ((KI) == 0 ? 32 : ((KI) == 1 ? 33 : (KI) - 2)))
#define RS_GLOAD(X, KI) do { const int k0_ = chunk_key0(RS_CH(KI)); \
        X.q0 = *(const pg8::u32x4*)(kgp + k0_); X.q1 = *(const pg8::u32x4*)(kgp + (size_t)32 * KEYS + k0_); X.q2 = *(const pg8::u32x4*)(kgp + (size_t)64 * KEYS + k0_); \
        X.q3 = *(const pg8::u32x4*)(kgp + (size_t)96 * KEYS + k0_); X.q4 = *(const pg8::u32x4*)(vgp + k0_); } while (0)
#define RS_LWRITE(X, BUF) do { char* d_ = wdst + (BUF) * RS_STAGE; \
        *(pg8::u32x4*)d_ = X.q0; *(pg8::u32x4*)(d_ + 32 * RS_ROWB) = X.q1; *(pg8::u32x4*)(d_ + 64 * RS_ROWB) = X.q2; \
        *(pg8::u32x4*)(d_ + 96 * RS_ROWB) = X.q3; *(pg8::u32x4*)(d_ + 128 * RS_ROWB) = X.q4; } while (0)
#define RS_STEP(KI, PAR, SW, SL) do { if ((KI) + 6 < 34) RS_GLOAD(SL, (KI) + 6); \
        if ((KI) + 1 < 34) RS_LWRITE(SW, 1 - (PAR)); \
        { bf16* d_ = Fd + (size_t)RS_CH(KI) * 32768; \
          *(uint2*)d_ = make_uint2(pack2(s0[0], s0[1]), pack2(s0[2], s0[3])); *(uint2*)(d_ + 16 * 128) = make_uint2(pack2(s1[0], s1[1]), pack2(s1[2], s1[3])); } \
        s0 *= g128; s1 *= g128; \
        _Pragma("unroll") for (int ks = 0; ks < 4; ++ks) { \
            const bf16x8 fk_ = *reinterpret_cast<const bf16x8*>(ka + (PAR) * RS_STAGE + 64 * ks); \
            const bf16x8 fa_ = *reinterpret_cast<const bf16x8*>(va + (PAR) * RS_STAGE + 64 * ks); \
            const bf16x8 fb_ = *reinterpret_cast<const bf16x8*>(va + (PAR) * RS_STAGE + 16 * RS_ROWB + 64 * ks); \
            s0 = __builtin_amdgcn_mfma_f32_16x16x32_bf16(fk_, fa_, s0, 0, 0, 0); s1 = __builtin_amdgcn_mfma_f32_16x16x32_bf16(fk_, fb_, s1, 0, 0, 0); } \
        __syncthreads(); } while (0)
    RS_GLOAD(g0, 0); RS_GLOAD(g1, 1); RS_GLOAD(g2, 2); RS_GLOAD(g3, 3); RS_GLOAD(g4, 4); RS_GLOAD(g5, 5);
    RS_LWRITE(g0, 0);
    __syncthreads();
    for (int kb = 0; kb < 30; kb += 6) {
        RS_STEP(kb, 0, g1, g0); RS_STEP(kb + 1, 1, g2, g1); RS_STEP(kb + 2, 0, g3, g2);
        RS_STEP(kb + 3, 1, g4, g3); RS_STEP(kb + 4, 0, g5, g4); RS_STEP(kb + 5, 1, g0, g5);
    }
    RS_STEP(30, 0, g1, g0); RS_STEP(31, 1, g2, g1); RS_STEP(32, 0, g3, g2); RS_STEP(33, 1, g4, g3);
#undef RS_STEP
#undef RS_LWRITE
#undef RS_GLOAD
#undef RS_CH
}

namespace r3 {
constexpr int KROWB = 272, VROWB = 264;
constexpr int KS_BYTES = 128 * KROWB, VT_BYTES = 256 * VROWB;
__device__ __forceinline__ int crow(int r, int hi) { return (r & 3) + 8 * (r >> 2) + 4 * hi; }
__device__ __forceinline__ bf16x8 scaleq(bf16x8 q, float sc) {
    ga::u32x4 w = *reinterpret_cast<ga::u32x4*>(&q);
    ga::u32x4 o = {pack2(lo2f(w[0]) * sc, hi2f(w[0]) * sc), pack2(lo2f(w[1]) * sc, hi2f(w[1]) * sc), pack2(lo2f(w[2]) * sc, hi2f(w[2]) * sc), pack2(lo2f(w[3]) * sc, hi2f(w[3]) * sc)};
    return *reinterpret_cast<bf16x8*>(&o);
}
__device__ __forceinline__ void body(const Params& p, int l, int b, int h, int c, char* lds) {
    const int tid = otid(), wid = tid >> 6, lane = tid & 63, r32 = lane & 31, hi = lane >> 5, wq = wid & 3, wv = wid >> 2;
    const bf16* QR = (const bf16*)(p.ws + OFF_QR); const bf16* KR = (const bf16*)(p.ws + OFF_KR);
    const bf16* VT = (const bf16*)(p.ws + OFF_VR); bf16* UR = (bf16*)(p.ws + OFF_UR);
    const bf16* F = (const bf16*)(p.ws + OFF_F);
    const int bh = b * 4 + h, key0 = chunk_key0(c);
    const int row0 = c < 32 ? b * SEQ + c * 128 : TLAT + b * CTXL + (c - 32) * 128;
    const float* dec = (const float*)(p.ws + OFF_DEC) + 64 + (size_t)((l * 4 + h) * 6) * 128;
    char* Ks = lds; char* Vt = lds + KS_BYTES; float* red = (float*)(lds + KS_BYTES + VT_BYTES);
    {
        uint4 kv[4], vv[8];
#pragma unroll
        for (int i = 0; i < 4; ++i) { const int idx = tid + NT * i; kv[i] = *(const uint4*)(KR + (size_t)(row0 + (idx >> 4)) * 512 + h * 128 + (idx & 15) * 8); }
#pragma unroll
        for (int i = 0; i < 8; ++i) { const int idx = tid + NT * i; vv[i] = *(const uint4*)(VT + ((size_t)bh * 256 + (idx >> 4)) * KEYS + key0 + (idx & 15) * 8); }
#pragma unroll
        for (int i = 0; i < 4; ++i) { const int idx = tid + NT * i; *(uint4*)(Ks + (idx >> 4) * KROWB + (idx & 15) * 16) = kv[i]; }
#pragma unroll
        for (int i = 0; i < 8; ++i) { const int idx = tid + NT * i; char* d = Vt + (idx >> 4) * VROWB + (idx & 15) * 16;
            *(uint2*)d = make_uint2(vv[i].x, vv[i].y); *(uint2*)(d + 8) = make_uint2(vv[i].z, vv[i].w); }
    }
    const int iq = 32 * wq + r32;
    bf16x8 qr[8];
    {
        const bf16* Qw = QR + (size_t)(row0 + iq) * 512 + h * 128 + hi * 8;
#pragma unroll
        for (int d0 = 0; d0 < 8; ++d0) qr[d0] = *reinterpret_cast<const bf16x8*>(Qw + d0 * 16);
    }
    __syncthreads();
    f32x16 o[4] = {};
    const bf16* St0 = F + ((size_t)(0 * 16 + bh) * 34 + c) * 32768; const bf16* St1 = F + ((size_t)(1 * 16 + bh) * 34 + c) * 32768;
#define R3_LD(P, i) (*(const uint4*)((P) + (size_t)(tid + NT * (i)) * 8))
    uint4 sv0 = R3_LD(St0, 0), sv1 = R3_LD(St0, 1), sv2 = R3_LD(St0, 2), sv3 = R3_LD(St0, 3), sv4 = R3_LD(St0, 4), sv5 = R3_LD(St0, 5), sv6 = R3_LD(St0, 6), sv7 = R3_LD(St0, 7);
#pragma unroll 1
    for (int kb = 0; kb < 4; ++kb) {
        f32x16 pz = {};
#pragma unroll
        for (int d0 = 0; d0 < 8; ++d0) {
            const bf16x8 kf = *reinterpret_cast<const bf16x8*>(Ks + (32 * kb + r32) * KROWB + (d0 * 16 + hi * 8) * 2);
            pz = __builtin_amdgcn_mfma_f32_32x32x16_bf16(kf, qr[d0], pz, 0, 0, 0);
        }
#pragma unroll
        for (int r = 0; r < 16; ++r) {
            const int dd = iq - (32 * kb + crow(r, hi));
            pz[r] *= (dd >= 0) ? dec[512 + dd] : dec[640 - dd];
        }
#pragma unroll
        for (int s2 = 0; s2 < 2; ++s2) {
            ga::u32x4 pw = {pack2(pz[8 * s2 + 0], pz[8 * s2 + 1]), pack2(pz[8 * s2 + 2], pz[8 * s2 + 3]), pack2(pz[8 * s2 + 4], pz[8 * s2 + 5]), pack2(pz[8 * s2 + 6], pz[8 * s2 + 7])};
            const bf16x8 pa = *reinterpret_cast<bf16x8*>(&pw);
#pragma unroll
            for (int db = 0; db < 4; ++db) {
                const char* vp = Vt + (128 * wv + 32 * db + r32) * VROWB + (32 * kb + 16 * s2 + 4 * hi) * 2;
                const uint2 lo = *(const uint2*)vp, hi2 = *(const uint2*)(vp + 16);
                ga::u32x4 bw = {lo.x, lo.y, hi2.x, hi2.y};
                o[db] = __builtin_amdgcn_mfma_f32_32x32x16_bf16(pa, *reinterpret_cast<bf16x8*>(&bw), o[db], 0, 0, 0);
            }
        }
    }
    char* Ss = lds;
#define R3_ST(i, v) do { const int idx = tid + NT * (i); *(uint4*)(Ss + (idx >> 4) * KROWB + (idx & 15) * 16) = (v); } while (0)
#define R3_STATE_WRITE() do { R3_ST(0, sv0); R3_ST(1, sv1); R3_ST(2, sv2); R3_ST(3, sv3); R3_ST(4, sv4); R3_ST(5, sv5); R3_ST(6, sv6); R3_ST(7, sv7); } while (0)
#define R3_STATE_MMA(SC) do { const float sc_ = (SC); _Pragma("unroll") for (int s = 0; s < 8; ++s) { const bf16x8 qa = scaleq(qr[s], sc_); \
        _Pragma("unroll") for (int db = 0; db < 4; ++db) { \
            const bf16x8 bfr = *reinterpret_cast<const bf16x8*>(Ss + (128 * wv + 32 * db + r32) * KROWB + (16 * s + 8 * hi) * 2); \
            o[db] = __builtin_amdgcn_mfma_f32_32x32x16_bf16(qa, bfr, o[db], 0, 0, 0); } } } while (0)
    __syncthreads();
    R3_STATE_WRITE();
    sv0 = R3_LD(St1, 0); sv1 = R3_LD(St1, 1); sv2 = R3_LD(St1, 2); sv3 = R3_LD(St1, 3); sv4 = R3_LD(St1, 4); sv5 = R3_LD(St1, 5); sv6 = R3_LD(St1, 6); sv7 = R3_LD(St1, 7);
    __syncthreads();
    R3_STATE_MMA(dec[256 + iq]);
    __syncthreads();
    R3_STATE_WRITE();
    uint4 uv[8];
#pragma unroll
    for (int k = 0; k < 8; ++k) { const int cidx = tid + NT * k; uv[k] = *(const uint4*)(UR + (size_t)(row0 + (cidx >> 5)) * 1024 + h * 256 + (cidx & 31) * 8); }
    __syncthreads();
    R3_STATE_MMA(dec[384 + iq]);
#undef R3_STATE_WRITE
#undef R3_STATE_MMA
#undef R3_ST
#undef R3_LD
    float ssq[16];
#pragma unroll
    for (int r = 0; r < 16; ++r) { ssq[r] = o[0][r] * o[0][r] + o[1][r] * o[1][r] + o[2][r] * o[2][r] + o[3][r] * o[3][r]; }
#pragma unroll
    for (int r = 0; r < 16; ++r) {
        float v = ssq[r];
        v += shx(v, 1, lane); v += shx(v, 2, lane); v += shx(v, 4, lane); v += shx(v, 8, lane); v += shx(v, 16, lane);
        ssq[r] = v;
    }
    if (r32 == 0) {
#pragma unroll
        for (int r = 0; r < 16; ++r) red[wv * 128 + 32 * wq + crow(r, hi)] = ssq[r];
    }
    __syncthreads();
    char* Os = lds;
#pragma unroll
    for (int r = 0; r < 16; ++r) {
        const int il = crow(r, hi);
        const float rs = rsqrtf((red[32 * wq + il] + red[128 + 32 * wq + il]) * (1.f / 256.f) + EPS);
#pragma unroll
        for (int db = 0; db < 4; ++db) *(bf16*)(Os + (32 * wq + il) * 528 + (128 * wv + 32 * db + r32) * 2) = f2bf(o[db][r] * rs);
    }
    __syncthreads();
    {
#pragma unroll
        for (int k = 0; k < 8; ++k) {
            const int cidx = tid + NT * k;
            const uint4 ov = *(const uint4*)(Os + (cidx >> 5) * 528 + (cidx & 31) * 16);
            float uf[8], of[8]; unpack8(uv[k], uf); unpack8(ov, of);
            uint4 w; w.x = pack2(of[0] * fsilu_(uf[0]), of[1] * fsilu_(uf[1])); w.y = pack2(of[2] * fsilu_(uf[2]), of[3] * fsilu_(uf[3]));
            w.z = pack2(of[4] * fsilu_(uf[4]), of[5] * fsilu_(uf[5])); w.w = pack2(of[6] * fsilu_(uf[6]), of[7] * fsilu_(uf[7]));
            *(uint4*)(UR + (size_t)(row0 + (cidx >> 5)) * 1024 + h * 256 + (cidx & 31) * 8) = w;
        }
    }
    __syncthreads();
}
}

__device__ __forceinline__ void ret3_item(const Params& p, int l, int it, char* smem) {
    int b, h, c;
    if (it < 512) { c = it & 31; h = (it >> 5) & 3; b = it >> 7; }
    else { int j = it - 512; c = 32 + (j & 1); h = (j >> 1) & 3; b = j >> 3; }
    r3::body(p, l, b, h, c, smem);
}

namespace swa {
constexpr int KROWB = 144, VROWB = 136;
constexpr int KT_BYTES = 64 * KROWB, VT_BYTES = 64 * VROWB, BUF_BYTES = KT_BYTES + VT_BYTES;
constexpr float LOG2E = 1.4426950408889634f;
constexpr float THR = 8.f;
__device__ __forceinline__ int crow(int r, int hi) { return (r & 3) + 8 * (r >> 2) + 4 * hi; }

__device__ __forceinline__ void body(const Params& p, int l, int b, int kvh, int qrow0, int q0pos, char* lds) {
    const int tid = otid(), wid = tid >> 6, lane = tid & 63, r32 = lane & 31, hi = lane >> 5;
    bf16* QS = (bf16*)(p.ws + OFF_QS); const bf16* KS = (const bf16*)(p.ws + OFF_KS); const bf16* VT = (const bf16*)(p.ws + OFF_VS);
    float* wsl = (float*)(lds + 2 * BUF_BYTES) + wid * 128;
    const int head = kvh * 8 + wid;
    const float sinkv = p.sink[l * 16 + head];
    float m_reg[2] = {sinkv, sinkv}, l_reg[2] = {1.f, 1.f};
    f32x16 o[2][2] = {};
    bf16x8 qr[2][4];
#pragma unroll
    for (int qb = 0; qb < 2; ++qb) {
        const bf16* Qw = QS + (size_t)(qrow0 + 32 * qb + r32) * 1024 + head * 64 + hi * 8;
#pragma unroll
        for (int d0 = 0; d0 < 4; ++d0) qr[qb][d0] = *reinterpret_cast<const bf16x8*>(Qw + d0 * 16);
    }
    int t0 = 0, nloc = 0;
    if (q0pos >= 0) {
        const int lo = q0pos - 128 < 0 ? 0 : q0pos - 128, hiq = q0pos + 192 > SEQ ? SEQ : q0pos + 192;
        t0 = lo >> 6; nloc = ((hiq - 1) >> 6) - t0 + 1;
    }
    const int ntiles = nloc + 4;
    const int sk = tid >> 3, sch = tid & 7;
    const bf16* vtb = VT + ((size_t)(b * 2 + kvh) * 64 + sk) * KEYS + sch * 8;
    uint4 rkA, rvA, rkB, rvB;
#define TLOAD(t, RK, RV) do { const int t_ = (t); const bool loc_ = t_ < nloc; const int key0_ = loc_ ? (t0 + t_) * 64 : 4096 + (t_ - nloc) * 64; \
        const int krow_ = loc_ ? b * SEQ + key0_ : TLAT + b * CTXL + (t_ - nloc) * 64; \
        RK = *(const uint4*)(KS + (size_t)(krow_ + sk) * 128 + kvh * 64 + sch * 8); RV = *(const uint4*)(vtb + key0_); } while (0)
#define TWRITE(buf, RK, RV) do { char* kb_ = lds + (buf) * BUF_BYTES; *(uint4*)(kb_ + sk * KROWB + sch * 16) = RK; \
        char* vb_ = kb_ + KT_BYTES + sk * VROWB + sch * 16; *(uint2*)vb_ = make_uint2(RV.x, RV.y); *(uint2*)(vb_ + 8) = make_uint2(RV.z, RV.w); } while (0)
#define SM_PV(t, QB, p0, p1) do { \
        const int qpos_ = q0pos + 32 * (QB); \
        if ((t) < nloc && !((t0 + (t)) * 64 >= qpos_ - 97 && (t0 + (t)) * 64 + 63 <= qpos_ + 128)) { const int kbase = (t0 + (t)) * 64 - (qpos_ + r32); \
            _Pragma("unroll") for (int r = 0; r < 16; ++r) { int d0_ = kbase + crow(r, hi); int d1_ = d0_ + 32; \
                if (d0_ < -128 || d0_ > 128) p0[r] = -1e30f; if (d1_ < -128 || d1_ > 128) p1[r] = -1e30f; } } \
        float pmax = p0[0]; \
        _Pragma("unroll") for (int r = 1; r < 16; ++r) pmax = fmaxf(pmax, p0[r]); \
        _Pragma("unroll") for (int r = 0; r < 16; ++r) pmax = fmaxf(pmax, p1[r]); \
        { auto rr = __builtin_amdgcn_permlane32_swap(__float_as_uint(pmax), __float_as_uint(pmax), false, false); \
          pmax = fmaxf(__uint_as_float(rr[0]), __uint_as_float(rr[1])); } \
        float alpha = 1.f; \
        if (!__all(pmax - m_reg[QB] <= THR)) { const float mn = fmaxf(m_reg[QB], pmax); float* al_ = wsl + 64 + 32 * (QB); \
            alpha = __builtin_amdgcn_exp2f((m_reg[QB] - mn) * LOG2E); m_reg[QB] = mn; \
            if (hi == 0) al_[r32] = alpha; \
            asm volatile("s_waitcnt lgkmcnt(0)" ::: "memory"); \
            _Pragma("unroll") for (int d = 0; d < 2; ++d) _Pragma("unroll") for (int r = 0; r < 16; ++r) o[QB][d][r] *= al_[crow(r, hi)]; } \
        const float mC = -m_reg[QB] * LOG2E; float ps = 0.f; \
        _Pragma("unroll") for (int r = 0; r < 16; ++r) { p0[r] = __builtin_amdgcn_exp2f(fmaf(p0[r], LOG2E, mC)); ps += p0[r]; } \
        _Pragma("unroll") for (int r = 0; r < 16; ++r) { p1[r] = __builtin_amdgcn_exp2f(fmaf(p1[r], LOG2E, mC)); ps += p1[r]; } \
        { auto rr = __builtin_amdgcn_permlane32_swap(__float_as_uint(ps), __float_as_uint(ps), false, false); \
          ps = __uint_as_float(rr[0]) + __uint_as_float(rr[1]); } \
        l_reg[QB] = l_reg[QB] * alpha + ps; \
        _Pragma("unroll") for (int s4 = 0; s4 < 4; ++s4) { unsigned w0, w1, w2, w3; \
            if (s4 < 2) { w0 = pack2(p0[8 * s4 + 0], p0[8 * s4 + 1]); w1 = pack2(p0[8 * s4 + 2], p0[8 * s4 + 3]); w2 = pack2(p0[8 * s4 + 4], p0[8 * s4 + 5]); w3 = pack2(p0[8 * s4 + 6], p0[8 * s4 + 7]); } \
            else { const int s2 = s4 - 2; w0 = pack2(p1[8 * s2 + 0], p1[8 * s2 + 1]); w1 = pack2(p1[8 * s2 + 2], p1[8 * s2 + 3]); w2 = pack2(p1[8 * s2 + 4], p1[8 * s2 + 5]); w3 = pack2(p1[8 * s2 + 6], p1[8 * s2 + 7]); } \
            ga::u32x4 pw = {w0, w1, w2, w3}; bf16x8 pa = *reinterpret_cast<bf16x8*>(&pw); \
            _Pragma("unroll") for (int db = 0; db < 2; ++db) { \
                const char* vp = Vb + (db * 32 + r32) * VROWB + (16 * s4 + 4 * hi) * 2; \
                uint2 lo = *(const uint2*)vp, hi2 = *(const uint2*)(vp + 16); \
                ga::u32x4 bw = {lo.x, lo.y, hi2.x, hi2.y}; bf16x8 vb = *reinterpret_cast<bf16x8*>(&bw); \
                o[QB][db] = __builtin_amdgcn_mfma_f32_32x32x16_bf16(pa, vb, o[QB][db], 0, 0, 0); } } \
    } while (0)
#define TILE_COMPUTE(t) do { \
        const char* Kb = lds + ((t) & 1) * BUF_BYTES; const char* Vb = Kb + KT_BYTES; \
        f32x16 pa0 = {}, pa1 = {}, pb0 = {}, pb1 = {}; \
        _Pragma("unroll") for (int d0 = 0; d0 < 4; ++d0) { \
            bf16x8 k0 = *reinterpret_cast<const bf16x8*>(Kb + r32 * KROWB + (d0 * 16 + hi * 8) * 2); \
            bf16x8 k1 = *reinterpret_cast<const bf16x8*>(Kb + (32 + r32) * KROWB + (d0 * 16 + hi * 8) * 2); \
            pa0 = __builtin_amdgcn_mfma_f32_32x32x16_bf16(k0, qr[0][d0], pa0, 0, 0, 0); \
            pa1 = __builtin_amdgcn_mfma_f32_32x32x16_bf16(k1, qr[0][d0], pa1, 0, 0, 0); \
            pb0 = __builtin_amdgcn_mfma_f32_32x32x16_bf16(k0, qr[1][d0], pb0, 0, 0, 0); \
            pb1 = __builtin_amdgcn_mfma_f32_32x32x16_bf16(k1, qr[1][d0], pb1, 0, 0, 0); } \
        SM_PV(t, 0, pa0, pa1); \
        SM_PV(t, 1, pb0, pb1); \
    } while (0)
    TLOAD(0, rkA, rvA); TLOAD(1, rkB, rvB);
    TWRITE(0, rkA, rvA); __syncthreads();
    int t = 0;
    for (; t + 1 < ntiles; t += 2) {
        if (t + 2 < ntiles) TLOAD(t + 2, rkA, rvA);
        TILE_COMPUTE(t);
        TWRITE(1, rkB, rvB);
        __syncthreads();
        if (t + 3 < ntiles) TLOAD(t + 3, rkB, rvB);
        TILE_COMPUTE(t + 1);
        if (t + 2 < ntiles) TWRITE(0, rkA, rvA);
        __syncthreads();
    }
    if (t < ntiles) { TILE_COMPUTE(t); __syncthreads(); }
#undef TILE_COMPUTE
#undef SM_PV
#pragma unroll
    for (int qb = 0; qb < 2; ++qb) if (hi == 0) wsl[32 * qb + r32] = l_reg[qb];
    asm volatile("s_waitcnt lgkmcnt(0)" ::: "memory");
#pragma unroll
    for (int qb = 0; qb < 2; ++qb) {
        bf16* Ow = QS + (size_t)(qrow0 + 32 * qb) * 1024 + head * 64;
#pragma unroll
        for (int r = 0; r < 16; ++r) {
            const int orow = crow(r, hi); const float rl = 1.f / wsl[32 * qb + orow];
#pragma unroll
            for (int db = 0; db < 2; ++db) Ow[(size_t)orow * 1024 + db * 32 + r32] = f2bf(o[qb][db][r] * rl);
        }
    }
    __syncthreads();
#undef TLOAD
#undef TWRITE
}
}

__device__ __forceinline__ void swa_item(const Params& p, int l, int it, char* smem) {
    if (it < 512) {
        const int pair = it & 7, j = it >> 3, b = pair >> 1, kvh = pair & 1;
        swa::body(p, l, b, kvh, b * SEQ + j * 64, j * 64, smem);
    } else {
        const int j = it - 512, pair = j & 7, qb = j >> 3, b = pair >> 1, kvh = pair & 1;
        swa::body(p, l, b, kvh, TLAT + b * CTXL + qb * 64, -1, smem);
    }
}
__device__ __forceinline__ void phase_mixA(const Params& p, int l, char* smem) {
    const int G = gridDim.x, bid = blockIdx.x;
    const int nga = bid < 256 ? (256 - bid + G - 1) / G : 0;
    const int n = 2 * nga;
    const bool rev = (bid >> 6) & 1;
    for (int k = 0; k < n; ++k) {
        const int kk = rev ? n - 1 - k : k;
        if (kk < nga) ga_item(p, l, bid + kk * G, smem);
        else ret_state_job(p, l, bid + (kk - nga) * G, smem);
    }
}
__device__ __forceinline__ void phase_mixB(const Params& p, int l, char* smem) {
    const int n_r3 = 512 + (l == 0 ? 32 : 0), n_sw = 512 + (l == 0 ? 32 : 0), n_gc = (l == 0 ? 32 : 0), n_cg = (l == 0 ? 48 : 0);
    const int total = 256 + n_r3 + n_sw + n_gc + n_cg;
    const int G = gridDim.x, bid = blockIdx.x;
    const int n = bid < total ? (total - bid + G - 1) / G : 0;
    const bool rev = (bid >> 3) & 1;
    for (int k = 0; k < n; ++k) {
        const int it = bid + (rev ? n - 1 - k : k) * G;
        if (it < 256) ga_item(p, l, 256 + it, smem);
        else if (it < 256 + n_r3) ret3_item(p, l, it - 256, smem);
        else if (it < 256 + n_r3 + n_sw) swa_item(p, l, it - 256 - n_r3, smem);
        else if (it < 256 + n_r3 + n_sw + n_gc) ga_item(p, l, 512 + (it - 256 - n_r3 - n_sw), smem);
        else ctx_gate_item(p, it - (256 + n_r3 + n_sw + n_gc), smem);
    }
}

#define XB_TMO      128
#define XB_XCNT(j)  (256  + 64 * (j))
#define XB_XSUB(j)  (1280 + 64 * (j))
#define XB_XGEN(j)  (2304 + 64 * (j))
#define XB_TOP      3328
#define XB_TOPGEN   3392
#define XCD_BAR_WORDS 3456
#define XB_SPIN_CAP (1u << 22)
#define LAS __attribute__((address_space(3)))
__device__ __forceinline__ unsigned xb_ld(unsigned* p)              { return __hip_atomic_load(p, __ATOMIC_RELAXED, __HIP_MEMORY_SCOPE_AGENT); }
__device__ __forceinline__ unsigned xb_add(unsigned* p, unsigned v) { return __hip_atomic_fetch_add(p, v, __ATOMIC_RELAXED, __HIP_MEMORY_SCOPE_AGENT); }
__device__ __forceinline__ unsigned xb_xcc_id() { return (unsigned)__builtin_amdgcn_s_getreg((3 << 11) | 20) & 0xFu; }
#define XB_SPIN(cond, bar) do { unsigned _sp = 0; while (cond) { __builtin_amdgcn_s_sleep(1); \
    if ((++_sp & 255u) == 0u) { if (xb_ld(&(bar)[XB_TMO])) break; if (_sp > XB_SPIN_CAP) { atomicAdd(&(bar)[XB_TMO], 1u); break; } } } } while (0)
struct XcdBarrier { unsigned* bar; unsigned x; volatile LAS unsigned* st; };
__device__ __forceinline__ XcdBarrier xcd_barrier_post(unsigned* bar, volatile LAS unsigned* st) {
    XcdBarrier b; b.bar = bar; b.x = xb_xcc_id(); b.st = st;
    if (threadIdx.x == 0) (void)xb_add(&bar[XB_XCNT(b.x)], 1u);
    return b;
}
__device__ __forceinline__ void xcd_barrier_complete(unsigned* bar, unsigned x, unsigned& nloc, unsigned& nx) {
    const unsigned G = gridDim.x * gridDim.y * gridDim.z;
    unsigned sum, cnt, mine, sp = 0u;
    for (;;) {
        sum = 0u; cnt = 0u; mine = 0u;
#pragma unroll
        for (unsigned j = 0; j < 16; ++j) { const unsigned c = xb_ld(&bar[XB_XCNT(j)]); sum += c; cnt += (c > 0u) ? 1u : 0u; mine = (j == x) ? c : mine; }
        if (sum == G) break;
        __builtin_amdgcn_s_sleep(1);
        if ((++sp & 255u) == 0u) { if (xb_ld(&bar[XB_TMO])) break; if (sp > XB_SPIN_CAP) { atomicAdd(&bar[XB_TMO], 1u); break; } }
    }
    nloc = mine > 0u ? mine : 1u; nx = cnt > 0u ? cnt : 1u;
}
__device__ __forceinline__ void xcd_barrier(const XcdBarrier& b) {
    asm volatile("s_waitcnt vmcnt(0)" ::: "memory");
    __syncthreads();
    if (threadIdx.x == 0) {
        unsigned* bar = b.bar;
        __builtin_amdgcn_s_waitcnt(0);
        unsigned nloc = b.st[0], nx = b.st[1];
        if (nloc == 0u) { xcd_barrier_complete(bar, b.x, nloc, nx); b.st[0] = nloc; b.st[1] = nx; }
        const unsigned old = xb_add(&bar[XB_XSUB(b.x)], 1u);
        const unsigned gen = old / nloc;
        if (old + 1u == (gen + 1u) * nloc) {
            __builtin_amdgcn_fence(__ATOMIC_RELEASE, "agent");
            asm volatile("s_waitcnt vmcnt(0)" ::: "memory");
            const unsigned og = xb_add(&bar[XB_TOP], 1u);
            const unsigned tg = og / nx;
            if (og + 1u == (tg + 1u) * nx) xb_add(&bar[XB_TOPGEN], 1u);
            else XB_SPIN(xb_ld(&bar[XB_TOPGEN]) == tg, bar);
            __builtin_amdgcn_fence(__ATOMIC_ACQUIRE, "agent");
            xb_add(&bar[XB_XGEN(b.x)], 1u);
            asm volatile("s_waitcnt vmcnt(0)" ::: "memory");
        } else {
            XB_SPIN(xb_ld(&bar[XB_XGEN(b.x)]) == gen, bar);
            __builtin_amdgcn_fence(__ATOMIC_ACQUIRE, "agent");
            asm volatile("s_waitcnt vmcnt(0)" ::: "memory");
        }
    }
    __syncthreads();
}

constexpr int PH_PER_LAYER = 9;
constexpr int NPHASE = 2 + 2 * PH_PER_LAYER;
constexpr int LDS_BYTES = pg8::STAGE_BYTES + 4096;

__device__ __forceinline__ void run_phase(const Params& p, int ph, char* smem) {
#ifndef PHASE_MASK
    if (ph == 0) { phase0(p, smem); return; }
    if (ph == NPHASE - 1) { phase_final(p); return; }
#else
    if (ph == 0 || ph == NPHASE - 1) return;
#endif
    const int l = (ph - 1) / PH_PER_LAYER, s = (ph - 1) % PH_PER_LAYER;
#ifdef PHASE_MASK
    if (!((PHASE_MASK >> s) & 1)) return;
#endif
    switch (s) {
        case 0: phase_norm1(p, l); if (l == 0) conv_run(p, 0, 0, smem); break;
        case 1: phase_inproj(p, l, smem); break;
        case 2: phase_mixA(p, l, smem); break;
        case 3: phase_mixB(p, l, smem); break;
        case 4: phase_gates_merge(p, l, smem); break;
        case 5: phase_outproj(p, l, smem); break;
        case 6: phase_norm2(p, l, smem); break;
        case 7: phase_moe1(p, l, smem); break;
        case 8: phase_moe2(p, l, smem); break;
    }
}

__global__ void __launch_bounds__(NT, 2) mega(Params p) {
    extern __shared__ __attribute__((aligned(16))) char smem[];
    cg::grid_group grid = cg::this_grid();
    volatile LAS unsigned* st = (volatile LAS unsigned*)(smem + LDS_BYTES);
    if (threadIdx.x < 4) st[threadIdx.x] = 0u;
    __syncthreads();
    unsigned* barw = (unsigned*)(p.ws + OFF_BAR);
#if !MULTI_LAUNCH
    if (blockIdx.x == 0) { for (int i = threadIdx.x; i < XCD_BAR_WORDS; i += NT) __hip_atomic_store(barw + i, 0u, __ATOMIC_RELAXED, __HIP_MEMORY_SCOPE_AGENT); __threadfence(); }
#endif
    XcdBarrier bar; bar.bar = barw; bar.x = 0u; bar.st = st;
#if MULTI_LAUNCH
    bar = xcd_barrier_post(barw, st);
#endif
    for (int ph = p.ph_lo; ph < p.ph_hi; ++ph) {
        run_phase(p, ph, smem);
        if (ph + 1 < p.ph_hi) {
            if (ph == p.ph_lo) {
                grid.sync();
#if !MULTI_LAUNCH
                bar = xcd_barrier_post(barw, st);
#endif
            }
            else xcd_barrier(bar);
        }
    }
}

extern "C" void kernel_launch(void* const* d_in, const int* in_sizes, int n_in, void* d_out, int out_size, void* d_ws, size_t ws_size,
                              hipStream_t stream) {
    static int grid_blocks = 0;
    if (!grid_blocks) {
        int dev = 0, cus = 0, per_cu = 0;
        hipGetDevice(&dev);
        hipDeviceGetAttribute(&cus, hipDeviceAttributeMultiprocessorCount, dev);
        hipFuncSetAttribute((const void*)mega, hipFuncAttributeMaxDynamicSharedMemorySize, LDS_BYTES + 16);
        hipOccupancyMaxActiveBlocksPerMultiprocessor(&per_cu, (const void*)mega, NT, LDS_BYTES + 16);
        if (per_cu < 1) { fprintf(stderr, "occupancy query returned %d\n", per_cu); per_cu = 1; }
        if (per_cu > 1) per_cu = 1;
        grid_blocks = cus * per_cu; if (grid_blocks > MAXBLK) grid_blocks = MAXBLK;
        if (ws_size < WS_END) fprintf(stderr, "workspace too small: %zu < %zu\n", ws_size, (size_t)WS_END);
    }
    Params p{};
    const float** f = (const float**)&p;
    for (int i = 0; i < 23; ++i) f[i] = (const float*)d_in[i];
    p.out = (float*)d_out; p.ws = (unsigned char*)d_ws;
#if MULTI_LAUNCH
    for (int ph = 0; ph < NPHASE; ++ph) {
        p.ph_lo = ph; p.ph_hi = ph + 1;
        hipMemsetAsync((char*)d_ws + OFF_BAR, 0, 16384, stream);
        hipLaunchKernelGGL(mega, dim3(grid_blocks), dim3(NT), LDS_BYTES + 16, stream, p);
    }
#else
    p.ph_lo = 0; p.ph_hi = NPHASE;
    void* args[] = {&p};
    hipError_t e = hipLaunchCooperativeKernel((const void*)mega, dim3(grid_blocks), dim3(NT), args, LDS_BYTES + 16, stream);
    if (e != hipSuccess) fprintf(stderr, "cooperative launch failed: %s (grid %d)\n", hipGetErrorString(e), grid_blocks);
#endif
}
```
